# Optimizing an MI355X kernel written in HIP

```python
import math
import jax
import jax.numpy as jnp
from jax import lax
import numpy as np

D_MODEL = 1024
BATCH = 32
SEQ = 2048
DEPTH = 1

N_META = 16
BLOCK = 128
PAD = BLOCK - N_META
WINDOW = 128
A_HEADS = 8
A_KV_HEADS = 2
A_HEAD_DIM = 64
B_HEADS = 8
B_HEAD_DIM = 64
B_Q_RANK = 256
B_KV_RANK = 128
IDX_HEADS = 4
IDX_DIM = 64
TOPK_MAX = 256
N_BUCKETS = 32
MAX_DISTANCE = 128
TOTAL_HEADS = A_HEADS + B_HEADS
D_FF = -(-8 * D_MODEL // (3 * 256)) * 256
EPS = 1e-6
NEG = -1e30

IN_WIDTHS = (A_HEADS * A_HEAD_DIM, A_KV_HEADS * A_HEAD_DIM, A_KV_HEADS * A_HEAD_DIM,
             B_Q_RANK, B_KV_RANK, IDX_HEADS * IDX_DIM, IDX_DIM, IDX_HEADS, 2 * D_MODEL)
IN_SPLITS = tuple(sum(IN_WIDTHS[:i + 1]) for i in range(len(IN_WIDTHS) - 1))
D_IN = sum(IN_WIDTHS)

kernel_name = "hybrid_gated_swa_sink_dsa_mla_block"


def rms_norm(x, g):
    xf = x.astype(jnp.float32)
    y = xf * lax.rsqrt(jnp.mean(xf * xf, axis=-1, keepdims=True) + EPS)
    return (y * g.astype(jnp.float32)).astype(x.dtype)


def layer_norm(x, g, b):
    xf = x.astype(jnp.float32)
    mu = jnp.mean(xf, axis=-1, keepdims=True)
    xc = xf - mu
    var = jnp.mean(xc * xc, axis=-1, keepdims=True)
    return (xc * lax.rsqrt(var + EPS) * g.astype(jnp.float32) + b.astype(jnp.float32)).astype(x.dtype)


def t5_bucket(dist):
    max_exact = N_BUCKETS // 2
    d = jnp.maximum(dist, 1).astype(jnp.float32)
    large = max_exact + (jnp.log(d / max_exact) / math.log(MAX_DISTANCE / max_exact)
                         * (N_BUCKETS - max_exact)).astype(jnp.int32)
    large = jnp.minimum(large, N_BUCKETS - 1)
    return jnp.where(dist < max_exact, dist, large)


def sliding_window_sink_attention(q, k, v, sinks, bias_table):
    b, p, _ = q.shape
    nb = p // BLOCK
    grp = A_HEADS // A_KV_HEADS
    qb = q.reshape(b, nb, BLOCK, A_KV_HEADS, grp, A_HEAD_DIM)
    kb = k.reshape(b, nb, BLOCK, A_KV_HEADS, A_HEAD_DIM)
    vb = v.reshape(b, nb, BLOCK, A_KV_HEADS, A_HEAD_DIM)

    def with_prev(t):
        prev = jnp.concatenate([jnp.zeros_like(t[:, :1]), t[:, :-1]], axis=1)
        return jnp.concatenate([prev, t], axis=2)

    kw, vw = with_prev(kb), with_prev(vb)
    s = jnp.einsum('bnqhgd,bnkhd->bnhgqk', qb, kw).astype(jnp.float32) * (A_HEAD_DIM ** -0.5)
    blk = jnp.arange(nb)[:, None] * BLOCK
    qpos = blk + jnp.arange(BLOCK)[None]
    kpos = blk - BLOCK + jnp.arange(2 * BLOCK)[None]
    dist = qpos[:, :, None] - kpos[:, None, :]
    allowed = (dist >= 0) & (dist < WINDOW) & (kpos[:, None, :] >= PAD)
    bias = bias_table[t5_bucket(jnp.maximum(dist, 0))]
    bias = bias.reshape(nb, BLOCK, 2 * BLOCK, A_KV_HEADS, grp).transpose(0, 3, 4, 1, 2)
    s = jnp.where(allowed[None, :, None, None], s + bias.astype(jnp.float32)[None], NEG)
    sink = sinks.astype(jnp.float32).reshape(A_KV_HEADS, grp)[None, None, :, :, None]
    m = jnp.maximum(s.max(axis=-1), sink)
    e = jnp.exp(s - m[..., None])
    pr = e / (e.sum(axis=-1, keepdims=True) + jnp.exp(sink - m)[..., None])
    o = jnp.einsum('bnhgqk,bnkhd->bnqhgd', pr.astype(v.dtype), vw)
    return o.reshape(b, p, A_HEADS * A_HEAD_DIM)


def indexed_sparse_mla(q_abs, c_kv, iq, ik, iw, w_uv, bias_table):
    b, p, _, _ = q_abs.shape
    nb = p // BLOCK
    topk = min(TOPK_MAX, (p - BLOCK) // 4)
    kpos = jnp.arange(p)
    gather = jax.vmap(lambda rows, idx: rows[idx])
    scale = B_HEAD_DIM ** -0.5

    def one_block(i):
        start = i * BLOCK
        qa = lax.dynamic_slice_in_dim(q_abs, start, BLOCK, axis=1)
        qi = lax.dynamic_slice_in_dim(iq, start, BLOCK, axis=1)
        wi = lax.dynamic_slice_in_dim(iw, start, BLOCK, axis=1)
        qpos = start + jnp.arange(BLOCK)
        logits = jnp.einsum('bqhd,bsd->bqhs', qi, ik)
        score = jnp.einsum('bqhs,bqh->bqs', jax.nn.relu(logits).astype(jnp.float32),
                           wi.astype(jnp.float32))
        admissible = (kpos[None, :] <= qpos[:, None]) & (kpos[None, :] >= PAD)
        score = jnp.where(admissible[None], score, -jnp.inf)
        _, sel = lax.top_k(score, topk)
        valid = (sel <= qpos[None, :, None]) & (sel >= PAD)
        c_sel = gather(c_kv, sel)
        s = jnp.einsum('bqhc,bqkc->bqhk', qa, c_sel).astype(jnp.float32) * scale
        bias = bias_table[t5_bucket(jnp.maximum(qpos[None, :, None] - sel, 0))]
        s = jnp.where(valid[:, :, None, :], s + jnp.moveaxis(bias, -1, 2).astype(jnp.float32), NEG)
        pr = jax.nn.softmax(s, axis=-1)
        return jnp.einsum('bqhk,bqkc->bqhc', pr.astype(c_kv.dtype), c_sel)

    lat = lax.map(one_block, jnp.arange(nb))
    lat = lat.transpose(1, 0, 2, 3, 4).reshape(b, p, B_HEADS, B_KV_RANK)
    o = jnp.einsum('bphc,chd->bphd', lat, w_uv)
    return o.reshape(b, p, B_HEADS * B_HEAD_DIM)


def setup_inputs(seed: int = 0) -> dict:
    key = jax.random.key(seed)
    ks = jax.random.split(key, 24)
    f32 = jnp.float32

    def dense(k, shape, fan_in):
        return jax.random.normal(k, shape, f32) * (fan_in ** -0.5)

    def gain(k, shape):
        return 1.0 + 0.05 * jax.random.normal(k, shape, f32)

    return {
        "x": jax.random.normal(ks[0], (BATCH, SEQ, D_MODEL), f32),
        "meta_tokens": jax.random.normal(ks[1], (N_META, D_MODEL), f32),
        "attn_norm_g": gain(ks[2], (DEPTH, D_MODEL)),
        "w_in": dense(ks[3], (DEPTH, D_MODEL, D_IN), D_MODEL),
        "b_gates": 0.02 * jax.random.normal(ks[4], (DEPTH, 2 * D_MODEL), f32),
        "q_norm_g": gain(ks[5], (DEPTH, B_Q_RANK)),
        "kv_norm_g": gain(ks[6], (DEPTH, B_KV_RANK)),
        "w_uq": dense(ks[7], (DEPTH, B_Q_RANK, B_HEADS * B_HEAD_DIM), B_Q_RANK),
        "w_uk": dense(ks[8], (DEPTH, B_KV_RANK, B_HEADS, B_HEAD_DIM), B_KV_RANK),
        "w_uv": dense(ks[9], (DEPTH, B_KV_RANK, B_HEADS, B_HEAD_DIM), B_KV_RANK),
        "idx_k_ln_g": gain(ks[10], (DEPTH, IDX_DIM)),
        "idx_k_ln_b": 0.02 * jax.random.normal(ks[11], (DEPTH, IDX_DIM), f32),
        "sinks": 0.5 * jax.random.normal(ks[12], (DEPTH, A_HEADS), f32),
        "rel_bias": 0.2 * jax.random.normal(ks[13], (N_BUCKETS, TOTAL_HEADS), f32),
        "w_branch_a": dense(ks[14], (DEPTH, A_HEADS * A_HEAD_DIM, D_MODEL), A_HEADS * A_HEAD_DIM),
        "w_branch_b": dense(ks[15], (DEPTH, B_HEADS * B_HEAD_DIM, D_MODEL), B_HEADS * B_HEAD_DIM),
        "w_out": dense(ks[16], (DEPTH, D_MODEL, D_MODEL), D_MODEL),
        "ffn_norm_g": gain(ks[17], (DEPTH, D_MODEL)),
        "w_ffn_gate": dense(ks[18], (DEPTH, D_MODEL, D_FF), D_MODEL),
        "w_ffn_up": dense(ks[19], (DEPTH, D_MODEL, D_FF), D_MODEL),
        "w_ffn_down": dense(ks[20], (DEPTH, D_FF, D_MODEL), D_FF),
        "final_norm_g": gain(ks[21], (D_MODEL,)),
    }


def reference(x, meta_tokens, attn_norm_g, w_in, b_gates, q_norm_g, kv_norm_g, w_uq, w_uk, w_uv,
              idx_k_ln_g, idx_k_ln_b, sinks, rel_bias, w_branch_a, w_branch_b, w_out,
              ffn_norm_g, w_ffn_gate, w_ffn_up, w_ffn_down, final_norm_g):
    b, seq, d = x.shape
    meta = jnp.broadcast_to(meta_tokens.astype(x.dtype)[None], (b, N_META, d))
    h = jnp.concatenate([jnp.zeros((b, PAD, d), x.dtype), meta, x], axis=1)
    p = h.shape[1]
    bias_a = rel_bias[:, :A_HEADS]
    bias_b = rel_bias[:, A_HEADS:]
    for l in range(DEPTH):
        hn = rms_norm(h, attn_norm_g[l])
        proj = hn @ w_in[l]
        aq, ak, av, bq, bkv, iq, ik, iw, gates = jnp.split(proj, IN_SPLITS, axis=-1)
        gates = jax.nn.sigmoid((gates + b_gates[l]).astype(jnp.float32)).astype(h.dtype)
        gate_a, gate_b = jnp.split(gates, 2, axis=-1)
        o_a = sliding_window_sink_attention(aq, ak, av, sinks[l], bias_a)
        q = (rms_norm(bq, q_norm_g[l]) @ w_uq[l]).reshape(b, p, B_HEADS, B_HEAD_DIM)
        c_kv = rms_norm(bkv, kv_norm_g[l])
        q_abs = jnp.einsum('bphd,chd->bphc', q, w_uk[l])
        iq = iq.reshape(b, p, IDX_HEADS, IDX_DIM)
        ik = layer_norm(ik, idx_k_ln_g[l], idx_k_ln_b[l])
        iw = iw * ((IDX_HEADS * IDX_DIM) ** -0.5)
        o_b = indexed_sparse_mla(q_abs, c_kv, iq, ik, iw, w_uv[l], bias_b)
        mixed = gate_a * (o_a @ w_branch_a[l]) + gate_b * (o_b @ w_branch_b[l])
        h = h + mixed @ w_out[l]
        hn = rms_norm(h, ffn_norm_g[l])
        h = h + (jax.nn.silu(hn @ w_ffn_gate[l]) * (hn @ w_ffn_up[l])) @ w_ffn_down[l]
    y = rms_norm(h, final_norm_g)
    return y[:, PAD + N_META:]
```

```cpp
#include <hip/hip_runtime.h>
#include <cstdio>
#include <cstdint>

#define LAS __attribute__((address_space(3)))
#define GAS __attribute__((address_space(1)))
typedef unsigned short h16;
typedef _Float16 h16x8 __attribute__((ext_vector_type(8)));
typedef _Float16 h16x4 __attribute__((ext_vector_type(4)));
typedef _Float16 h16x2 __attribute__((ext_vector_type(2)));
typedef float f32x4 __attribute__((ext_vector_type(4)));
typedef float f32x16 __attribute__((ext_vector_type(16)));
typedef unsigned u32x4 __attribute__((ext_vector_type(4)));
typedef unsigned u32x2 __attribute__((ext_vector_type(2)));
typedef short s16x4 __attribute__((ext_vector_type(4)));

constexpr int BATCH = 32, SEQ = 2048, D = 1024, NPAD = 112, NMETA = 16, BLK = 128, P = BLK + SEQ  , NBLK = P / BLK  ;
constexpr int M = BATCH * SEQ;
constexpr int DIN = 3524, DINP = 3584, DFF = 2816, NGU = 2 * DFF  ;
constexpr int TOPK = 256;
constexpr float EPS = 1e-6f, LOG2E = 1.4426950408889634f;
constexpr float QSCALE = 0.125f * LOG2E;

__device__ __forceinline__ unsigned pk_h2(float lo, float hi) { h16x2 v = {(_Float16)lo, (_Float16)hi}; return __builtin_bit_cast(unsigned, v); }
__device__ __forceinline__ u32x4 pk_h8(f32x4 a, f32x4 b) { u32x4 w; w.x = pk_h2(a[0], a[1]); w.y = pk_h2(a[2], a[3]); w.z = pk_h2(b[0], b[1]); w.w = pk_h2(b[2], b[3]); return w; }
__device__ __forceinline__ float h2f(h16 v) { return (float)__builtin_bit_cast(_Float16, v); }
__device__ __forceinline__ float sigmoidf_fast(float x) { return __builtin_amdgcn_rcpf(1.0f + __builtin_amdgcn_exp2f(-LOG2E * x)); }

namespace pg8 {
constexpr int BM = 256, BK = 64, HALF = 128, HTB = HALF * BK * 2  , STAGE_BYTES = 8 * HTB, NXCD = 8, WGM = 8;
__host__ __device__ __forceinline__ int lds_byte(int r, int c) { const int st = (r >> 4) * 2 + (c >> 5), rr = r & 15, cc = c & 31, ob = rr * 64 + cc * 2; return st * 1024 + (ob ^ (((ob >> 9) & 1) << 5)); }
__host__ __device__ __forceinline__ void stage_rc(int b, int& R, int& C) { const int st = b / 1024, sb = b % 1024, swz = sb ^ (((sb >> 9) & 1) << 5); R = (st >> 1) * 16 + swz / 64; C = (st & 1) * 32 + (swz % 64) / 2; }
__host__ __device__ __forceinline__ int perm32(int rho) { const int n = rho >> 4, i = rho & 15; return 8 * (i >> 2) + 4 * n + (i & 3); }

struct Unit { int pm, pn; };
struct Gemm { const h16* A; const h16* Bt; int M, N, K; };

struct StaticOrder {
    int nM, nN, nwg, G, c;
    __host__ __device__ void init(int M_, int N_, int G_, int c_) { nM = M_ / BM; nN = N_ / BM; nwg = nM * nN; G = G_; c = c_; }
    __host__ __device__ bool next(int i, Unit& u) const {
        const long L = (long)i * G + c; if (L >= nwg) return false;
        int wgid = (int)L; { const int q = nwg / NXCD, r = nwg % NXCD, xcd = wgid % NXCD, off = wgid / NXCD; wgid = (xcd < r ? xcd * (q + 1) : r * (q + 1) + (xcd - r) * q) + off; }
        const int nig = WGM * nN, gid = wgid / nig, fm = gid * WGM, gsz = (nM - fm) < WGM ? (nM - fm) : WGM;
        u.pm = fm + ((wgid % nig) % gsz); u.pn = (wgid % nig) / gsz; return true;
    }
    __device__ __forceinline__ void a_ready(const Unit&) const {}
    __device__ __forceinline__ void done(const Unit&) const {}
};

template <class Epi, class Sched, bool ALIGN_EPI = true, bool SP2 = true>
__device__ __forceinline__ void gemm_phase(LAS unsigned char* lds, const Gemm g, const Sched& S, const Epi& E) {
    const int tid = threadIdx.x, wid = __builtin_amdgcn_readfirstlane(tid >> 6), lane = tid & 63, wr = wid >> 2, wc = wid & 3, fr = lane & 15, fq = lane >> 4;
    int K = g.K; asm volatile("" : "+s"(K));
    const int nt = K / BK;
    unsigned voffA[2], voffB[2];
#pragma unroll
    for (int i = 0; i < 2; ++i) { int R, C; stage_rc(tid * 16 + i * 8192, R, C); const int Rb = (R & ~31) + perm32(R & 31);
        voffA[i] = (unsigned)(R * K + C) * 2u; voffB[i] = (unsigned)(Rb * K + C) * 2u; }
    const size_t kstep = (size_t)(BK * 2);
    const size_t hstep = (size_t)HALF * K * 2;
    const size_t tstep = 2 * hstep;
    const unsigned ldsw = (unsigned)wid * 1024u;
    const int aoff = lds_byte(wr * 64 + fr, fq * 8), boff = lds_byte(wc * 32 + fr, fq * 8);
#define PG8_SA(b, h) (((b) * 2 + (h)) * HTB)
#define PG8_SB(b, h) ((4 + (b) * 2 + (h)) * HTB)
#define PG8_STAGE(bufoff, gbase, voff) do { _Pragma("unroll") for (int _i = 0; _i < 2; ++_i) \
        __builtin_amdgcn_global_load_lds((const unsigned*)((const char*)(gbase) + (voff)[_i]), (LAS unsigned*)(lds + (bufoff) + ldsw + _i * 8192), 16, 0, 0); } while (0)
#define PG8_LDA(dst, b, h) do { _Pragma("unroll") for (int m = 0; m < 4; ++m) _Pragma("unroll") for (int k = 0; k < 2; ++k) dst[m][k] = *(const LAS h16x8*)(lds + PG8_SA(b, h) + aoff + m * 2048 + k * 1024); } while (0)
#define PG8_LDB(dst, b, h) do { _Pragma("unroll") for (int n = 0; n < 2; ++n) _Pragma("unroll") for (int k = 0; k < 2; ++k) dst[n][k] = *(const LAS h16x8*)(lds + PG8_SB(b, h) + boff + n * 2048 + k * 1024); } while (0)
#define PG8_MMA(ai, bj, At, Bt) do { __builtin_amdgcn_s_setprio(1); _Pragma("unroll") for (int m = 0; m < 4; ++m) _Pragma("unroll") for (int n = 0; n < 2; ++n) _Pragma("unroll") for (int k = 0; k < 2; ++k) \
        acc[ai][bj][m][n] = __builtin_amdgcn_mfma_f32_16x16x32_f16(Bt[n][k], At[m][k], acc[ai][bj][m][n], 0, 0, 0); __builtin_amdgcn_s_setprio(0); } while (0)
#define PG8_WAIT_V(n) asm volatile("s_waitcnt vmcnt(" #n ")" ::: "memory")
#define PG8_WAIT_L(n) asm volatile("s_waitcnt lgkmcnt(" #n ")" ::: "memory")
#define PG8_BAR __builtin_amdgcn_s_barrier()
#define PG8_SCHED __builtin_amdgcn_sched_barrier(0)
    Unit cur, nxt; int ui = 0;
    if (!S.next(0, cur)) return;
    f32x4 acc[2][2][4][2];
#pragma unroll
    for (int a = 0; a < 2; ++a)
#pragma unroll
        for (int b = 0; b < 2; ++b)
#pragma unroll
            for (int m = 0; m < 4; ++m)
#pragma unroll
                for (int n = 0; n < 2; ++n) acc[a][b][m][n] = (f32x4){0.f, 0.f, 0.f, 0.f};
    h16x8 At[4][2], B0[2][2], B1[2][2];
    const char* cA = (const char*)g.A + (size_t)cur.pm * tstep; const char* cB = (const char*)g.Bt + (size_t)cur.pn * tstep;
    S.a_ready(cur);
    if constexpr (SP2) {
        PG8_STAGE(PG8_SB(0, 0), cB, voffB); PG8_STAGE(PG8_SB(0, 1), cB + hstep, voffB); PG8_STAGE(PG8_SA(0, 0), cA, voffA); PG8_STAGE(PG8_SA(0, 1), cA + hstep, voffA);
        if (wr == 1) PG8_BAR;
        PG8_WAIT_V(2); PG8_BAR;
        PG8_STAGE(PG8_SB(1, 0), cB + kstep, voffB); PG8_STAGE(PG8_SA(1, 0), cA + kstep, voffA); PG8_STAGE(PG8_SB(1, 1), cB + hstep + kstep, voffB);
        PG8_WAIT_V(6); PG8_BAR;
    } else {
        PG8_STAGE(PG8_SB(0, 0), cB, voffB); PG8_STAGE(PG8_SA(0, 0), cA, voffA); PG8_STAGE(PG8_SB(0, 1), cB + hstep, voffB); PG8_STAGE(PG8_SA(0, 1), cA + hstep, voffA);
        if (wr == 1) PG8_BAR;
        PG8_WAIT_V(4); PG8_BAR;
        PG8_STAGE(PG8_SB(1, 0), cB + kstep, voffB); PG8_STAGE(PG8_SA(1, 0), cA + kstep, voffA); PG8_STAGE(PG8_SB(1, 1), cB + hstep + kstep, voffB);
        PG8_WAIT_V(6); PG8_BAR;
    }
    for (;;) {
        const bool has_next = S.next(ui + 1, nxt);
        const char* nA = has_next ? (const char*)g.A + (size_t)nxt.pm * tstep : cA; const char* nB = has_next ? (const char*)g.Bt + (size_t)nxt.pn * tstep : cB;
        for (int t = 0; t < nt; t += 2) {
            const bool last = (t == nt - 2);
            const char* a1 = cA + (size_t)(t + 1) * kstep;
            const char* a2 = last ? nA : cA + (size_t)(t + 2) * kstep; const char* b2 = last ? nB : cB + (size_t)(t + 2) * kstep;
            const char* a3 = a2 + kstep; const char* b3 = b2 + kstep;
            if (last && has_next) S.a_ready(nxt);
            if constexpr (SP2) {
            PG8_LDB(B0, 0, 0); PG8_LDB(B1, 0, 1); PG8_SCHED; PG8_LDA(At, 0, 0); PG8_STAGE(PG8_SA(1, 1), a1 + hstep, voffA);
            PG8_WAIT_V(8); PG8_WAIT_L(0); PG8_BAR; PG8_MMA(0, 0, At, B0); PG8_MMA(0, 1, At, B1); PG8_BAR; PG8_SCHED;
            PG8_LDA(At, 0, 1); PG8_STAGE(PG8_SB(0, 0), b2, voffB); PG8_STAGE(PG8_SB(0, 1), b2 + hstep, voffB); PG8_STAGE(PG8_SA(0, 0), a2, voffA);
            PG8_WAIT_V(8); PG8_WAIT_L(0); PG8_BAR; PG8_MMA(1, 0, At, B0); PG8_MMA(1, 1, At, B1); PG8_BAR; PG8_SCHED;
            PG8_LDB(B0, 1, 0); PG8_LDB(B1, 1, 1); PG8_SCHED; PG8_LDA(At, 1, 0); PG8_STAGE(PG8_SA(0, 1), a2 + hstep, voffA);
            PG8_WAIT_V(8); PG8_WAIT_L(0); PG8_BAR; PG8_MMA(0, 0, At, B0); PG8_MMA(0, 1, At, B1); PG8_BAR; PG8_SCHED;
            PG8_LDA(At, 1, 1); PG8_STAGE(PG8_SB(1, 0), b3, voffB); PG8_STAGE(PG8_SB(1, 1), b3 + hstep, voffB); PG8_STAGE(PG8_SA(1, 0), a3, voffA);
            PG8_WAIT_V(8); PG8_WAIT_L(0); PG8_BAR; PG8_MMA(1, 0, At, B0); PG8_MMA(1, 1, At, B1); PG8_BAR; PG8_SCHED;
            } else {
            PG8_LDB(B0, 0, 0); PG8_SCHED; PG8_LDA(At, 0, 0); PG8_STAGE(PG8_SA(1, 1), a1 + hstep, voffA);
            PG8_WAIT_L(8); PG8_BAR; PG8_WAIT_L(0); PG8_MMA(0, 0, At, B0); PG8_BAR; PG8_SCHED;
            PG8_LDB(B1, 0, 1); PG8_STAGE(PG8_SB(0, 0), b2, voffB);
            PG8_BAR; PG8_WAIT_L(0); PG8_MMA(0, 1, At, B1); PG8_BAR;
            PG8_LDA(At, 0, 1); PG8_STAGE(PG8_SA(0, 0), a2, voffA);
            PG8_BAR; PG8_WAIT_L(0); PG8_MMA(1, 0, At, B0); PG8_BAR; PG8_SCHED;
            PG8_STAGE(PG8_SB(0, 1), b2 + hstep, voffB);
            PG8_WAIT_V(6); PG8_BAR; PG8_MMA(1, 1, At, B1); PG8_BAR;
            PG8_LDB(B0, 1, 0); PG8_SCHED; PG8_LDA(At, 1, 0); PG8_STAGE(PG8_SA(0, 1), a2 + hstep, voffA);
            PG8_WAIT_L(8); PG8_BAR; PG8_WAIT_L(0); PG8_MMA(0, 0, At, B0); PG8_BAR; PG8_SCHED;
            PG8_LDB(B1, 1, 1); PG8_STAGE(PG8_SB(1, 0), b3, voffB);
            PG8_BAR; PG8_WAIT_L(0); PG8_MMA(0, 1, At, B1); PG8_BAR;
            PG8_LDA(At, 1, 1); PG8_STAGE(PG8_SA(1, 0), a3, voffA);
            PG8_BAR; PG8_WAIT_L(0); PG8_MMA(1, 0, At, B0); PG8_BAR; PG8_SCHED;
            PG8_STAGE(PG8_SB(1, 1), b3 + hstep, voffB);
            PG8_WAIT_V(6); PG8_BAR; PG8_MMA(1, 1, At, B1); PG8_BAR;
            }
        }
        if constexpr (ALIGN_EPI) { if (wr == 0) PG8_BAR; }
        E(acc, cur, wr, wc, fr, fq); S.done(cur);
        if (!has_next) break;
#pragma unroll
        for (int a = 0; a < 2; ++a)
#pragma unroll
            for (int b = 0; b < 2; ++b)
#pragma unroll
                for (int m = 0; m < 4; ++m)
#pragma unroll
                    for (int n = 0; n < 2; ++n) acc[a][b][m][n] = (f32x4){0.f, 0.f, 0.f, 0.f};
        cur = nxt; cA = nA; cB = nB; ++ui;
        if constexpr (ALIGN_EPI) { if (wr == 1) PG8_BAR; }
    }
    PG8_WAIT_V(0);
    if constexpr (!ALIGN_EPI) { if (wr == 0) PG8_BAR; }
    PG8_BAR;
#undef PG8_SA
#undef PG8_SB
#undef PG8_STAGE
#undef PG8_LDA
#undef PG8_LDB
#undef PG8_MMA
#undef PG8_WAIT_V
#undef PG8_WAIT_L
#undef PG8_BAR
#undef PG8_SCHED
}
}

#define EPI_ROWS _Pragma("unroll") for (int ai = 0; ai < 2; ++ai) _Pragma("unroll") for (int m = 0; m < 4; ++m)
#define EPI_BJ _Pragma("unroll") for (int bj = 0; bj < 2; ++bj)
__device__ __forceinline__ void ld_h8(const h16* p, f32x4& a, f32x4& b) { const u32x4 w = *(const u32x4*)p; const h16x8 h = __builtin_bit_cast(h16x8, w);
    a = (f32x4){(float)h[0], (float)h[1], (float)h[2], (float)h[3]}; b = (f32x4){(float)h[4], (float)h[5], (float)h[6], (float)h[7]}; }
__device__ __forceinline__ float ssq8(const f32x4& v0, const f32x4& v1) { return ((v0[0] * v0[0] + v0[1] * v0[1]) + (v0[2] * v0[2] + v0[3] * v0[3])) + ((v1[0] * v1[0] + v1[1] * v1[1]) + (v1[2] * v1[2] + v1[3] * v1[3])); }

struct EpiInProj {
    const float* rs1; h16* AQ; h16* AK; h16* AV; h16* BQ; float* RAW4; h16* IQ; h16* GATES; const float* bg;
    __device__ __forceinline__ void operator()(const f32x4 (&acc)[2][2][4][2], const pg8::Unit& u, int wr, int wc, int fr, int fq) const {
        const int pn = u.pn, row0 = u.pm * 256 + wr * 64 + fr, ct = wc * 32 + 8 * fq;
        if (pn >= 6) {
            const int gc0 = (pn - 6) * 256 + ct;
            f32x4 b[2][2];
            EPI_BJ { b[bj][0] = *(const f32x4*)(bg + gc0 + bj * 128); b[bj][1] = *(const f32x4*)(bg + gc0 + bj * 128 + 4); }
            EPI_ROWS { const int row = row0 + ai * 128 + m * 16; const float s = rs1[row]; h16* rp = GATES + (size_t)row * 2048 + gc0;
                EPI_BJ { f32x4 v0 = acc[ai][bj][m][0] * s + b[bj][0], v1 = acc[ai][bj][m][1] * s + b[bj][1];
                    _Pragma("unroll") for (int e = 0; e < 4; ++e) { v0[e] = sigmoidf_fast(v0[e]); v1[e] = sigmoidf_fast(v1[e]); }
                    *(u32x4*)(rp + bj * 128) = pk_h8(v0, v1); } }
        } else if (pn == 4) {
            EPI_ROWS { const int row = row0 + ai * 128 + m * 16; const float s = rs1[row]; float* rp = RAW4 + (size_t)row * 256 + ct;
                EPI_BJ { *(f32x4*)(rp + bj * 128) = acc[ai][bj][m][0] * s; *(f32x4*)(rp + bj * 128 + 4) = acc[ai][bj][m][1] * s; } }
        } else if (pn == 2) {
            EPI_ROWS { const int row = row0 + ai * 128 + m * 16; const float s = rs1[row]; const size_t prow = (size_t)(row >> 11) * P + BLK + (row & 2047);
                *(u32x4*)(AK + prow * 128 + ct) = pk_h8(acc[ai][0][m][0] * s, acc[ai][0][m][1] * s);
                *(u32x4*)(AV + prow * 128 + ct) = pk_h8(acc[ai][1][m][0] * s, acc[ai][1][m][1] * s); }
        } else {
            h16* base = pn < 2 ? AQ + pn * 256 : (pn == 3 ? BQ : IQ); const int ld = pn < 2 ? 512 : 256;
            EPI_ROWS { const int row = row0 + ai * 128 + m * 16; const float s = rs1[row]; h16* rp = base + (size_t)row * ld + ct;
                EPI_BJ *(u32x4*)(rp + bj * 128) = pk_h8(acc[ai][bj][m][0] * s, acc[ai][bj][m][1] * s); }
        }
    }
};
struct EpiH16 {
    h16* O; int ldc;
    __device__ __forceinline__ void operator()(const f32x4 (&acc)[2][2][4][2], const pg8::Unit& u, int wr, int wc, int fr, int fq) const {
        const int row0 = u.pm * 256 + wr * 64 + fr, col0 = u.pn * 256 + wc * 32 + 8 * fq;
        EPI_ROWS { const int row = row0 + ai * 128 + m * 16; h16* rp = O + (size_t)row * ldc + col0;
            EPI_BJ *(u32x4*)(rp + bj * 128) = pk_h8(acc[ai][bj][m][0], acc[ai][bj][m][1]); }
    }
};
template <bool ACCUM> struct EpiGate {
    const h16* G; h16* O;
    __device__ __forceinline__ void operator()(const f32x4 (&acc)[2][2][4][2], const pg8::Unit& u, int wr, int wc, int fr, int fq) const {
        const int row0 = u.pm * 256 + wr * 64 + fr, col0 = u.pn * 256 + wc * 32 + 8 * fq;
        EPI_ROWS { const int row = row0 + ai * 128 + m * 16; const h16* gp = G + (size_t)row * 2048 + col0; h16* rp = O + (size_t)row * 1024 + col0;
            EPI_BJ { f32x4 g0, g1; ld_h8(gp + bj * 128, g0, g1); f32x4 v0 = acc[ai][bj][m][0] * g0, v1 = acc[ai][bj][m][1] * g1;
                if (ACCUM) { f32x4 t0, t1; ld_h8(rp + bj * 128, t0, t1); v0 += t0; v1 += t1; }
                *(u32x4*)(rp + bj * 128) = pk_h8(v0, v1); } }
    }
};
struct EpiWo {
    const float* x; h16* H1; float* SSQ;
    __device__ __forceinline__ void operator()(const f32x4 (&acc)[2][2][4][2], const pg8::Unit& u, int wr, int wc, int fr, int fq) const {
        const int row0 = u.pm * 256 + wr * 64 + fr, col0 = u.pn * 256 + wc * 32 + 8 * fq;
        EPI_ROWS { const int row = row0 + ai * 128 + m * 16; const float* xp = x + (size_t)row * 1024 + col0; h16* rp = H1 + (size_t)row * 1024 + col0; float q = 0.f;
            EPI_BJ { const f32x4 v0 = acc[ai][bj][m][0] + *(const f32x4*)(xp + bj * 128), v1 = acc[ai][bj][m][1] + *(const f32x4*)(xp + bj * 128 + 4);
                q += ssq8(v0, v1); *(u32x4*)(rp + bj * 128) = pk_h8(v0, v1); }
            q += __shfl_xor(q, 16); q += __shfl_xor(q, 32);
            if (fq == 0) SSQ[(size_t)row * 16 + u.pn * 4 + wc] = q; }
    }
};
__device__ __forceinline__ float row_rs16(const float* ssq_row) {
    const f32x4* sp = (const f32x4*)ssq_row; const f32x4 s0 = sp[0], s1 = sp[1], s2 = sp[2], s3 = sp[3];
    const float ss = (((s0[0] + s0[1]) + (s0[2] + s0[3])) + ((s1[0] + s1[1]) + (s1[2] + s1[3]))) + (((s2[0] + s2[1]) + (s2[2] + s2[3])) + ((s3[0] + s3[1]) + (s3[2] + s3[3])));
    return __builtin_amdgcn_rsqf(ss * (1.0f / 1024.0f) + EPS);
}
struct EpiSwiGLU {
    const float* SSQ; h16* ACT;
    __device__ __forceinline__ void operator()(const f32x4 (&acc)[2][2][4][2], const pg8::Unit& u, int wr, int wc, int fr, int fq) const {
        const int row0 = u.pm * 256 + wr * 64 + fr, col0 = u.pn * 128 + wc * 32 + 8 * fq;
        EPI_ROWS { const int row = row0 + ai * 128 + m * 16; const float rs = row_rs16(SSQ + (size_t)row * 16);
            f32x4 o[2];
            _Pragma("unroll") for (int n = 0; n < 2; ++n)
                _Pragma("unroll") for (int e = 0; e < 4; ++e) { const float g = acc[ai][0][m][n][e] * rs, up = acc[ai][1][m][n][e] * rs; o[n][e] = g * sigmoidf_fast(g) * up; }
            *(u32x4*)(ACT + (size_t)row * DFF + col0) = pk_h8(o[0], o[1]); }
    }
};
struct EpiDown {
    const h16* H1; float* OUT; float* SSQ;
    __device__ __forceinline__ void operator()(const f32x4 (&acc)[2][2][4][2], const pg8::Unit& u, int wr, int wc, int fr, int fq) const {
        const int row0 = u.pm * 256 + wr * 64 + fr, col0 = u.pn * 256 + wc * 32 + 8 * fq;
        EPI_ROWS { const int row = row0 + ai * 128 + m * 16; const h16* hp = H1 + (size_t)row * 1024 + col0; float* rp = OUT + (size_t)row * 1024 + col0; float q = 0.f;
            EPI_BJ { f32x4 h0, h1; ld_h8(hp + bj * 128, h0, h1); const f32x4 v0 = acc[ai][bj][m][0] + h0, v1 = acc[ai][bj][m][1] + h1;
                q += ssq8(v0, v1); *(f32x4*)(rp + bj * 128) = v0; *(f32x4*)(rp + bj * 128 + 4) = v1; }
            q += __shfl_xor(q, 16); q += __shfl_xor(q, 32);
            if (fq == 0) SSQ[(size_t)row * 16 + u.pn * 4 + wc] = q; }
    }
};

constexpr size_t MiB = 1u << 20;
constexpr size_t WS_CTL = 0, CTL_ZERO_BYTES = 65536;
constexpr size_t WS_WIN = 2 * MiB, WS_WQABS = 9 * MiB, WS_WA = 10 * MiB, WS_WUVB = 11 * MiB, WS_WO = 13 * MiB, WS_WGU = 15 * MiB, WS_WD = 26 * MiB;
constexpr size_t WS_RS1 = 32 * MiB, WS_RSQ = WS_RS1 + 256 * 1024, WS_IWS = 33 * MiB, WS_SSQ1 = 34 * MiB, WS_SSQ2 = 38 * MiB, WS_METAP = 42 * MiB, WS_TBL = WS_METAP + 512 * 1024;
constexpr size_t KVROWS = (size_t)BATCH * P;
constexpr size_t WS_AK = 44 * MiB, WS_AV = 61 * MiB, WS_CKV = 78 * MiB, WS_IKN = 95 * MiB;
constexpr size_t WS_OA = 104 * MiB, WS_GATES = 168 * MiB;
constexpr size_t WS_AQ = 424 * MiB, WS_BQ = 488 * MiB, WS_IQ = 520 * MiB, WS_H1 = 424 * MiB;
constexpr size_t WS_XH = 552 * MiB, WS_MIXED = 552 * MiB, WS_QABS = 680 * MiB, WS_RAW4 = 808 * MiB, WS_LAT = 808 * MiB, WS_ACT = 552 * MiB, WS_END = 936 * MiB;
static_assert(WS_WIN + (size_t)DINP * D * 2 <= WS_WQABS && WS_WGU + (size_t)NGU * D * 2 <= WS_WD && WS_WD + (size_t)D * DFF * 2 <= WS_RS1, "weights map");
static_assert(WS_AK + KVROWS * 256 <= WS_AV && WS_CKV + KVROWS * 256 <= WS_IKN && WS_IKN + KVROWS * 128 <= WS_OA, "kv map");
static_assert(WS_ACT + (size_t)M * DFF * 2 <= WS_END && WS_LAT + (size_t)M * 1024 * 2 <= WS_END && WS_TBL + 16 * 132 * 4 <= WS_AK, "act map");
constexpr int CW_TMO = 0, CW_BAR = 4096;
constexpr int TBLW = 132;

constexpr int RING_OFF = 0, RING_BYTES = 131072;
constexpr int LDSCTL_OFF = RING_BYTES, MISC_OFF = LDSCTL_OFF + 320;
constexpr int LDS_BYTES = 147456;
constexpr int NWAVES = 8;

#define RLX_AGENT __ATOMIC_RELAXED, __HIP_MEMORY_SCOPE_AGENT
#define LDS_WAIT() asm volatile("s_waitcnt lgkmcnt(0)" ::: "memory")
#define VM_WAIT() asm volatile("s_waitcnt vmcnt(0)" ::: "memory")

#define XB_TMO      128
#define XB_XCNT(j)  (256  + 64 * (j))
#define XB_XSUB(j)  (1280 + 64 * (j))
#define XB_XGEN(j)  (2304 + 64 * (j))
#define XB_TOP      3328
#define XB_TOPGEN   3392
#define XCD_BAR_WORDS 3456
#define XB_SPIN_CAP (1u << 18)
__device__ __forceinline__ unsigned xb_ld(unsigned* p)              { return __hip_atomic_load(p, __ATOMIC_RELAXED, __HIP_MEMORY_SCOPE_AGENT); }
__device__ __forceinline__ unsigned xb_add(unsigned* p, unsigned v) { return __hip_atomic_fetch_add(p, v, __ATOMIC_RELAXED, __HIP_MEMORY_SCOPE_AGENT); }
__device__ __forceinline__ unsigned xb_xcc_id() { return (unsigned)__builtin_amdgcn_s_getreg((3 << 11) | 20) & 0xFu; }
#define XB_SPIN(cond, bar) do { unsigned _sp = 0; while (cond) { __builtin_amdgcn_s_sleep(1); \
    if ((++_sp & 255u) == 0u) { if (xb_ld(&(bar)[XB_TMO])) break; if (_sp > XB_SPIN_CAP) { atomicAdd(&(bar)[XB_TMO], 1u); break; } } } } while (0)
struct XcdBarrier { unsigned* bar; unsigned x; volatile LAS unsigned* st; };
__device__ __forceinline__ XcdBarrier xcd_barrier_post(unsigned* bar, volatile LAS unsigned* st) {
    XcdBarrier b; b.bar = bar; b.x = xb_xcc_id(); b.st = st;
    if (threadIdx.x == 0) (void)xb_add(&bar[XB_XCNT(b.x)], 1u);
    return b;
}
__device__ __forceinline__ void xcd_barrier_complete(unsigned* bar, unsigned x, unsigned& nloc, unsigned& nx) {
    const unsigned G = gridDim.x * gridDim.y * gridDim.z;
    unsigned sum, cnt, mine, sp = 0u;
    for (;;) {
        sum = 0u; cnt = 0u; mine = 0u;
#pragma unroll
        for (unsigned j = 0; j < 16; ++j) { const unsigned c = xb_ld(&bar[XB_XCNT(j)]); sum += c; cnt += (c > 0u) ? 1u : 0u; mine = (j == x) ? c : mine; }
        if (sum == G) break;
        __builtin_amdgcn_s_sleep(1);
        if ((++sp & 255u) == 0u) { if (xb_ld(&bar[XB_TMO])) break; if (sp > XB_SPIN_CAP) { atomicAdd(&bar[XB_TMO], 1u); break; } }
    }
    nloc = mine > 0u ? mine : 1u; nx = cnt > 0u ? cnt : 1u;
}
__device__ __forceinline__ void xcd_barrier(const XcdBarrier& b) {
    asm volatile("s_waitcnt vmcnt(0)" ::: "memory");
    __syncthreads();
    if (threadIdx.x == 0) {
        unsigned* bar = b.bar;
        __builtin_amdgcn_s_waitcnt(0);
        unsigned nloc = b.st[0], nx = b.st[1];
        if (nloc == 0u) { xcd_barrier_complete(bar, b.x, nloc, nx); b.st[0] = nloc; b.st[1] = nx; }
        const unsigned old = xb_add(&bar[XB_XSUB(b.x)], 1u);
        const unsigned gen = old / nloc;
        if (old + 1u == (gen + 1u) * nloc) {
            __builtin_amdgcn_fence(__ATOMIC_RELEASE, "agent");
            asm volatile("s_waitcnt vmcnt(0)" ::: "memory");
            const unsigned og = xb_add(&bar[XB_TOP], 1u);
            const unsigned tg = og / nx;
            if (og + 1u == (tg + 1u) * nx) xb_add(&bar[XB_TOPGEN], 1u);
            else XB_SPIN(xb_ld(&bar[XB_TOPGEN]) == tg, bar);
            __builtin_amdgcn_fence(__ATOMIC_ACQUIRE, "agent");
            xb_add(&bar[XB_XGEN(b.x)], 1u);
            asm volatile("s_waitcnt vmcnt(0)" ::: "memory");
        } else {
            XB_SPIN(xb_ld(&bar[XB_XGEN(b.x)]) == gen, bar);
            __builtin_amdgcn_fence(__ATOMIC_ACQUIRE, "agent");
            asm volatile("s_waitcnt vmcnt(0)" ::: "memory");
        }
    }
    __syncthreads();
}

struct Frame {
    LAS unsigned char* lds;
    int tid, lane, wave, vcu, G;
    const float *x, *meta, *g1, *w_in, *bg, *qg, *kvg, *w_uq, *w_uk, *w_uv, *lng, *lnb, *sinks, *relb, *w_a, *w_b, *w_o, *g2, *w_g, *w_u, *w_d, *gf;
    float* out;
    h16 *Win_t, *Wqabs_t, *Wa_t, *Wuvb_t, *Wo_t, *Wgu_t, *Wd_t;
    float *RS1, *RSQ, *IWS, *SSQ1, *SSQ2, *METAP, *TBL, *RAW4;
    h16 *AK, *AV, *CKV, *IKN, *OA, *GATES, *AQ, *BQ, *IQ, *H1, *XH, *MIXED, *QABS, *LAT, *ACT;
};
__device__ __forceinline__ float wave_sum(float v) {
#pragma unroll
    for (int o = 1; o < 64; o <<= 1) v += __shfl_xor(v, o);
    return v;
}

__device__ __forceinline__ int inmap(int n) {
    if (n < 1152) return n;
    if (n < 1216) return 1408 + (n - 1152);
    if (n < 1220) return 1472 + (n - 1216);
    if (n < 1280) return -1;
    if (n < 1536) return 1152 + (n - 1280);
    return 1476 + (n - 1536);
}
template <int MODE> __device__ __forceinline__ void p0_transpose_item(const float* W, const float* W2, int ldw, int K, int N, const float* gain, h16* WT, LAS float* scr, int item, int lane) {
    const int nblk = N / 32, kb = item / nblk, nb = item % nblk, k0 = 64 * kb, n0 = 32 * nb, n = n0 + (lane & 31);
    const float* src = W; int oc = n; float cs = 1.f;
    if (MODE == 0) { oc = inmap(n); if (n < 512) cs = QSCALE; }
    if (MODE == 3) { const int pp = n >> 8, j = n & 255; oc = 128 * pp + (j & 127); src = (j < 128) ? W : W2; }
#pragma unroll 8
    for (int i = 0; i < 32; ++i) { const int kk = 2 * i + (lane >> 5); float v = 0.f; if (oc >= 0) v = src[(size_t)(k0 + kk) * ldw + oc]; if (gain) v *= gain[k0 + kk]; scr[kk * 33 + (lane & 31)] = v * cs; }
    LDS_WAIT(); asm volatile("" ::: "memory");
    const int c = lane & 7;
#pragma unroll
    for (int j = 0; j < 4; ++j) { const int nn = (lane >> 3) + 8 * j; const LAS float* s = scr + (8 * c) * 33 + nn;
        u32x4 o; o.x = pk_h2(s[0 * 33], s[1 * 33]); o.y = pk_h2(s[2 * 33], s[3 * 33]); o.z = pk_h2(s[4 * 33], s[5 * 33]); o.w = pk_h2(s[6 * 33], s[7 * 33]);
        *(u32x4*)(WT + (size_t)(n0 + nn) * K + k0 + 8 * c) = o; }
    LDS_WAIT(); asm volatile("" ::: "memory");
}
__device__ __forceinline__ int t5_bucket_d(int dist) {
    if (dist < 16) return dist;
    int large = 16 + (int)(log((double)dist / 16.0) / log(8.0) * 16.0);
    return large < 31 ? large : 31;
}
__device__ __forceinline__ void p0_prologue(Frame& F) {
    LAS float* scr = (LAS float*)(F.lds + RING_OFF + F.wave * 16384);
    const int gw = F.vcu * NWAVES + F.wave, NGW = F.G * NWAVES, lane = F.lane;
    constexpr int I_IN = (D / 64) * (DINP / 32), I_A = (512 / 64) * (D / 32), I_O = (D / 64) * (D / 32), I_GU = (D / 64) * (NGU / 32), I_D = (DFF / 64) * (D / 32);
    constexpr int I_QABS = 1024 * 4, I_UVB = 1024 * 8 * 2, I_META = 7 * 8, I_TBL = 1;
    constexpr int NITEMS = I_IN + I_A + I_O + I_GU + I_D + I_QABS + I_UVB + I_META + I_TBL;
    for (int it = gw; it < NITEMS; it += NGW) {
        int r = it;
        if (r < I_IN) { p0_transpose_item<0>(F.w_in, nullptr, DIN, D, DINP, F.g1, F.Win_t, scr, r, lane); continue; } r -= I_IN;
        if (r < I_A) { p0_transpose_item<1>(F.w_a, nullptr, D, 512, D, nullptr, F.Wa_t, scr, r, lane); continue; } r -= I_A;
        if (r < I_O) { p0_transpose_item<1>(F.w_o, nullptr, D, D, D, nullptr, F.Wo_t, scr, r, lane); continue; } r -= I_O;
        if (r < I_GU) { p0_transpose_item<3>(F.w_g, F.w_u, DFF, D, NGU, F.g2, F.Wgu_t, scr, r, lane); continue; } r -= I_GU;
        if (r < I_D) { p0_transpose_item<1>(F.w_d, nullptr, D, DFF, D, nullptr, F.Wd_t, scr, r, lane); continue; } r -= I_D;
        if (r < I_QABS) {
            const int n = r >> 2, rr = (r & 3) * 64 + lane, h = n >> 7, c = n & 127;
            const f32x4* uq = (const f32x4*)(F.w_uq + (size_t)rr * 512 + h * 64); const f32x4* uk = (const f32x4*)(F.w_uk + (size_t)c * 512 + h * 64);
            float a = 0.f;
#pragma unroll 4
            for (int d = 0; d < 16; ++d) { const f32x4 p = uq[d], q = uk[d]; a += (p[0] * q[0] + p[1] * q[1]) + (p[2] * q[2] + p[3] * q[3]); }
            F.Wqabs_t[(size_t)n * 256 + rr] = __builtin_bit_cast(h16, (_Float16)(a * QSCALE * F.qg[rr]));
            continue; } r -= I_QABS;
        if (r < I_UVB) {
            const int n = r >> 4, h = (r >> 1) & 7, c = (r & 1) * 64 + lane;
            const f32x4* uv = (const f32x4*)(F.w_uv + (size_t)c * 512 + h * 64); const float* wb = F.w_b + (size_t)(h * 64) * 1024 + n;
            float a = 0.f;
#pragma unroll 4
            for (int d = 0; d < 16; ++d) { const f32x4 p = uv[d]; a += (p[0] * wb[(size_t)(4 * d) * 1024] + p[1] * wb[(size_t)(4 * d + 1) * 1024]) + (p[2] * wb[(size_t)(4 * d + 2) * 1024] + p[3] * wb[(size_t)(4 * d + 3) * 1024]); }
            F.Wuvb_t[(size_t)n * 1024 + h * 128 + c] = __builtin_bit_cast(h16, (_Float16)a);
            continue; } r -= I_UVB;
        if (r < I_META) {
            const int cg = r >> 3, kc = r & 7, ci = cg * 64 + lane;
            const int oc = ci < 128 ? 512 + ci : (ci < 256 ? 640 + (ci - 128) : (ci < 384 ? 1024 + (ci - 256) : 1408 + (ci - 384)));
            float a[16];
#pragma unroll
            for (int q = 0; q < 16; ++q) a[q] = 0.f;
            for (int k = kc * 128; k < kc * 128 + 128; ++k) { const float w = F.w_in[(size_t)k * DIN + oc] * F.g1[k];
#pragma unroll
                for (int q = 0; q < 16; ++q) a[q] += F.meta[q * 1024 + k] * w; }
#pragma unroll
            for (int q = 0; q < 16; ++q) F.METAP[(size_t)(kc * 16 + q) * 448 + ci] = a[q];
            continue; } r -= I_META;
        {
            for (int e = lane; e < 16 * 129; e += 64) { const int hh = e / 129, dd = e % 129; F.TBL[hh * TBLW + dd] = LOG2E * F.relb[t5_bucket_d(dd) * 16 + hh]; }
        }
    }
    for (int row = gw; row < M; row += NGW) {
        const f32x4* xr = (const f32x4*)(F.x + (size_t)row * D) + lane; f32x4 v[4]; float s = 0.f;
#pragma unroll
        for (int j = 0; j < 4; ++j) { v[j] = xr[64 * j]; s += (v[j][0] * v[j][0] + v[j][1] * v[j][1]) + (v[j][2] * v[j][2] + v[j][3] * v[j][3]); }
        s = wave_sum(s);
        if (lane == 0) F.RS1[row] = 1.0f / sqrtf(s * (1.0f / D) + EPS);
        u32x2* o8 = (u32x2*)(F.XH + (size_t)row * D) + lane;
#pragma unroll
        for (int j = 0; j < 4; ++j) { u32x2 w; w.x = pk_h2(v[j][0], v[j][1]); w.y = pk_h2(v[j][2], v[j][3]); o8[64 * j] = w; }
    }
}

__device__ __forceinline__ void p2_norms(Frame& F) {
    const int gw = F.vcu * NWAVES + F.wave, NGW = F.G * NWAVES, lane = F.lane;
    const float kg0 = F.kvg[2 * lane], kg1 = F.kvg[2 * lane + 1], lg = F.lng[lane], lb = F.lnb[lane];
    for (int row = gw; row < M; row += NGW) {
        const float* rw = F.RAW4 + (size_t)row * 256; const size_t prow = (size_t)(row >> 11) * P + BLK + (row & 2047);
        const float b0 = rw[2 * lane], b1 = rw[2 * lane + 1], ik = rw[128 + lane];
        const float rk = 1.0f / sqrtf(wave_sum(b0 * b0 + b1 * b1) * (1.0f / 128.0f) + EPS);
        ((unsigned*)(F.CKV + prow * 128))[lane] = pk_h2(b0 * rk * kg0, b1 * rk * kg1);
        const float mu = wave_sum(ik) * (1.0f / 64.0f), dc = ik - mu, var = wave_sum(dc * dc) * (1.0f / 64.0f);
        F.IKN[prow * 64 + lane] = __builtin_bit_cast(h16, (_Float16)(dc * (1.0f / sqrtf(var + EPS)) * lg + lb));
        if (lane < 4) F.IWS[(size_t)row * 4 + lane] = rw[192 + lane] * 0.0625f;
        const u32x2 qw = ((const u32x2*)(F.BQ + (size_t)row * 256))[lane]; const h16x4 qh = __builtin_bit_cast(h16x4, qw);
        const float q0 = (float)qh[0], q1 = (float)qh[1], q2 = (float)qh[2], q3 = (float)qh[3];
        const float sq = wave_sum((q0 * q0 + q1 * q1) + (q2 * q2 + q3 * q3));
        if (lane == 0) F.RSQ[row] = 1.0f / sqrtf(sq * (1.0f / 256.0f) + EPS);
    }
    if (gw < 16) {
        const int r = gw; float s = 0.f;
        for (int k = lane; k < 1024; k += 64) { const float v = F.meta[r * 1024 + k]; s += v * v; }
        const float rsm = 1.0f / sqrtf(wave_sum(s) * (1.0f / D) + EPS);
        float v[7];
#pragma unroll
        for (int cg = 0; cg < 7; ++cg) { float a = 0.f;
#pragma unroll
            for (int kc = 0; kc < 8; ++kc) a += F.METAP[(size_t)(kc * 16 + r) * 448 + cg * 64 + lane];
            v[cg] = a * rsm; }
        const float rk = 1.0f / sqrtf(wave_sum(v[4] * v[4] + v[5] * v[5]) * (1.0f / 128.0f) + EPS);
        const float c0 = v[4] * rk * F.kvg[lane], c1 = v[5] * rk * F.kvg[64 + lane];
        const float mu = wave_sum(v[6]) * (1.0f / 64.0f), dc = v[6] - mu, var = wave_sum(dc * dc) * (1.0f / 64.0f);
        const float ikn = dc * (1.0f / sqrtf(var + EPS)) * lg + lb;
        for (int b = 0; b < BATCH; ++b) { const size_t prow = (size_t)b * P + NPAD + r;
            F.AK[prow * 128 + lane] = __builtin_bit_cast(h16, (_Float16)v[0]); F.AK[prow * 128 + 64 + lane] = __builtin_bit_cast(h16, (_Float16)v[1]);
            F.AV[prow * 128 + lane] = __builtin_bit_cast(h16, (_Float16)v[2]); F.AV[prow * 128 + 64 + lane] = __builtin_bit_cast(h16, (_Float16)v[3]);
            F.CKV[prow * 128 + lane] = __builtin_bit_cast(h16, (_Float16)c0); F.CKV[prow * 128 + 64 + lane] = __builtin_bit_cast(h16, (_Float16)c1);
            F.IKN[prow * 64 + lane] = __builtin_bit_cast(h16, (_Float16)ikn); }
    }
    for (int it = gw; it < BATCH * NPAD; it += NGW) { const size_t prow = (size_t)(it / NPAD) * P + (it % NPAD);
        ((unsigned*)(F.AK + prow * 128))[lane] = 0u; ((unsigned*)(F.AV + prow * 128))[lane] = 0u; ((unsigned*)(F.CKV + prow * 128))[lane] = 0u;
        if (lane < 32) ((unsigned*)(F.IKN + prow * 64))[lane] = 0u; }
}

constexpr int A_KSTR = 144, A_VSTR = 528, A_LDS_K = 0, A_LDS_VT = 256 * A_KSTR, A_LDS_TB = A_LDS_VT + 64 * A_VSTR;
__device__ __forceinline__ void attn_a_phase(Frame& F) {
    LAS unsigned char* lds = F.lds;
    const int lane = F.lane, w = F.wave, tid = F.tid, q32 = lane & 31, hh = lane >> 5;
    const float NINF = -__builtin_inff();
    for (int u = F.vcu; u < BATCH * 16 * 2; u += F.G) {
        const int kvh = u & 1, blk = 1 + ((u >> 1) & 15), b = u >> 5;
        const size_t kbase = (size_t)b * P + (size_t)(blk - 1) * BLK;
        __syncthreads();
#pragma unroll
        for (int i = 0; i < 4; ++i) { const int id = i * 512 + tid, row = id >> 3, ch = id & 7;
            const u32x4 kv = *(const u32x4*)(F.AK + (kbase + row) * 128 + kvh * 64 + ch * 8);
            *(LAS u32x4*)(lds + A_LDS_K + row * A_KSTR + ch * 16) = kv;
            const u32x4 vv = *(const u32x4*)(F.AV + (kbase + row) * 128 + kvh * 64 + ch * 8);
            const int pk = (row & ~12) | ((row & 4) << 1) | ((row & 8) >> 1);
#pragma unroll
            for (int e = 0; e < 8; ++e) *(LAS h16*)(lds + A_LDS_VT + (ch * 8 + e) * A_VSTR + pk * 2) = (h16)((vv[e >> 1] >> (16 * (e & 1))) & 0xffffu); }
        ((LAS float*)(lds + A_LDS_TB))[tid] = F.TBL[(kvh * 4 + (tid >> 7)) * TBLW + (tid & 127)];
        __syncthreads();
        const int g = w & 3, head = kvh * 4 + g;
        const float sink = F.sinks[head] * LOG2E;
        const LAS float* TB = (const LAS float*)(lds + A_LDS_TB) + g * 128;
        for (int qq = 0; qq < 2; ++qq) {
            const int qg = (w >> 2) * 2 + qq, i_loc = qg * 32 + q32;
            const size_t qrow = (size_t)b * SEQ + (size_t)(blk - 1) * BLK + i_loc;
            h16x8 qf[4];
#pragma unroll
            for (int ks = 0; ks < 4; ++ks) qf[ks] = *(const h16x8*)(F.AQ + qrow * 512 + head * 64 + ks * 16 + hh * 8);
            float m_run = sink, l_run = 1.0f;
            f32x16 o0, o1;
#pragma unroll
            for (int r = 0; r < 16; ++r) { o0[r] = 0.f; o1[r] = 0.f; }
            for (int kt = qg; kt <= qg + 4; ++kt) {
                f32x16 s;
#pragma unroll
                for (int r = 0; r < 16; ++r) s[r] = 0.f;
#pragma unroll
                for (int ks = 0; ks < 4; ++ks) { const h16x8 kf = *(const LAS h16x8*)(lds + A_LDS_K + (kt * 32 + q32) * A_KSTR + (ks * 16 + hh * 8) * 2);
                    s = __builtin_amdgcn_mfma_f32_32x32x16_f16(kf, qf[ks], s, 0, 0, 0); }
                float mx = NINF;
#pragma unroll
                for (int r = 0; r < 16; ++r) { const int j = kt * 32 + (r & 3) + 8 * (r >> 2) + 4 * hh, dist = 128 + i_loc - j;
                    const bool valid = (dist >= 0) && (dist < 128) && ((blk - 1) * BLK + j >= NPAD);
                    const float v = valid ? s[r] + TB[dist & 127] : NINF; s[r] = v; mx = fmaxf(mx, v); }
                mx = fmaxf(mx, __shfl_xor(mx, 32));
                const float m_new = fmaxf(m_run, mx), alpha = __builtin_amdgcn_exp2f(m_run - m_new);
                float ps = 0.f;
#pragma unroll
                for (int r = 0; r < 16; ++r) { const float p = __builtin_amdgcn_exp2f(s[r] - m_new); s[r] = p; ps += p; }
                ps += __shfl_xor(ps, 32);
                l_run = l_run * alpha + ps; m_run = m_new;
#pragma unroll
                for (int r = 0; r < 16; ++r) { o0[r] *= alpha; o1[r] *= alpha; }
#pragma unroll
                for (int sx = 0; sx < 2; ++sx) {
                    const u32x4 pw = {pk_h2(s[8 * sx], s[8 * sx + 1]), pk_h2(s[8 * sx + 2], s[8 * sx + 3]), pk_h2(s[8 * sx + 4], s[8 * sx + 5]), pk_h2(s[8 * sx + 6], s[8 * sx + 7])};
                    const h16x8 pf = __builtin_bit_cast(h16x8, pw);
                    const h16x8 va0 = *(const LAS h16x8*)(lds + A_LDS_VT + q32 * A_VSTR + (kt * 32 + 16 * sx + 8 * hh) * 2);
                    const h16x8 va1 = *(const LAS h16x8*)(lds + A_LDS_VT + (32 + q32) * A_VSTR + (kt * 32 + 16 * sx + 8 * hh) * 2);
                    o0 = __builtin_amdgcn_mfma_f32_32x32x16_f16(va0, pf, o0, 0, 0, 0);
                    o1 = __builtin_amdgcn_mfma_f32_32x32x16_f16(va1, pf, o1, 0, 0, 0); }
            }
            const float inv = 1.0f / l_run;
            h16* op = F.OA + qrow * 512 + head * 64 + 4 * hh;
#pragma unroll
            for (int g4 = 0; g4 < 4; ++g4) {
                u32x2 w0, w1; w0.x = pk_h2(o0[4 * g4] * inv, o0[4 * g4 + 1] * inv); w0.y = pk_h2(o0[4 * g4 + 2] * inv, o0[4 * g4 + 3] * inv);
                w1.x = pk_h2(o1[4 * g4] * inv, o1[4 * g4 + 1] * inv); w1.y = pk_h2(o1[4 * g4 + 2] * inv, o1[4 * g4 + 3] * inv);
                *(u32x2*)(op + 8 * g4) = w0; *(u32x2*)(op + 32 + 8 * g4) = w1; }
        }
    }
    __syncthreads();
}

constexpr int L3_STAGE = 0, L3_SEL = 65536, L3_CNT = L3_SEL + 16 * 256 * 2, L3_CNT2 = L3_CNT + 2 * 8 * 16 * 4, L3_TB = L3_CNT2 + 8 * 4 * 16 * 4, L3_END = L3_TB + 8 * TBLW * 4;
static_assert(L3_END <= RING_BYTES, "P3 LDS map");
__device__ __forceinline__ unsigned off_b(unsigned row, unsigned ch) { return 256u * row + 16u * (ch ^ (((row & 3u) << 2) | ((row >> 2) & 3u))); }
__device__ __forceinline__ h16x4 ds_tr16(const LAS unsigned char* p) { return __builtin_bit_cast(h16x4, __builtin_amdgcn_ds_read_tr16_b64_v4i16((LAS s16x4*)p)); }
constexpr int IMIN = (int)0x80000000;
__device__ __forceinline__ void mixer_b_phase(Frame& F) {
    LAS unsigned char* lds = F.lds;
    const int lane = F.lane, w = F.wave, tid = F.tid, n16 = lane & 15, g = lane >> 4;
    const float NINF = -__builtin_inff();
    LAS unsigned short* SEL = (LAS unsigned short*)(lds + L3_SEL);
    LAS unsigned* CNT = (LAS unsigned*)(lds + L3_CNT);
    LAS unsigned* CNT2 = (LAS unsigned*)(lds + L3_CNT2);
    LAS float* TB = (LAS float*)(lds + L3_TB);
    LAS unsigned char* stage = lds + L3_STAGE + w * 8192;
    __syncthreads();
    for (int e = tid; e < 8 * 129; e += 512) { const int hh = e / 129, dd = e % 129; TB[hh * TBLW + dd] = F.TBL[(8 + hh) * TBLW + dd]; }
    const int nunits = BATCH * 16 * 8;
    for (int it = 0; ; ++it) {
        int b, blk, sub;
        if (F.G == 256) { if (it >= 16) break; b = 4 * (F.vcu >> 5) + (F.vcu & 3); sub = (F.vcu >> 2) & 7; blk = 1 + it; }
        else { const int uid = F.vcu + it * F.G; if (uid >= nunits) break; b = uid >> 7; sub = (uid >> 4) & 7; blk = 1 + (uid & 15); }
        const int t0 = (blk - 1) * BLK + sub * 16;
        const size_t qrow0 = (size_t)b * SEQ + t0;
        const int qpos = BLK + t0 + n16;
        const int ntile = (blk + 1) * 8;
        const h16* ikb = F.IKN + (size_t)b * P * 64;
        h16x8 qb[4][2];
#pragma unroll
        for (int h = 0; h < 4; ++h)
#pragma unroll
            for (int ks = 0; ks < 2; ++ks) qb[h][ks] = *(const h16x8*)(F.IQ + (qrow0 + n16) * 256 + h * 64 + ks * 32 + 8 * g);
        const f32x4 wv = *(const f32x4*)(F.IWS + (qrow0 + n16) * 4);
        int sk[17][4];
        int kb1 = w * 16 + 4 * g; asm volatile("" : "+v"(kb1));
        h16x8 a0n, a1n;
        { const u32x4 z = {0u, 0u, 0u, 0u}; a0n = __builtin_bit_cast(h16x8, z); a1n = a0n; }
        const h16* ap = ikb + (size_t)(w * 16 + n16) * 64 + 8 * g;
        if (w < ntile) { a0n = *(const h16x8*)ap; a1n = *(const h16x8*)(ap + 32); }
#pragma unroll
        for (int j = 0; j < 17; ++j) {
            const int kt = w + 8 * j;
            const h16x8 a0 = a0n, a1 = a1n;
            ap += 8192; asm volatile("" : "+v"(ap));
            if (j < 16 && kt + 8 < ntile) { a0n = *(const h16x8*)ap; a1n = *(const h16x8*)(ap + 32); }
            asm volatile("" ::: "memory");
            if (kt < ntile) {
                float sc[4] = {0.f, 0.f, 0.f, 0.f};
#pragma unroll
                for (int h = 0; h < 4; ++h) { f32x4 c = {0.f, 0.f, 0.f, 0.f};
                    c = __builtin_amdgcn_mfma_f32_16x16x32_f16(a0, qb[h][0], c, 0, 0, 0); c = __builtin_amdgcn_mfma_f32_16x16x32_f16(a1, qb[h][1], c, 0, 0, 0);
#pragma unroll
                    for (int r = 0; r < 4; ++r) sc[r] += fmaxf(c[r], 0.f) * wv[h]; }
#pragma unroll
                for (int r = 0; r < 4; ++r) { const int kpos = kb1 + 128 * j + r; const int bits = __builtin_bit_cast(int, sc[r]);
                    int key = (sc[r] == 0.f) ? (-1 - kpos) : (bits >= 0 ? bits : (bits ^ 0x7fffffff));
                    if (kpos < NPAD || kpos > qpos) key = IMIN;
                    sk[j][r] = key; }
            } else {
#pragma unroll
                for (int r = 0; r < 4; ++r) sk[j][r] = IMIN;
            }
        }
        const int nadm = qpos - NPAD + 1, Kq = nadm < TOPK ? nadm : TOPK;
        int lo = IMIN + 1, hi = 0x7fffffff, T = IMIN + 1; bool done = (nadm <= TOPK);
        unsigned par = 0;
        for (int step = 0; step < 40; ++step) {
            if (!__any(!done)) break;
            const int mid = (int)(((long long)lo + (long long)hi) >> 1);
            int c = 0;
#pragma unroll
            for (int j = 0; j < 17; ++j)
#pragma unroll
                for (int r = 0; r < 4; ++r) c += (sk[j][r] >= mid) ? 1 : 0;
            c += __shfl_xor(c, 16); c += __shfl_xor(c, 32);
            if (g == 0) CNT[(par * 8 + w) * 16 + n16] = (unsigned)c;
            __syncthreads();
            int tot = 0;
#pragma unroll
            for (int ww = 0; ww < 8; ++ww) tot += (int)CNT[(par * 8 + ww) * 16 + n16];
            if (!done) {
                if (tot == Kq) { T = mid; done = true; }
                else { if (tot > Kq) lo = mid; else hi = mid; if ((unsigned)hi - (unsigned)lo <= 1u) { T = lo; done = true; } }
            }
            par ^= 1u;
        }
        {
            int kb2 = w * 16 + 4 * g; asm volatile("" : "+v"(kb2));
            int c = 0;
#pragma unroll
            for (int j = 0; j < 17; ++j)
#pragma unroll
                for (int r = 0; r < 4; ++r) c += (sk[j][r] >= T) ? 1 : 0;
            CNT2[(w * 4 + g) * 16 + n16] = (unsigned)c;
            __syncthreads();
            int off = 0;
            for (int o = 0; o < w * 4 + g; ++o) off += (int)CNT2[o * 16 + n16];
#pragma unroll
            for (int j = 0; j < 17; ++j)
#pragma unroll
                for (int r = 0; r < 4; ++r) if (sk[j][r] >= T) { if (off < TOPK) SEL[n16 * 256 + off] = (unsigned short)(kb2 + 128 * j + r); ++off; }
            __syncthreads();
        }
        const h16* ckb = F.CKV + (size_t)b * P * 128;
        for (int qq = w; qq < 16; qq += 8) {
            const size_t qrow = qrow0 + qq; const int qp = BLK + t0 + qq;
            const int nsel = (qp - NPAD + 1) < TOPK ? (qp - NPAD + 1) : TOPK, nch = (nsel + 31) >> 5;
            h16x8 qa[4];
#pragma unroll
            for (int ks = 0; ks < 4; ++ks) { const u32x4 z = {0u, 0u, 0u, 0u}; qa[ks] = (n16 < 8) ? *(const h16x8*)(F.QABS + qrow * 1024 + n16 * 128 + ks * 32 + 8 * g) : __builtin_bit_cast(h16x8, z); }
            const float rsq = F.RSQ[qrow];
            const LAS float* tb = TB + (n16 & 7) * TBLW;
            float m_run = -1e30f, l_run = 0.f;
            f32x4 o[8];
#pragma unroll
            for (int mt = 0; mt < 8; ++mt) o[mt] = (f32x4){0.f, 0.f, 0.f, 0.f};
            for (int c = 0; c < nch; ++c) {
#pragma unroll
                for (int i = 0; i < 8; ++i) { const int p = i * 64 + lane, j = p >> 4, ch = p & 15, idx = 32 * c + j;
                    const int kp = idx < nsel ? (int)SEL[qq * 256 + idx] : qp;
                    const u32x4 v = *(const u32x4*)(ckb + (size_t)kp * 128 + ch * 8);
                    *(LAS u32x4*)(stage + off_b(j, ch)) = v; }
                f32x4 st[2];
#pragma unroll
                for (int t = 0; t < 2; ++t) { st[t] = (f32x4){0.f, 0.f, 0.f, 0.f};
                    const unsigned rowl = 8u * (n16 >> 2) + 4u * t + (n16 & 3);
#pragma unroll
                    for (int ks = 0; ks < 4; ++ks) { const h16x8 a = *(const LAS h16x8*)(stage + off_b(rowl, 4 * ks + g)); st[t] = __builtin_amdgcn_mfma_f32_16x16x32_f16(a, qa[ks], st[t], 0, 0, 0); } }
                float mx = NINF;
#pragma unroll
                for (int t = 0; t < 2; ++t)
#pragma unroll
                    for (int r = 0; r < 4; ++r) { const int idx = 32 * c + 8 * g + 4 * t + r; const bool valid = idx < nsel;
                        const int kp = valid ? (int)SEL[qq * 256 + idx] : qp; const int dist = qp - kp;
                        const float v = valid ? st[t][r] * rsq + tb[dist < 128 ? dist : 128] : NINF; st[t][r] = v; mx = fmaxf(mx, v); }
                mx = fmaxf(mx, __shfl_xor(mx, 16)); mx = fmaxf(mx, __shfl_xor(mx, 32));
                const float m_new = fmaxf(m_run, mx), alpha = __builtin_amdgcn_exp2f(m_run - m_new);
                float ps = 0.f;
#pragma unroll
                for (int t = 0; t < 2; ++t)
#pragma unroll
                    for (int r = 0; r < 4; ++r) { const float p = __builtin_amdgcn_exp2f(st[t][r] - m_new); st[t][r] = p; ps += p; }
                ps += __shfl_xor(ps, 16); ps += __shfl_xor(ps, 32);
                l_run = l_run * alpha + ps; m_run = m_new;
                const u32x4 pw = {pk_h2(st[0][0], st[0][1]), pk_h2(st[0][2], st[0][3]), pk_h2(st[1][0], st[1][1]), pk_h2(st[1][2], st[1][3])};
                const h16x8 pb = __builtin_bit_cast(h16x8, pw);
                const unsigned qd = (unsigned)(n16 >> 2), pp = (unsigned)(lane & 3);
#pragma unroll
                for (int mt = 0; mt < 8; ++mt) {
                    const h16x4 lo4 = ds_tr16(stage + off_b(8u * g + qd, 2u * mt + (pp >> 1)) + 8u * (pp & 1));
                    const h16x4 hi4 = ds_tr16(stage + off_b(8u * g + 4u + qd, 2u * mt + (pp >> 1)) + 8u * (pp & 1));
                    const h16x8 a = {lo4[0], lo4[1], lo4[2], lo4[3], hi4[0], hi4[1], hi4[2], hi4[3]};
                    o[mt] = o[mt] * alpha;
                    o[mt] = __builtin_amdgcn_mfma_f32_16x16x32_f16(a, pb, o[mt], 0, 0, 0); }
            }
            const float inv = 1.0f / l_run;
            if (n16 < 8) { h16* op = F.LAT + qrow * 1024 + n16 * 128 + 4 * g;
#pragma unroll
                for (int mt = 0; mt < 8; ++mt) { u32x2 ww; ww.x = pk_h2(o[mt][0] * inv, o[mt][1] * inv); ww.y = pk_h2(o[mt][2] * inv, o[mt][3] * inv); *(u32x2*)(op + 16 * mt) = ww; } }
        }
        __syncthreads();
    }
}

__device__ __forceinline__ void final_norm_phase(Frame& F) {
    const int gw = F.vcu * NWAVES + F.wave, NGW = F.G * NWAVES, lane = F.lane;
    f32x4 gv[4];
#pragma unroll
    for (int j = 0; j < 4; ++j) gv[j] = ((const f32x4*)F.gf)[lane + 64 * j];
    for (int row = gw; row < M; row += NGW) {
        const float rs = row_rs16(F.SSQ2 + (size_t)row * 16);
        f32x4* xr = (f32x4*)(F.out + (size_t)row * D) + lane;
#pragma unroll
        for (int j = 0; j < 4; ++j) { const f32x4 v = xr[64 * j]; xr[64 * j] = v * rs * gv[j]; }
    }
}

#ifndef MK_N_LAUNCHES
#define MK_N_LAUNCHES 1
#endif
constexpr int N_PHASES = 10;
struct Args { const float* in[22]; float* out; unsigned char* ws; int ph_lo, ph_hi; };
__global__ void __launch_bounds__(NWAVES * 64, 2) fwd_kernel(Args args) {
    extern __shared__ __attribute__((aligned(16))) unsigned char lds_raw[];
    Frame F;
    F.lds = (LAS unsigned char*)lds_raw;
    F.tid = threadIdx.x; F.lane = F.tid & 63; F.wave = __builtin_amdgcn_readfirstlane(F.tid >> 6);
    F.G = gridDim.x; { const int bx = blockIdx.x; F.vcu = (F.G % 8 == 0) ? (bx % 8) * (F.G / 8) + bx / 8 : bx; }
    unsigned char* ws = args.ws;
    F.x = args.in[0]; F.meta = args.in[1]; F.g1 = args.in[2]; F.w_in = args.in[3]; F.bg = args.in[4]; F.qg = args.in[5]; F.kvg = args.in[6]; F.w_uq = args.in[7]; F.w_uk = args.in[8];
    F.w_uv = args.in[9]; F.lng = args.in[10]; F.lnb = args.in[11]; F.sinks = args.in[12]; F.relb = args.in[13]; F.w_a = args.in[14]; F.w_b = args.in[15]; F.w_o = args.in[16];
    F.g2 = args.in[17]; F.w_g = args.in[18]; F.w_u = args.in[19]; F.w_d = args.in[20]; F.gf = args.in[21]; F.out = args.out;
    F.Win_t = (h16*)(ws + WS_WIN); F.Wqabs_t = (h16*)(ws + WS_WQABS); F.Wa_t = (h16*)(ws + WS_WA); F.Wuvb_t = (h16*)(ws + WS_WUVB); F.Wo_t = (h16*)(ws + WS_WO);
    F.Wgu_t = (h16*)(ws + WS_WGU); F.Wd_t = (h16*)(ws + WS_WD);
    F.RS1 = (float*)(ws + WS_RS1); F.RSQ = (float*)(ws + WS_RSQ); F.IWS = (float*)(ws + WS_IWS); F.SSQ1 = (float*)(ws + WS_SSQ1); F.SSQ2 = (float*)(ws + WS_SSQ2);
    F.METAP = (float*)(ws + WS_METAP); F.TBL = (float*)(ws + WS_TBL); F.RAW4 = (float*)(ws + WS_RAW4);
    F.AK = (h16*)(ws + WS_AK); F.AV = (h16*)(ws + WS_AV); F.CKV = (h16*)(ws + WS_CKV); F.IKN = (h16*)(ws + WS_IKN); F.OA = (h16*)(ws + WS_OA); F.GATES = (h16*)(ws + WS_GATES);
    F.AQ = (h16*)(ws + WS_AQ); F.BQ = (h16*)(ws + WS_BQ); F.IQ = (h16*)(ws + WS_IQ); F.H1 = (h16*)(ws + WS_H1); F.XH = (h16*)(ws + WS_XH); F.MIXED = (h16*)(ws + WS_MIXED);
    F.QABS = (h16*)(ws + WS_QABS); F.LAT = (h16*)(ws + WS_LAT); F.ACT = (h16*)(ws + WS_ACT);
    for (int u = F.tid; u < (LDS_BYTES - LDSCTL_OFF) / 4; u += NWAVES * 64) ((LAS unsigned*)(F.lds + LDSCTL_OFF))[u] = 0u;
    __syncthreads();
    XcdBarrier bar; bar.bar = (unsigned*)(ws + WS_CTL) + CW_BAR; bar.x = 0; bar.st = nullptr;
    if (MK_N_LAUNCHES == 1) bar = xcd_barrier_post((unsigned*)(ws + WS_CTL) + CW_BAR, (volatile LAS unsigned*)(F.lds + MISC_OFF) + 8);
    const int lo = args.ph_lo, hi = args.ph_hi;
#ifndef PHMASK
#define PHMASK 0x3ff
#endif
#define IN(k) ((((PHMASK) >> (k)) & 1) && lo <= (k) && (k) < hi)
#define SEAM(k) do { if (MK_N_LAUNCHES == 1) { if (IN(k) && IN((k) + 1)) xcd_barrier(bar); } } while (0)

    if (IN(0)) { p0_prologue(F); } SEAM(0);
    if (IN(1)) {
        pg8::Gemm g{F.XH, F.Win_t, M, DINP, D}; pg8::StaticOrder S; S.init(M, DINP, F.G, (int)blockIdx.x);
        EpiInProj E{F.RS1, F.AQ, F.AK, F.AV, F.BQ, F.RAW4, F.IQ, F.GATES, F.bg};
        pg8::gemm_phase<EpiInProj, pg8::StaticOrder>(F.lds + RING_OFF, g, S, E);
    } SEAM(1);
    if (IN(2)) {
#ifndef NO_NORMS
        p2_norms(F);
#endif
        { pg8::Gemm g{F.BQ, F.Wqabs_t, M, 1024, 256}; pg8::StaticOrder S; S.init(M, 1024, F.G, (int)blockIdx.x);
          EpiH16 E{F.QABS, 1024};
          pg8::gemm_phase<EpiH16, pg8::StaticOrder>(F.lds + RING_OFF, g, S, E); }
    } SEAM(2);
    if (IN(3)) {
#ifndef NO_ATTN_A
        attn_a_phase(F);
#endif
#ifndef NO_MIXER_B
        mixer_b_phase(F);
#endif
    } SEAM(3);
    if (IN(4)) {
        pg8::Gemm g{F.OA, F.Wa_t, M, D, 512}; pg8::StaticOrder S; S.init(M, D, F.G, (int)blockIdx.x);
        EpiGate<false> E{F.GATES, F.MIXED};
        pg8::gemm_phase<EpiGate<false>, pg8::StaticOrder>(F.lds + RING_OFF, g, S, E);
    } SEAM(4);
    if (IN(5)) {
        pg8::Gemm g{F.LAT, F.Wuvb_t, M, D, 1024}; pg8::StaticOrder S; S.init(M, D, F.G, (int)blockIdx.x);
        EpiGate<true> E{F.GATES + 1024, F.MIXED};
        pg8::gemm_phase<EpiGate<true>, pg8::StaticOrder>(F.lds + RING_OFF, g, S, E);
    } SEAM(5);
    if (IN(6)) {
        pg8::Gemm g{F.MIXED, F.Wo_t, M, D, D}; pg8::StaticOrder S; S.init(M, D, F.G, (int)blockIdx.x);
        EpiWo E{F.x, F.H1, F.SSQ1};
        pg8::gemm_phase<EpiWo, pg8::StaticOrder>(F.lds + RING_OFF, g, S, E);
    } SEAM(6);
    if (IN(7)) {
        pg8::Gemm g{F.H1, F.Wgu_t, M, NGU, D}; pg8::StaticOrder S; S.init(M, NGU, F.G, (int)blockIdx.x);
        EpiSwiGLU E{F.SSQ1, F.ACT};
        pg8::gemm_phase<EpiSwiGLU, pg8::StaticOrder>(F.lds + RING_OFF, g, S, E);
    } SEAM(7);
    if (IN(8)) {
        pg8::Gemm g{F.ACT, F.Wd_t, M, D, DFF}; pg8::StaticOrder S; S.init(M, D, F.G, (int)blockIdx.x);
        EpiDown E{F.H1, F.out, F.SSQ2};
        pg8::gemm_phase<EpiDown, pg8::StaticOrder>(F.lds + RING_OFF, g, S, E);
    } SEAM(8);
    if (IN(9)) { final_norm_phase(F); }
#undef IN
#undef SEAM
}

extern "C" void kernel_launch(void* const* d_in, const int* in_sizes, int n_in, void* d_out, int out_size, void* d_ws, size_t ws_size, hipStream_t stream) {
    static int grid = 0;
    if (grid == 0) {
        if (n_in != 22 || in_sizes[0] != M * D || out_size != M * D || ws_size < WS_END) {
            fprintf(stderr, "kernel_launch: built for 22 inputs, x/out of %d floats, >= %zu bytes of workspace; got n_in %d, in0 %d, out %d, ws %zu; nothing launched\n", M * D, (size_t)WS_END, n_in, n_in > 0 ? in_sizes[0] : -1, out_size, ws_size);
            grid = -1; return; }
        int dev = 0, cus = 0, per_cu = 0;
        if (hipGetDevice(&dev) != hipSuccess || hipDeviceGetAttribute(&cus, hipDeviceAttributeMultiprocessorCount, dev) != hipSuccess) { fprintf(stderr, "kernel_launch: device query failed\n"); grid = -1; return; }
        if (hipFuncSetAttribute((const void*)fwd_kernel, hipFuncAttributeMaxDynamicSharedMemorySize, LDS_BYTES) != hipSuccess) { fprintf(stderr, "kernel_launch: hipFuncSetAttribute failed\n"); grid = -1; return; }
        if (hipOccupancyMaxActiveBlocksPerMultiprocessor(&per_cu, (const void*)fwd_kernel, NWAVES * 64, LDS_BYTES) != hipSuccess || per_cu < 1)
            fprintf(stderr, "kernel_launch: note: occupancy query reports %d workgroups per CU\n", per_cu);
        (void)hipGetLastError();
        grid = cus;
    }
    if (grid < 0) return;
    if (hipMemsetAsync((char*)d_ws + WS_CTL, 0, CTL_ZERO_BYTES, stream) != hipSuccess) { fprintf(stderr, "kernel_launch: hipMemsetAsync failed\n"); return; }
    Args a{};
    for (int i = 0; i < 22; ++i) a.in[i] = (const float*)d_in[i];
    a.out = (float*)d_out; a.ws = (unsigned char*)d_ws;
    for (int li = 0; li < MK_N_LAUNCHES; ++li) {
        a.ph_lo = (MK_N_LAUNCHES == 1) ? 0 : li; a.ph_hi = (MK_N_LAUNCHES == 1) ? N_PHASES : li + 1;
        hipLaunchKernelGGL(fwd_kernel, dim3(grid), dim3(NWAVES * 64), LDS_BYTES, stream, a);
        const hipError_t le = hipPeekAtLastError();
        if (le != hipSuccess) { fprintf(stderr, "kernel_launch: launch %d failed: %s\n", li, hipGetErrorName(le)); break; }
    }
}
```

```cpp
#include <hip/hip_runtime.h>
#include <cstdio>
#include <cstdint>

#define LAS __attribute__((address_space(3)))
#define GAS __attribute__((address_space(1)))
typedef unsigned short h16;
typedef _Float16 h16x8 __attribute__((ext_vector_type(8)));
typedef _Float16 h16x4 __attribute__((ext_vector_type(4)));
typedef _Float16 h16x2 __attribute__((ext_vector_type(2)));
typedef float f32x4 __attribute__((ext_vector_type(4)));
typedef float f32x16 __attribute__((ext_vector_type(16)));
typedef unsigned u32x4 __attribute__((ext_vector_type(4)));
typedef unsigned u32x2 __attribute__((ext_vector_type(2)));
typedef short s16x4 __attribute__((ext_vector_type(4)));

constexpr int BATCH = 32, SEQ = 2048, D = 1024, NPAD = 112, NMETA = 16, BLK = 128, P = BLK + SEQ  , NBLK = P / BLK  ;
constexpr int M = BATCH * SEQ;
constexpr int DIN = 3524, DINP = 3584, DFF = 2816, NGU = 2 * DFF  ;
constexpr int TOPK = 256;
constexpr float EPS = 1e-6f, LOG2E = 1.4426950408889634f;
constexpr float QSCALE = 0.125f * LOG2E;

__device__ __forceinline__ unsigned pk_h2(float lo, float hi) { h16x2 v = {(_Float16)lo, (_Float16)hi}; return __builtin_bit_cast(unsigned, v); }
__device__ __forceinline__ u32x4 pk_h8(f32x4 a, f32x4 b) { u32x4 w; w.x = pk_h2(a[0], a[1]); w.y = pk_h2(a[2], a[3]); w.z = pk_h2(b[0], b[1]); w.w = pk_h2(b[2], b[3]); return w; }
__device__ __forceinline__ float h2f(h16 v) { return (float)__builtin_bit_cast(_Float16, v); }
__device__ __forceinline__ float sigmoidf_fast(float x) { return __builtin_amdgcn_rcpf(1.0f + __builtin_amdgcn_exp2f(-LOG2E * x)); }

namespace pg8 {
constexpr int BM = 256, BK = 64, HALF = 128, HTB = HALF * BK * 2  , STAGE_BYTES = 8 * HTB, NXCD = 8, WGM = 8;
__host__ __device__ __forceinline__ int lds_byte(int r, int c) { const int st = (r >> 4) * 2 + (c >> 5), rr = r & 15, cc = c & 31, ob = rr * 64 + cc * 2; return st * 1024 + (ob ^ (((ob >> 9) & 1) << 5)); }
__host__ __device__ __forceinline__ void stage_rc(int b, int& R, int& C) { const int st = b / 1024, sb = b % 1024, swz = sb ^ (((sb >> 9) & 1) << 5); R = (st >> 1) * 16 + swz / 64; C = (st & 1) * 32 + (swz % 64) / 2; }
__host__ __device__ __forceinline__ int perm32(int rho) { const int n = rho >> 4, i = rho & 15; return 8 * (i >> 2) + 4 * n + (i & 3); }

struct Unit { int pm, pn; };
struct Gemm { const h16* A; const h16* Bt; int M, N, K; };

struct StaticOrder {
    int nM, nN, nwg, G, c;
    __host__ __device__ void init(int M_, int N_, int G_, int c_) { nM = M_ / BM; nN = N_ / BM; nwg = nM * nN; G = G_; c = c_; }
    __host__ __device__ bool next(int i, Unit& u) const {
        const long L = (long)i * G + c; if (L >= nwg) return false;
        int wgid = (int)L; { const int q = nwg / NXCD, r = nwg % NXCD, xcd = wgid % NXCD, off = wgid / NXCD; wgid = (xcd < r ? xcd * (q + 1) : r * (q + 1) + (xcd - r) * q) + off; }
        const int nig = WGM * nN, gid = wgid / nig, fm = gid * WGM, gsz = (nM - fm) < WGM ? (nM - fm) : WGM;
        u.pm = fm + ((wgid % nig) % gsz); u.pn = (wgid % nig) / gsz; return true;
    }
    __device__ __forceinline__ void a_ready(const Unit&) const {}
    __device__ __forceinline__ void done(const Unit&) const {}
};

template <class Epi, class Sched, bool ALIGN_EPI = true, bool SP2 = true>
__device__ __forceinline__ void gemm_phase(LAS unsigned char* lds, const Gemm g, const Sched& S, const Epi& E) {
    const int tid = threadIdx.x, wid = __builtin_amdgcn_readfirstlane(tid >> 6), lane = tid & 63, wr = wid >> 2, wc = wid & 3, fr = lane & 15, fq = lane >> 4;
    int K = g.K; asm volatile("" : "+s"(K));
    const int nt = K / BK;
    unsigned voffA[2], voffB[2];
#pragma unroll
    for (int i = 0; i < 2; ++i) { int R, C; stage_rc(tid * 16 + i * 8192, R, C); const int Rb = (R & ~31) + perm32(R & 31);
        voffA[i] = (unsigned)(R * K + C) * 2u; voffB[i] = (unsigned)(Rb * K + C) * 2u; }
    const size_t kstep = (size_t)(BK * 2);
    const size_t hstep = (size_t)HALF * K * 2;
    const size_t tstep = 2 * hstep;
    const unsigned ldsw = (unsigned)wid * 1024u;
    const int aoff = lds_byte(wr * 64 + fr, fq * 8), boff = lds_byte(wc * 32 + fr, fq * 8);
#define PG8_SA(b, h) (((b) * 2 + (h)) * HTB)
#define PG8_SB(b, h) ((4 + (b) * 2 + (h)) * HTB)
#define PG8_STAGE(bufoff, gbase, voff) do { _Pragma("unroll") for (int _i = 0; _i < 2; ++_i) \
        __builtin_amdgcn_global_load_lds((const unsigned*)((const char*)(gbase) + (voff)[_i]), (LAS unsigned*)(lds + (bufoff) + ldsw + _i * 8192), 16, 0, 0); } while (0)
#define PG8_LDA(dst, b, h) do { _Pragma("unroll") for (int m = 0; m < 4; ++m) _Pragma("unroll") for (int k = 0; k < 2; ++k) dst[m][k] = *(const LAS h16x8*)(lds + PG8_SA(b, h) + aoff + m * 2048 + k * 1024); } while (0)
#define PG8_LDB(dst, b, h) do { _Pragma("unroll") for (int n = 0; n < 2; ++n) _Pragma("unroll") for (int k = 0; k < 2; ++k) dst[n][k] = *(const LAS h16x8*)(lds + PG8_SB(b, h) + boff + n * 2048 + k * 1024); } while (0)
#define PG8_MMA(ai, bj, At, Bt) do { __builtin_amdgcn_s_setprio(1); _Pragma("unroll") for (int m = 0; m < 4; ++m) _Pragma("unroll") for (int n = 0; n < 2; ++n) _Pragma("unroll") for (int k = 0; k < 2; ++k) \
        acc[ai][bj][m][n] = __builtin_amdgcn_mfma_f32_16x16x32_f16(Bt[n][k], At[m][k], acc[ai][bj][m][n], 0, 0, 0); __builtin_amdgcn_s_setprio(0); } while (0)
#define PG8_WAIT_V(n) asm volatile("s_waitcnt vmcnt(" #n ")" ::: "memory")
#define PG8_WAIT_L(n) asm volatile("s_waitcnt lgkmcnt(" #n ")" ::: "memory")
#define PG8_BAR __builtin_amdgcn_s_barrier()
#define PG8_SCHED __builtin_amdgcn_sched_barrier(0)
    Unit cur, nxt; int ui = 0;
    if (!S.next(0, cur)) return;
    f32x4 acc[2][2][4][2];
#pragma unroll
    for (int a = 0; a < 2; ++a)
#pragma unroll
        for (int b = 0; b < 2; ++b)
#pragma unroll
            for (int m = 0; m < 4; ++m)
#pragma unroll
                for (int n = 0; n < 2; ++n) acc[a][b][m][n] = (f32x4){0.f, 0.f, 0.f, 0.f};
    h16x8 At[4][2], B0[2][2], B1[2][2];
    const char* cA = (const char*)g.A + (size_t)cur.pm * tstep; const char* cB = (const char*)g.Bt + (size_t)cur.pn * tstep;
    S.a_ready(cur);
    if constexpr (SP2) {
        PG8_STAGE(PG8_SB(0, 0), cB, voffB); PG8_STAGE(PG8_SB(0, 1), cB + hstep, voffB); PG8_STAGE(PG8_SA(0, 0), cA, voffA); PG8_STAGE(PG8_SA(0, 1), cA + hstep, voffA);
        if (wr == 1) PG8_BAR;
        PG8_WAIT_V(2); PG8_BAR;
        PG8_STAGE(PG8_SB(1, 0), cB + kstep, voffB); PG8_STAGE(PG8_SA(1, 0), cA + kstep, voffA); PG8_STAGE(PG8_SB(1, 1), cB + hstep + kstep, voffB);
        PG8_WAIT_V(6); PG8_BAR;
    } else {
        PG8_STAGE(PG8_SB(0, 0), cB, voffB); PG8_STAGE(PG8_SA(0, 0), cA, voffA); PG8_STAGE(PG8_SB(0, 1), cB + hstep, voffB); PG8_STAGE(PG8_SA(0, 1), cA + hstep, voffA);
        if (wr == 1) PG8_BAR;
        PG8_WAIT_V(4); PG8_BAR;
        PG8_STAGE(PG8_SB(1, 0), cB + kstep, voffB); PG8_STAGE(PG8_SA(1, 0), cA + kstep, voffA); PG8_STAGE(PG8_SB(1, 1), cB + hstep + kstep, voffB);
        PG8_WAIT_V(6); PG8_BAR;
    }
    for (;;) {
        const bool has_next = S.next(ui + 1, nxt);
        const char* nA = has_next ? (const char*)g.A + (size_t)nxt.pm * tstep : cA; const char* nB = has_next ? (const char*)g.Bt + (size_t)nxt.pn * tstep : cB;
        for (int t = 0; t < nt; t += 2) {
            const bool last = (t == nt - 2);
            const char* a1 = cA + (size_t)(t + 1) * kstep;
            const char* a2 = last ? nA : cA + (size_t)(t + 2) * kstep; const char* b2 = last ? nB : cB + (size_t)(t + 2) * kstep;
            const char* a3 = a2 + kstep; const char* b3 = b2 + kstep;
            if (last && has_next) S.a_ready(nxt);
            if constexpr (SP2) {
            PG8_LDB(B0, 0, 0); PG8_LDB(B1, 0, 1); PG8_SCHED; PG8_LDA(At, 0, 0); PG8_STAGE(PG8_SA(1, 1), a1 + hstep, voffA);
            PG8_WAIT_V(8); PG8_WAIT_L(0); PG8_BAR; PG8_MMA(0, 0, At, B0); PG8_MMA(0, 1, At, B1); PG8_BAR; PG8_SCHED;
            PG8_LDA(At, 0, 1); PG8_STAGE(PG8_SB(0, 0), b2, voffB); PG8_STAGE(PG8_SB(0, 1), b2 + hstep, voffB); PG8_STAGE(PG8_SA(0, 0), a2, voffA);
            PG8_WAIT_V(8); PG8_WAIT_L(0); PG8_BAR; PG8_MMA(1, 0, At, B0); PG8_MMA(1, 1, At, B1); PG8_BAR; PG8_SCHED;
            PG8_LDB(B0, 1, 0); PG8_LDB(B1, 1, 1); PG8_SCHED; PG8_LDA(At, 1, 0); PG8_STAGE(PG8_SA(0, 1), a2 + hstep, voffA);
            PG8_WAIT_V(8); PG8_WAIT_L(0); PG8_BAR; PG8_MMA(0, 0, At, B0); PG8_MMA(0, 1, At, B1); PG8_BAR; PG8_SCHED;
            PG8_LDA(At, 1, 1); PG8_STAGE(PG8_SB(1, 0), b3, voffB); PG8_STAGE(PG8_SB(1, 1), b3 + hstep, voffB); PG8_STAGE(PG8_SA(1, 0), a3, voffA);
            PG8_WAIT_V(8); PG8_WAIT_L(0); PG8_BAR; PG8_MMA(1, 0, At, B0); PG8_MMA(1, 1, At, B1); PG8_BAR; PG8_SCHED;
            } else {
            PG8_LDB(B0, 0, 0); PG8_SCHED; PG8_LDA(At, 0, 0); PG8_STAGE(PG8_SA(1, 1), a1 + hstep, voffA);
            PG8_WAIT_L(8); PG8_BAR; PG8_WAIT_L(0); PG8_MMA(0, 0, At, B0); PG8_BAR; PG8_SCHED;
            PG8_LDB(B1, 0, 1); PG8_STAGE(PG8_SB(0, 0), b2, voffB);
            PG8_BAR; PG8_WAIT_L(0); PG8_MMA(0, 1, At, B1); PG8_BAR;
            PG8_LDA(At, 0, 1); PG8_STAGE(PG8_SA(0, 0), a2, voffA);
            PG8_BAR; PG8_WAIT_L(0); PG8_MMA(1, 0, At, B0); PG8_BAR; PG8_SCHED;
            PG8_STAGE(PG8_SB(0, 1), b2 + hstep, voffB);
            PG8_WAIT_V(6); PG8_BAR; PG8_MMA(1, 1, At, B1); PG8_BAR;
            PG8_LDB(B0, 1, 0); PG8_SCHED; PG8_LDA(At, 1, 0); PG8_STAGE(PG8_SA(0, 1), a2 + hstep, voffA);
            PG8_WAIT_L(8); PG8_BAR; PG8_WAIT_L(0); PG8_MMA(0, 0, At, B0); PG8_BAR; PG8_SCHED;
            PG8_LDB(B1, 1, 1); PG8_STAGE(PG8_SB(1, 0), b3, voffB);
            PG8_BAR; PG8_WAIT_L(0); PG8_MMA(0, 1, At, B1); PG8_BAR;
            PG8_LDA(At, 1, 1); PG8_STAGE(PG8_SA(1, 0), a3, voffA);
            PG8_BAR; PG8_WAIT_L(0); PG8_MMA(1, 0, At, B0); PG8_BAR; PG8_SCHED;
            PG8_STAGE(PG8_SB(1, 1), b3 + hstep, voffB);
            PG8_WAIT_V(6); PG8_BAR; PG8_MMA(1, 1, At, B1); PG8_BAR;
            }
        }
        if constexpr (ALIGN_EPI) { if (wr == 0) PG8_BAR; }
        E(acc, cur, wr, wc, fr, fq); S.done(cur);
        if (!has_next) break;
#pragma unroll
        for (int a = 0; a < 2; ++a)
#pragma unroll
            for (int b = 0; b < 2; ++b)
#pragma unroll
                for (int m = 0; m < 4; ++m)
#pragma unroll
                    for (int n = 0; n < 2; ++n) acc[a][b][m][n] = (f32x4){0.f, 0.f, 0.f, 0.f};
        cur = nxt; cA = nA; cB = nB; ++ui;
        if constexpr (ALIGN_EPI) { if (wr == 1) PG8_BAR; }
    }
    PG8_WAIT_V(0);
    if constexpr (!ALIGN_EPI) { if (wr == 0) PG8_BAR; }
    PG8_BAR;
#undef PG8_SA
#undef PG8_SB
#undef PG8_STAGE
#undef PG8_LDA
#undef PG8_LDB
#undef PG8_MMA
#undef PG8_WAIT_V
#undef PG8_WAIT_L
#undef PG8_BAR
#undef PG8_SCHED
}
}

#define EPI_ROWS _Pragma("unroll") for (int ai = 0; ai < 2; ++ai) _Pragma("unroll") for (int m = 0; m < 4; ++m)
#define EPI_BJ _Pragma("unroll") for (int bj = 0; bj < 2; ++bj)
__device__ __forceinline__ void ld_h8(const h16* p, f32x4& a, f32x4& b) { const u32x4 w = *(const u32x4*)p; const h16x8 h = __builtin_bit_cast(h16x8, w);
    a = (f32x4){(float)h[0], (float)h[1], (float)h[2], (float)h[3]}; b = (f32x4){(float)h[4], (float)h[5], (float)h[6], (float)h[7]}; }
__device__ __forceinline__ float ssq8(const f32x4& v0, const f32x4& v1) { return ((v0[0] * v0[0] + v0[1] * v0[1]) + (v0[2] * v0[2] + v0[3] * v0[3])) + ((v1[0] * v1[0] + v1[1] * v1[1]) + (v1[2] * v1[2] + v1[3] * v1[3])); }

struct EpiInProj {
    const float* rs1; h16* AQ; h16* AK; h16* AV; h16* BQ; float* RAW4; h16* IQ; h16* GATES; const float* bg;
    __device__ __forceinline__ void operator()(const f32x4 (&acc)[2][2][4][2], const pg8::Unit& u, int wr, int wc, int fr, int fq) const {
        const int pn = u.pn, row0 = u.pm * 256 + wr * 64 + fr, ct = wc * 32 + 8 * fq;
        if (pn >= 6) {
            const int gc0 = (pn - 6) * 256 + ct;
            f32x4 b[2][2];
            EPI_BJ { b[bj][0] = *(const f32x4*)(bg + gc0 + bj * 128); b[bj][1] = *(const f32x4*)(bg + gc0 + bj * 128 + 4); }
            EPI_ROWS { const int row = row0 + ai * 128 + m * 16; const float s = rs1[row]; h16* rp = GATES + (size_t)row * 2048 + gc0;
                EPI_BJ { f32x4 v0 = acc[ai][bj][m][0] * s + b[bj][0], v1 = acc[ai][bj][m][1] * s + b[bj][1];
                    _Pragma("unroll") for (int e = 0; e < 4; ++e) { v0[e] = sigmoidf_fast(v0[e]); v1[e] = sigmoidf_fast(v1[e]); }
                    *(u32x4*)(rp + bj * 128) = pk_h8(v0, v1); } }
        } else if (pn == 4) {
            EPI_ROWS { const int row = row0 + ai * 128 + m * 16; const float s = rs1[row]; float* rp = RAW4 + (size_t)row * 256 + ct;
                EPI_BJ { *(f32x4*)(rp + bj * 128) = acc[ai][bj][m][0] * s; *(f32x4*)(rp + bj * 128 + 4) = acc[ai][bj][m][1] * s; } }
        } else if (pn == 2) {
            EPI_ROWS { const int row = row0 + ai * 128 + m * 16; const float s = rs1[row]; const size_t prow = (size_t)(row >> 11) * P + BLK + (row & 2047);
                *(u32x4*)(AK + prow * 128 + ct) = pk_h8(acc[ai][0][m][0] * s, acc[ai][0][m][1] * s);
                *(u32x4*)(AV + prow * 128 + ct) = pk_h8(acc[ai][1][m][0] * s, acc[ai][1][m][1] * s); }
        } else {
            h16* base = pn < 2 ? AQ + pn * 256 : (pn == 3 ? BQ : IQ); const int ld = pn < 2 ? 512 : 256;
            EPI_ROWS { const int row = row0 + ai * 128 + m * 16; const float s = rs1[row]; h16* rp = base + (size_t)row * ld + ct;
                EPI_BJ *(u32x4*)(rp + bj * 128) = pk_h8(acc[ai][bj][m][0] * s, acc[ai][bj][m][1] * s); }
        }
    }
};
struct EpiH16 {
    h16* O; int ldc;
    __device__ __forceinline__ void operator()(const f32x4 (&acc)[2][2][4][2], const pg8::Unit& u, int wr, int wc, int fr, int fq) const {
        const int row0 = u.pm * 256 + wr * 64 + fr, col0 = u.pn * 256 + wc * 32 + 8 * fq;
        EPI_ROWS { const int row = row0 + ai * 128 + m * 16; h16* rp = O + (size_t)row * ldc + col0;
            EPI_BJ *(u32x4*)(rp + bj * 128) = pk_h8(acc[ai][bj][m][0], acc[ai][bj][m][1]); }
    }
};
template <bool ACCUM> struct EpiGate {
    const h16* G; h16* O;
    __device__ __forceinline__ void operator()(const f32x4 (&acc)[2][2][4][2], const pg8::Unit& u, int wr, int wc, int fr, int fq) const {
        const int row0 = u.pm * 256 + wr * 64 + fr, col0 = u.pn * 256 + wc * 32 + 8 * fq;
        EPI_ROWS { const int row = row0 + ai * 128 + m * 16; const h16* gp = G + (size_t)row * 2048 + col0; h16* rp = O + (size_t)row * 1024 + col0;
            EPI_BJ { f32x4 g0, g1; ld_h8(gp + bj * 128, g0, g1); f32x4 v0 = acc[ai][bj][m][0] * g0, v1 = acc[ai][bj][m][1] * g1;
                if (ACCUM) { f32x4 t0, t1; ld_h8(rp + bj * 128, t0, t1); v0 += t0; v1 += t1; }
                *(u32x4*)(rp + bj * 128) = pk_h8(v0, v1); } }
    }
};
struct EpiWo {
    const float* x; h16* H1; float* SSQ;
    __device__ __forceinline__ void operator()(const f32x4 (&acc)[2][2][4][2], const pg8::Unit& u, int wr, int wc, int fr, int fq) const {
        const int row0 = u.pm * 256 + wr * 64 + fr, col0 = u.pn * 256 + wc * 32 + 8 * fq;
        EPI_ROWS { const int row = row0 + ai * 128 + m * 16; const float* xp = x + (size_t)row * 1024 + col0; h16* rp = H1 + (size_t)row * 1024 + col0; float q = 0.f;
            EPI_BJ { const f32x4 v0 = acc[ai][bj][m][0] + *(const f32x4*)(xp + bj * 128), v1 = acc[ai][bj][m][1] + *(const f32x4*)(xp + bj * 128 + 4);
                q += ssq8(v0, v1); *(u32x4*)(rp + bj * 128) = pk_h8(v0, v1); }
            q += __shfl_xor(q, 16); q += __shfl_xor(q, 32);
            if (fq == 0) SSQ[(size_t)row * 16 + u.pn * 4 + wc] = q; }
    }
};
__device__ __forceinline__ float row_rs16(const float* ssq_row) {
    const f32x4* sp = (const f32x4*)ssq_row; const f32x4 s0 = sp[0], s1 = sp[1], s2 = sp[2], s3 = sp[3];
    const float ss = (((s0[0] + s0[1]) + (s0[2] + s0[3])) + ((s1[0] + s1[1]) + (s1[2] + s1[3]))) + (((s2[0] + s2[1]) + (s2[2] + s2[3])) + ((s3[0] + s3[1]) + (s3[2] + s3[3])));
    return __builtin_amdgcn_rsqf(ss * (1.0f / 1024.0f) + EPS);
}
struct EpiSwiGLU {
    const float* SSQ; h16* ACT;
    __device__ __forceinline__ void operator()(const f32x4 (&acc)[2][2][4][2], const pg8::Unit& u, int wr, int wc, int fr, int fq) const {
        const int row0 = u.pm * 256 + wr * 64 + fr, col0 = u.pn * 128 + wc * 32 + 8 * fq;
        EPI_ROWS { const int row = row0 + ai * 128 + m * 16; const float rs = row_rs16(SSQ + (size_t)row * 16);
            f32x4 o[2];
            _Pragma("unroll") for (int n = 0; n < 2; ++n)
                _Pragma("unroll") for (int e = 0; e < 4; ++e) { const float g = acc[ai][0][m][n][e] * rs, up = acc[ai][1][m][n][e] * rs; o[n][e] = g * sigmoidf_fast(g) * up; }
            *(u32x4*)(ACT + (size_t)row * DFF + col0) = pk_h8(o[0], o[1]); }
    }
};
struct EpiDown {
    const h16* H1; float* OUT; float* SSQ;
    __device__ __forceinline__ void operator()(const f32x4 (&acc)[2][2][4][2], const pg8::Unit& u, int wr, int wc, int fr, int fq) const {
        const int row0 = u.pm * 256 + wr * 64 + fr, col0 = u.pn * 256 + wc * 32 + 8 * fq;
        EPI_ROWS { const int row = row0 + ai * 128 + m * 16; const h16* hp = H1 + (size_t)row * 1024 + col0; float* rp = OUT + (size_t)row * 1024 + col0; float q = 0.f;
            EPI_BJ { f32x4 h0, h1; ld_h8(hp + bj * 128, h0, h1); const f32x4 v0 = acc[ai][bj][m][0] + h0, v1 = acc[ai][bj][m][1] + h1;
                q += ssq8(v0, v1); *(f32x4*)(rp + bj * 128) = v0; *(f32x4*)(rp + bj * 128 + 4) = v1; }
            q += __shfl_xor(q, 16); q += __shfl_xor(q, 32);
            if (fq == 0) SSQ[(size_t)row * 16 + u.pn * 4 + wc] = q; }
    }
};

constexpr size_t MiB = 1u << 20;
constexpr size_t WS_CTL = 0, CTL_ZERO_BYTES = 65536;
constexpr size_t WS_WIN = 2 * MiB, WS_WQABS = 9 * MiB, WS_WA = 10 * MiB, WS_WUVB = 11 * MiB, WS_WO = 13 * MiB, WS_WGU = 15 * MiB, WS_WD = 26 * MiB;
constexpr size_t WS_RS1 = 32 * MiB, WS_RSQ = WS_RS1 + 256 * 1024, WS_IWS = 33 * MiB, WS_SSQ1 = 34 * MiB, WS_SSQ2 = 38 * MiB, WS_METAP = 42 * MiB, WS_TBL = WS_METAP + 512 * 1024;
constexpr size_t KVROWS = (size_t)BATCH * P;
constexpr size_t WS_AK = 44 * MiB, WS_AV = 61 * MiB, WS_CKV = 78 * MiB, WS_IKN = 95 * MiB;
constexpr size_t WS_OA = 104 * MiB, WS_GATES = 168 * MiB;
constexpr size_t WS_AQ = 424 * MiB, WS_BQ = 488 * MiB, WS_IQ = 520 * MiB, WS_H1 = 424 * MiB;
constexpr size_t WS_XH = 552 * MiB, WS_MIXED = 552 * MiB, WS_QABS = 680 * MiB, WS_RAW4 = 808 * MiB, WS_LAT = 808 * MiB, WS_ACT = 552 * MiB, WS_END = 936 * MiB;
static_assert(WS_WIN + (size_t)DINP * D * 2 <= WS_WQABS && WS_WGU + (size_t)NGU * D * 2 <= WS_WD && WS_WD + (size_t)D * DFF * 2 <= WS_RS1, "weights map");
static_assert(WS_AK + KVROWS * 256 <= WS_AV && WS_CKV + KVROWS * 256 <= WS_IKN && WS_IKN + KVROWS * 128 <= WS_OA, "kv map");
static_assert(WS_ACT + (size_t)M * DFF * 2 <= WS_END && WS_LAT + (size_t)M * 1024 * 2 <= WS_END && WS_TBL + 16 * 132 * 4 <= WS_AK, "act map");
constexpr int CW_TMO = 0, CW_BAR = 4096;
constexpr int TBLW = 132;

constexpr int RING_OFF = 0, RING_BYTES = 131072;
constexpr int LDSCTL_OFF = RING_BYTES, MISC_OFF = LDSCTL_OFF + 320;
constexpr int LDS_BYTES = 147456;
constexpr int NWAVES = 8;

#define RLX_AGENT __ATOMIC_RELAXED, __HIP_MEMORY_SCOPE_AGENT
#define LDS_WAIT() asm volatile("s_waitcnt lgkmcnt(0)" ::: "memory")
#define VM_WAIT() asm volatile("s_waitcnt vmcnt(0)" ::: "memory")

#define XB_TMO      128
#define XB_XCNT(j)  (256  + 64 * (j))
#define XB_XSUB(j)  (1280 + 64 * (j))
#define XB_XGEN(j)  (2304 + 64 * (j))
#define XB_TOP      3328
#define XB_TOPGEN   3392
#define XCD_BAR_WORDS 3456
#define XB_SPIN_CAP (1u << 18)
__device__ __forceinline__ unsigned xb_ld(unsigned* p)              { return __hip_atomic_load(p, __ATOMIC_RELAXED, __HIP_MEMORY_SCOPE_AGENT); }
__device__ __forceinline__ unsigned xb_add(unsigned* p, unsigned v) { return __hip_atomic_fetch_add(p, v, __ATOMIC_RELAXED, __HIP_MEMORY_SCOPE_AGENT); }
__device__ __forceinline__ unsigned xb_xcc_id() { return (unsigned)__builtin_amdgcn_s_getreg((3 << 11) | 20) & 0xFu; }
#define XB_SPIN(cond, bar) do { unsigned _sp = 0; while (cond) { __builtin_amdgcn_s_sleep(1); \
    if ((++_sp & 255u) == 0u) { if (xb_ld(&(bar)[XB_TMO])) break; if (_sp > XB_SPIN_CAP) { atomicAdd(&(bar)[XB_TMO], 1u); break; } } } } while (0)
struct XcdBarrier { unsigned* bar; unsigned x; volatile LAS unsigned* st; };
__device__ __forceinline__ XcdBarrier xcd_barrier_post(unsigned* bar, volatile LAS unsigned* st) {
    XcdBarrier b; b.bar = bar; b.x = xb_xcc_id(); b.st = st;
    if (threadIdx.x == 0) (void)xb_add(&bar[XB_XCNT(b.x)], 1u);
    return b;
}
__device__ __forceinline__ void xcd_barrier_complete(unsigned* bar, unsigned x, unsigned& nloc, unsigned& nx) {
    const unsigned G = gridDim.x * gridDim.y * gridDim.z;
    unsigned sum, cnt, mine, sp = 0u;
    for (;;) {
        sum = 0u; cnt = 0u; mine = 0u;
#pragma unroll
        for (unsigned j = 0; j < 16; ++j) { const unsigned c = xb_ld(&bar[XB_XCNT(j)]); sum += c; cnt += (c > 0u) ? 1u : 0u; mine = (j == x) ? c : mine; }
        if (sum == G) break;
        __builtin_amdgcn_s_sleep(1);
        if ((++sp & 255u) == 0u) { if (xb_ld(&bar[XB_TMO])) break; if (sp > XB_SPIN_CAP) { atomicAdd(&bar[XB_TMO], 1u); break; } }
    }
    nloc = mine > 0u ? mine : 1u; nx = cnt > 0u ? cnt : 1u;
}
__device__ __forceinline__ void xcd_barrier(const XcdBarrier& b) {
    asm volatile("s_waitcnt vmcnt(0)" ::: "memory");
    __syncthreads();
    if (threadIdx.x == 0) {
        unsigned* bar = b.bar;
        __builtin_amdgcn_s_waitcnt(0);
        unsigned nloc = b.st[0], nx = b.st[1];
        if (nloc == 0u) { xcd_barrier_complete(bar, b.x, nloc, nx); b.st[0] = nloc; b.st[1] = nx; }
        const unsigned old = xb_add(&bar[XB_XSUB(b.x)], 1u);
        const unsigned gen = old / nloc;
        if (old + 1u == (gen + 1u) * nloc) {
            __builtin_amdgcn_fence(__ATOMIC_RELEASE, "agent");
            asm volatile("s_waitcnt vmcnt(0)" ::: "memory");
            const unsigned og = xb_add(&bar[XB_TOP], 1u);
            const unsigned tg = og / nx;
            if (og + 1u == (tg + 1u) * nx) xb_add(&bar[XB_TOPGEN], 1u);
            else XB_SPIN(xb_ld(&bar[XB_TOPGEN]) == tg, bar);
            __builtin_amdgcn_fence(__ATOMIC_ACQUIRE, "agent");
            xb_add(&bar[XB_XGEN(b.x)], 1u);
            asm volatile("s_waitcnt vmcnt(0)" ::: "memory");
        } else {
            XB_SPIN(xb_ld(&bar[XB_XGEN(b.x)]) == gen, bar);
            __builtin_amdgcn_fence(__ATOMIC_ACQUIRE, "agent");
            asm volatile("s_waitcnt vmcnt(0)" ::: "memory");
        }
    }
    __syncthreads();
}

struct Frame {
    LAS unsigned char* lds;
    int tid, lane, wave, vcu, G;
    const float *x, *meta, *g1, *w_in, *bg, *qg, *kvg, *w_uq, *w_uk, *w_uv, *lng, *lnb, *sinks, *relb, *w_a, *w_b, *w_o, *g2, *w_g, *w_u, *w_d, *gf;
    float* out;
    h16 *Win_t, *Wqabs_t, *Wa_t, *Wuvb_t, *Wo_t, *Wgu_t, *Wd_t;
    float *RS1, *RSQ, *IWS, *SSQ1, *SSQ2, *METAP, *TBL, *RAW4;
    h16 *AK, *AV, *CKV, *IKN, *OA, *GATES, *AQ, *BQ, *IQ, *H1, *XH, *MIXED, *QABS, *LAT, *ACT;
};
__device__ __forceinline__ float wave_sum(float v) {
#pragma unroll
    for (int o = 1; o < 64; o <<= 1) v += __shfl_xor(v, o);
    return v;
}

__device__ __forceinline__ int inmap(int n) {
    if (n < 1152) return n;
    if (n < 1216) return 1408 + (n - 1152);
    if (n < 1220) return 1472 + (n - 1216);
    if (n < 1280) return -1;
    if (n < 1536) return 1152 + (n - 1280);
    return 1476 + (n - 1536);
}
template <int MODE> __device__ __forceinline__ void p0_transpose_item(const float* W, const float* W2, int ldw, int K, int N, const float* gain, h16* WT, LAS float* scr, int item, int lane) {
    const int nblk = N / 32, kb = item / nblk, nb = item % nblk, k0 = 64 * kb, n0 = 32 * nb, n = n0 + (lane & 31);
    const float* src = W; int oc = n; float cs = 1.f;
    if (MODE == 0) { oc = inmap(n); if (n < 512) cs = QSCALE; }
    if (MODE == 3) { const int pp = n >> 8, j = n & 255; oc = 128 * pp + (j & 127); src = (j < 128) ? W : W2; }
#pragma unroll 16
    for (int i = 0; i < 32; ++i) { const int kk = 2 * i + (lane >> 5); float v = 0.f; if (oc >= 0) v = src[(size_t)(k0 + kk) * ldw + oc]; if (gain) v *= gain[k0 + kk]; scr[kk * 33 + (lane & 31)] = v * cs; }
    LDS_WAIT(); asm volatile("" ::: "memory");
    const int c = lane & 7;
#pragma unroll
    for (int j = 0; j < 4; ++j) { const int nn = (lane >> 3) + 8 * j; const LAS float* s = scr + (8 * c) * 33 + nn;
        u32x4 o; o.x = pk_h2(s[0 * 33], s[1 * 33]); o.y = pk_h2(s[2 * 33], s[3 * 33]); o.z = pk_h2(s[4 * 33], s[5 * 33]); o.w = pk_h2(s[6 * 33], s[7 * 33]);
        *(u32x4*)(WT + (size_t)(n0 + nn) * K + k0 + 8 * c) = o; }
    LDS_WAIT(); asm volatile("" ::: "memory");
}
__device__ __forceinline__ int t5_bucket_d(int dist) {
    if (dist < 16) return dist;
    int large = 16 + (int)(log((double)dist / 16.0) / log(8.0) * 16.0);
    return large < 31 ? large : 31;
}
__device__ __forceinline__ void p0_prologue(Frame& F) {
    LAS float* scr = (LAS float*)(F.lds + RING_OFF + F.wave * 16384);
    const int gw = F.vcu * NWAVES + F.wave, NGW = F.G * NWAVES, lane = F.lane;
    constexpr int I_IN = (D / 64) * (DINP / 32), I_A = (512 / 64) * (D / 32), I_O = (D / 64) * (D / 32), I_GU = (D / 64) * (NGU / 32), I_D = (DFF / 64) * (D / 32);
    constexpr int I_QABS = 1024 * 4, I_UVB = 8 * 16 * 8, I_META = 7 * 8, I_TBL = 1;
    constexpr int NITEMS = I_IN + I_A + I_O + I_GU + I_D + I_QABS + I_UVB + I_META + I_TBL;
    for (int it = gw; it < NITEMS; it += NGW) {
        int r = it;
        if (r < I_IN) { p0_transpose_item<0>(F.w_in, nullptr, DIN, D, DINP, F.g1, F.Win_t, scr, r, lane); continue; } r -= I_IN;
        if (r < I_A) { p0_transpose_item<1>(F.w_a, nullptr, D, 512, D, nullptr, F.Wa_t, scr, r, lane); continue; } r -= I_A;
        if (r < I_O) { p0_transpose_item<1>(F.w_o, nullptr, D, D, D, nullptr, F.Wo_t, scr, r, lane); continue; } r -= I_O;
        if (r < I_GU) { p0_transpose_item<3>(F.w_g, F.w_u, DFF, D, NGU, F.g2, F.Wgu_t, scr, r, lane); continue; } r -= I_GU;
        if (r < I_D) { p0_transpose_item<1>(F.w_d, nullptr, D, DFF, D, nullptr, F.Wd_t, scr, r, lane); continue; } r -= I_D;
        if (r < I_QABS) {
            const int n = r >> 2, rr = (r & 3) * 64 + lane, h = n >> 7, c = n & 127;
            const f32x4* uq = (const f32x4*)(F.w_uq + (size_t)rr * 512 + h * 64); const f32x4* uk = (const f32x4*)(F.w_uk + (size_t)c * 512 + h * 64);
            float a = 0.f;
#pragma unroll 8
            for (int d = 0; d < 16; ++d) { const f32x4 p = uq[d], q = uk[d]; a += (p[0] * q[0] + p[1] * q[1]) + (p[2] * q[2] + p[3] * q[3]); }
            F.Wqabs_t[(size_t)n * 256 + rr] = __builtin_bit_cast(h16, (_Float16)(a * QSCALE * F.qg[rr]));
            continue; } r -= I_QABS;
        if (r < I_UVB) {
            const int h = r >> 7, ng = (r >> 3) & 15, cg = r & 7, n = ng * 64 + lane;
            const float* wb = F.w_b + (size_t)(h * 64) * 1024 + n; const float* uv = F.w_uv + (size_t)(cg * 16) * 512 + h * 64;
            float a[16];
#pragma unroll
            for (int q = 0; q < 16; ++q) a[q] = 0.f;
#pragma unroll 4
            for (int d = 0; d < 64; ++d) { const float wv_ = wb[(size_t)d * 1024];
#pragma unroll
                for (int q = 0; q < 16; ++q) a[q] += uv[q * 512 + d] * wv_; }
            u32x4 o0, o1;
            o0.x = pk_h2(a[0], a[1]); o0.y = pk_h2(a[2], a[3]); o0.z = pk_h2(a[4], a[5]); o0.w = pk_h2(a[6], a[7]);
            o1.x = pk_h2(a[8], a[9]); o1.y = pk_h2(a[10], a[11]); o1.z = pk_h2(a[12], a[13]); o1.w = pk_h2(a[14], a[15]);
            h16* op = F.Wuvb_t + (size_t)n * 1024 + h * 128 + cg * 16;
            *(u32x4*)op = o0; *(u32x4*)(op + 8) = o1;
            continue; } r -= I_UVB;
        if (r < I_META) {
            const int cg = r >> 3, kc = r & 7, ci = cg * 64 + lane;
            const int oc = ci < 128 ? 512 + ci : (ci < 256 ? 640 + (ci - 128) : (ci < 384 ? 1024 + (ci - 256) : 1408 + (ci - 384)));
#pragma unroll 4
            for (int e = lane; e < 16 * 128; e += 64) { const int q = e >> 7, kk = e & 127; scr[kk * 16 + q] = F.meta[q * 1024 + kc * 128 + kk] * F.g1[kc * 128 + kk]; }
            LDS_WAIT(); asm volatile("" ::: "memory");
            float a[16];
#pragma unroll
            for (int q = 0; q < 16; ++q) a[q] = 0.f;
            const float* wp = F.w_in + (size_t)(kc * 128) * DIN + oc;
#pragma unroll 8
            for (int kk = 0; kk < 128; ++kk) { const float w = wp[(size_t)kk * DIN];
                const LAS f32x4* mp = (const LAS f32x4*)(scr + kk * 16);
#pragma unroll
                for (int q4 = 0; q4 < 4; ++q4) { const f32x4 mv = mp[q4];
#pragma unroll
                    for (int e = 0; e < 4; ++e) a[4 * q4 + e] += mv[e] * w; } }
#pragma unroll
            for (int q = 0; q < 16; ++q) F.METAP[(size_t)(kc * 16 + q) * 448 + ci] = a[q];
            LDS_WAIT(); asm volatile("" ::: "memory");
            continue; } r -= I_META;
        {
            for (int e = lane; e < 16 * 129; e += 64) { const int hh = e / 129, dd = e % 129; F.TBL[hh * TBLW + dd] = LOG2E * F.relb[t5_bucket_d(dd) * 16 + hh]; }
        }
    }
    for (int row = 2 * gw; row < M; row += 2 * NGW) {
        const f32x4* xr = (const f32x4*)(F.x + (size_t)row * D) + lane; f32x4 v[8]; float s0 = 0.f, s1 = 0.f;
#pragma unroll
        for (int j = 0; j < 8; ++j) v[j] = xr[64 * j];
#pragma unroll
        for (int j = 0; j < 4; ++j) { s0 += (v[j][0] * v[j][0] + v[j][1] * v[j][1]) + (v[j][2] * v[j][2] + v[j][3] * v[j][3]);
            s1 += (v[j + 4][0] * v[j + 4][0] + v[j + 4][1] * v[j + 4][1]) + (v[j + 4][2] * v[j + 4][2] + v[j + 4][3] * v[j + 4][3]); }
#pragma unroll
        for (int o = 1; o < 64; o <<= 1) { s0 += __shfl_xor(s0, o); s1 += __shfl_xor(s1, o); }
        if (lane == 0) { F.RS1[row] = 1.0f / sqrtf(s0 * (1.0f / D) + EPS); F.RS1[row + 1] = 1.0f / sqrtf(s1 * (1.0f / D) + EPS); }
        u32x2* o8 = (u32x2*)(F.XH + (size_t)row * D) + lane;
#pragma unroll
        for (int j = 0; j < 8; ++j) { u32x2 w; w.x = pk_h2(v[j][0], v[j][1]); w.y = pk_h2(v[j][2], v[j][3]); o8[64 * j] = w; }
    }
}

__device__ __forceinline__ void p2_norms(Frame& F) {
    const int gw = F.vcu * NWAVES + F.wave, NGW = F.G * NWAVES, lane = F.lane;
    const float kg0 = F.kvg[2 * lane], kg1 = F.kvg[2 * lane + 1], lg = F.lng[lane], lb = F.lnb[lane];
    for (int row = gw; row < M; row += NGW) {
        const float* rw = F.RAW4 + (size_t)row * 256; const size_t prow = (size_t)(row >> 11) * P + BLK + (row & 2047);
        const float b0 = rw[2 * lane], b1 = rw[2 * lane + 1], ik = rw[128 + lane];
        const float rk = 1.0f / sqrtf(wave_sum(b0 * b0 + b1 * b1) * (1.0f / 128.0f) + EPS);
        ((unsigned*)(F.CKV + prow * 128))[lane] = pk_h2(b0 * rk * kg0, b1 * rk * kg1);
        const float mu = wave_sum(ik) * (1.0f / 64.0f), dc = ik - mu, var = wave_sum(dc * dc) * (1.0f / 64.0f);
        F.IKN[prow * 64 + lane] = __builtin_bit_cast(h16, (_Float16)(dc * (1.0f / sqrtf(var + EPS)) * lg + lb));
        if (lane < 4) F.IWS[(size_t)row * 4 + lane] = rw[192 + lane] * 0.0625f;
        const u32x2 qw = ((const u32x2*)(F.BQ + (size_t)row * 256))[lane]; const h16x4 qh = __builtin_bit_cast(h16x4, qw);
        const float q0 = (float)qh[0], q1 = (float)qh[1], q2 = (float)qh[2], q3 = (float)qh[3];
        const float sq = wave_sum((q0 * q0 + q1 * q1) + (q2 * q2 + q3 * q3));
        if (lane == 0) F.RSQ[row] = 1.0f / sqrtf(sq * (1.0f / 256.0f) + EPS);
    }
    if (gw < 16) {
        const int r = gw; float s = 0.f;
        for (int k = lane; k < 1024; k += 64) { const float v = F.meta[r * 1024 + k]; s += v * v; }
        const float rsm = 1.0f / sqrtf(wave_sum(s) * (1.0f / D) + EPS);
        float v[7];
#pragma unroll
        for (int cg = 0; cg < 7; ++cg) { float a = 0.f;
#pragma unroll
            for (int kc = 0; kc < 8; ++kc) a += F.METAP[(size_t)(kc * 16 + r) * 448 + cg * 64 + lane];
            v[cg] = a * rsm; }
        const float rk = 1.0f / sqrtf(wave_sum(v[4] * v[4] + v[5] * v[5]) * (1.0f / 128.0f) + EPS);
        const float c0 = v[4] * rk * F.kvg[lane], c1 = v[5] * rk * F.kvg[64 + lane];
        const float mu = wave_sum(v[6]) * (1.0f / 64.0f), dc = v[6] - mu, var = wave_sum(dc * dc) * (1.0f / 64.0f);
        const float ikn = dc * (1.0f / sqrtf(var + EPS)) * lg + lb;
        for (int b = 0; b < BATCH; ++b) { const size_t prow = (size_t)b * P + NPAD + r;
            F.AK[prow * 128 + lane] = __builtin_bit_cast(h16, (_Float16)v[0]); F.AK[prow * 128 + 64 + lane] = __builtin_bit_cast(h16, (_Float16)v[1]);
            F.AV[prow * 128 + lane] = __builtin_bit_cast(h16, (_Float16)v[2]); F.AV[prow * 128 + 64 + lane] = __builtin_bit_cast(h16, (_Float16)v[3]);
            F.CKV[prow * 128 + lane] = __builtin_bit_cast(h16, (_Float16)c0); F.CKV[prow * 128 + 64 + lane] = __builtin_bit_cast(h16, (_Float16)c1);
            F.IKN[prow * 64 + lane] = __builtin_bit_cast(h16, (_Float16)ikn); }
    }
    for (int it = gw; it < BATCH * NPAD; it += NGW) { const size_t prow = (size_t)(it / NPAD) * P + (it % NPAD);
        ((unsigned*)(F.AK + prow * 128))[lane] = 0u; ((unsigned*)(F.AV + prow * 128))[lane] = 0u; ((unsigned*)(F.CKV + prow * 128))[lane] = 0u;
        if (lane < 32) ((unsigned*)(F.IKN + prow * 64))[lane] = 0u; }
}

constexpr int A_KSTR = 144, A_VSTR = 528, A_LDS_K = 0, A_LDS_VT = 256 * A_KSTR, A_LDS_TB = A_LDS_VT + 64 * A_VSTR;
__device__ __forceinline__ void attn_a_phase(Frame& F) {
    LAS unsigned char* lds = F.lds;
    const int lane = F.lane, w = F.wave, tid = F.tid, q32 = lane & 31, hh = lane >> 5;
    const float NINF = -__builtin_inff();
    for (int u = F.vcu; u < BATCH * 16 * 2; u += F.G) {
        const int kvh = u & 1, blk = 1 + ((u >> 1) & 15), b = u >> 5;
        const size_t kbase = (size_t)b * P + (size_t)(blk - 1) * BLK;
        __syncthreads();
#pragma unroll
        for (int i = 0; i < 4; ++i) { const int id = i * 512 + tid, row = id >> 3, ch = id & 7;
            const u32x4 kv = *(const u32x4*)(F.AK + (kbase + row) * 128 + kvh * 64 + ch * 8);
            *(LAS u32x4*)(lds + A_LDS_K + row * A_KSTR + ch * 16) = kv;
            const u32x4 vv = *(const u32x4*)(F.AV + (kbase + row) * 128 + kvh * 64 + ch * 8);
            const int pk = (row & ~12) | ((row & 4) << 1) | ((row & 8) >> 1);
#pragma unroll
            for (int e = 0; e < 8; ++e) *(LAS h16*)(lds + A_LDS_VT + (ch * 8 + e) * A_VSTR + pk * 2) = (h16)((vv[e >> 1] >> (16 * (e & 1))) & 0xffffu); }
        ((LAS float*)(lds + A_LDS_TB))[tid] = F.TBL[(kvh * 4 + (tid >> 7)) * TBLW + (tid & 127)];
        __syncthreads();
        const int g = w & 3, head = kvh * 4 + g;
        const float sink = F.sinks[head] * LOG2E;
        const LAS float* TB = (const LAS float*)(lds + A_LDS_TB) + g * 128;
        for (int qq = 0; qq < 2; ++qq) {
            const int qg = (w >> 2) * 2 + qq, i_loc = qg * 32 + q32;
            const size_t qrow = (size_t)b * SEQ + (size_t)(blk - 1) * BLK + i_loc;
            h16x8 qf[4];
#pragma unroll
            for (int ks = 0; ks < 4; ++ks) qf[ks] = *(const h16x8*)(F.AQ + qrow * 512 + head * 64 + ks * 16 + hh * 8);
            float m_run = sink, l_run = 1.0f;
            f32x16 o0, o1;
#pragma unroll
            for (int r = 0; r < 16; ++r) { o0[r] = 0.f; o1[r] = 0.f; }
            for (int kt = qg; kt <= qg + 4; ++kt) {
                f32x16 s;
#pragma unroll
                for (int r = 0; r < 16; ++r) s[r] = 0.f;
#pragma unroll
                for (int ks = 0; ks < 4; ++ks) { const h16x8 kf = *(const LAS h16x8*)(lds + A_LDS_K + (kt * 32 + q32) * A_KSTR + (ks * 16 + hh * 8) * 2);
                    s = __builtin_amdgcn_mfma_f32_32x32x16_f16(kf, qf[ks], s, 0, 0, 0); }
                float mx = NINF;
#pragma unroll
                for (int r = 0; r < 16; ++r) { const int j = kt * 32 + (r & 3) + 8 * (r >> 2) + 4 * hh, dist = 128 + i_loc - j;
                    const bool valid = (dist >= 0) && (dist < 128) && ((blk - 1) * BLK + j >= NPAD);
                    const float v = valid ? s[r] + TB[dist & 127] : NINF; s[r] = v; mx = fmaxf(mx, v); }
                mx = fmaxf(mx, __shfl_xor(mx, 32));
                const float m_new = fmaxf(m_run, mx), alpha = __builtin_amdgcn_exp2f(m_run - m_new);
                float ps = 0.f;
#pragma unroll
                for (int r = 0; r < 16; ++r) { const float p = __builtin_amdgcn_exp2f(s[r] - m_new); s[r] = p; ps += p; }
                ps += __shfl_xor(ps, 32);
                l_run = l_run * alpha + ps; m_run = m_new;
#pragma unroll
                for (int r = 0; r < 16; ++r) { o0[r] *= alpha; o1[r] *= alpha; }
#pragma unroll
                for (int sx = 0; sx < 2; ++sx) {
                    const u32x4 pw = {pk_h2(s[8 * sx], s[8 * sx + 1]), pk_h2(s[8 * sx + 2], s[8 * sx + 3]), pk_h2(s[8 * sx + 4], s[8 * sx + 5]), pk_h2(s[8 * sx + 6], s[8 * sx + 7])};
                    const h16x8 pf = __builtin_bit_cast(h16x8, pw);
                    const h16x8 va0 = *(const LAS h16x8*)(lds + A_LDS_VT + q32 * A_VSTR + (kt * 32 + 16 * sx + 8 * hh) * 2);
                    const h16x8 va1 = *(const LAS h16x8*)(lds + A_LDS_VT + (32 + q32) * A_VSTR + (kt * 32 + 16 * sx + 8 * hh) * 2);
                    o0 = __builtin_amdgcn_mfma_f32_32x32x16_f16(va0, pf, o0, 0, 0, 0);
                    o1 = __builtin_amdgcn_mfma_f32_32x32x16_f16(va1, pf, o1, 0, 0, 0); }
            }
            const float inv = 1.0f / l_run;
            h16* op = F.OA + qrow * 512 + head * 64 + 4 * hh;
#pragma unroll
            for (int g4 = 0; g4 < 4; ++g4) {
                u32x2 w0, w1; w0.x = pk_h2(o0[4 * g4] * inv, o0[4 * g4 + 1] * inv); w0.y = pk_h2(o0[4 * g4 + 2] * inv, o0[4 * g4 + 3] * inv);
                w1.x = pk_h2(o1[4 * g4] * inv, o1[4 * g4 + 1] * inv); w1.y = pk_h2(o1[4 * g4 + 2] * inv, o1[4 * g4 + 3] * inv);
                *(u32x2*)(op + 8 * g4) = w0; *(u32x2*)(op + 32 + 8 * g4) = w1; }
        }
    }
    __syncthreads();
}

constexpr int L3_STAGE = 0, L3_SEL = 65536, L3_HIST = L3_SEL + 16 * 256 * 2, L3_DUMMY = L3_HIST + 256 * 16 * 4  ,
              L3_RES = L3_DUMMY + 512 * 4, L3_CNT2 = L3_RES + 256, L3_TB = L3_CNT2 + 16 * 32 * 4, L3_END = L3_TB + 8 * TBLW * 4;
static_assert(L3_END <= RING_BYTES, "P3 LDS map");
__device__ __forceinline__ unsigned off_b(unsigned row, unsigned ch) { return 256u * row + 16u * (ch ^ (((row & 3u) << 2) | ((row >> 2) & 3u))); }
__device__ __forceinline__ h16x4 ds_tr16(const LAS unsigned char* p) { return __builtin_bit_cast(h16x4, __builtin_amdgcn_ds_read_tr16_b64_v4i16((LAS s16x4*)p)); }
__device__ __forceinline__ void mixer_b_phase(Frame& F) {
    LAS unsigned char* lds = F.lds;
    const int lane = F.lane, w = F.wave, tid = F.tid, n16 = lane & 15, g = lane >> 4;
    const float NINF = -__builtin_inff();
    LAS unsigned short* SEL = (LAS unsigned short*)(lds + L3_SEL);
    LAS unsigned* HIST = (LAS unsigned*)(lds + L3_HIST);
    LAS unsigned* RES = (LAS unsigned*)(lds + L3_RES);
    LAS unsigned* CNT2 = (LAS unsigned*)(lds + L3_CNT2);
    LAS float* TB = (LAS float*)(lds + L3_TB);
    LAS unsigned char* stage = lds + L3_STAGE + w * 8192;
    __syncthreads();
    for (int e = tid; e < 8 * 129; e += 512) { const int hh = e / 129, dd = e % 129; TB[hh * TBLW + dd] = F.TBL[(8 + hh) * TBLW + dd]; }
    for (int e = tid; e < 256 * 16; e += 512) HIST[e] = 0u;
    const int nunits = BATCH * 16 * 8;
    for (int it = 0; ; ++it) {
        int b, blk, sub;
        if (F.G == 256) { if (it >= 16) break; b = 4 * (F.vcu >> 5) + (F.vcu & 3); sub = (F.vcu >> 2) & 7; blk = 1 + it; }
        else { const int uid = F.vcu + it * F.G; if (uid >= nunits) break; b = uid >> 7; sub = (uid >> 4) & 7; blk = 1 + (uid & 15); }
        const int t0 = (blk - 1) * BLK + sub * 16;
        const size_t qrow0 = (size_t)b * SEQ + t0;
        const int qpos = BLK + t0 + n16;
        const int ntile = (blk + 1) * 8;
        const h16* ikb = F.IKN + (size_t)b * P * 64;
        h16x8 qb[4][2];
#pragma unroll
        for (int h = 0; h < 4; ++h)
#pragma unroll
            for (int ks = 0; ks < 2; ++ks) qb[h][ks] = *(const h16x8*)(F.IQ + (qrow0 + n16) * 256 + h * 64 + ks * 32 + 8 * g);
        const f32x4 wv = *(const f32x4*)(F.IWS + (qrow0 + n16) * 4);
        unsigned sk[17][4];
        int kb1 = w * 16 + 4 * g; asm volatile("" : "+v"(kb1));
        const h16* ap = ikb + (size_t)(w * 16 + n16) * 64 + 8 * g;
        h16x8 A0[21], A1[21];
        { const u32x4 z = {0u, 0u, 0u, 0u};
#pragma unroll
          for (int j = 0; j < 21; ++j) { A0[j] = __builtin_bit_cast(h16x8, z); A1[j] = A0[j]; } }
#pragma unroll
        for (int j = 0; j < 4; ++j) if (w + 8 * j < ntile) { A0[j] = *(const h16x8*)(ap + 8192 * j); A1[j] = *(const h16x8*)(ap + 8192 * j + 32); }
        ap += 3 * 8192;
#pragma unroll
        for (int j = 0; j < 17; ++j) {
            const int kt = w + 8 * j;
            ap += 8192; asm volatile("" : "+v"(ap));
            if (j + 4 < 17 && kt + 32 < ntile) { A0[j + 4] = *(const h16x8*)ap; A1[j + 4] = *(const h16x8*)(ap + 32); }
            asm volatile("" ::: "memory");
            if (kt < ntile) {
                float sc[4] = {0.f, 0.f, 0.f, 0.f};
#pragma unroll
                for (int h = 0; h < 4; ++h) { f32x4 c = {0.f, 0.f, 0.f, 0.f};
                    c = __builtin_amdgcn_mfma_f32_16x16x32_f16(A0[j], qb[h][0], c, 0, 0, 0); c = __builtin_amdgcn_mfma_f32_16x16x32_f16(A1[j], qb[h][1], c, 0, 0, 0);
#pragma unroll
                    for (int r = 0; r < 4; ++r) sc[r] += fmaxf(c[r], 0.f) * wv[h]; }
#pragma unroll
                for (int r = 0; r < 4; ++r) { const int kpos = kb1 + 128 * j + r; const unsigned bits = __builtin_bit_cast(unsigned, sc[r]);
                    unsigned key = (sc[r] == 0.f) ? (0x7fffffffu - (unsigned)kpos) : ((bits & 0x80000000u) ? ~bits : (bits | 0x80000000u));
                    if (kpos < NPAD || kpos > qpos) key = 0u;
                    sk[j][r] = key; }
            } else {
#pragma unroll
                for (int r = 0; r < 4; ++r) sk[j][r] = 0u;
            }
        }
        const int nadm = qpos - NPAD + 1;
        unsigned prefix = 0u, T = 1u; int need = nadm < TOPK ? nadm : TOPK; bool done = (nadm <= TOPK);
#pragma unroll 1
        for (int pass = 0; pass < 4; ++pass) {
            if (!__any(!done)) break;
            const int shift = 24 - 8 * pass;
            {
                const unsigned sink = (unsigned)(L3_DUMMY - L3_HIST) / 4u + (unsigned)tid;
                const unsigned pmask = done ? 0xffffffffu : 0u;
#pragma unroll
                for (int j = 0; j < 17; ++j)
#pragma unroll
                    for (int r = 0; r < 4; ++r) { const unsigned uk = sk[j][r];
                        const unsigned mism = (pass == 0 ? 0u : (((uk ^ prefix) >> shift) >> 8)) | pmask | (uk == 0u ? 1u : 0u);
                        const unsigned slot = mism ? sink : ((uk >> shift) & 255u) * 16u + (unsigned)n16;
                        __hip_atomic_fetch_add(HIST + slot, 1u, __ATOMIC_RELAXED, __HIP_MEMORY_SCOPE_WORKGROUP); }
            }
            __syncthreads();
            {
                const int qs = 2 * w + (lane >> 5), l32 = lane & 31;
                unsigned cnt[8]; unsigned t = 0u;
#pragma unroll
                for (int i = 0; i < 8; ++i) { cnt[i] = HIST[(8 * l32 + i) * 16 + qs]; HIST[(8 * l32 + i) * 16 + qs] = 0u; t += cnt[i]; }
                unsigned incl = t;
#pragma unroll
                for (int d = 1; d < 32; d <<= 1) { const unsigned v = (unsigned)__shfl_down((int)incl, d, 32); incl += (l32 + d < 32) ? v : 0u; }
                const unsigned S = incl - t;
                const unsigned mq = (unsigned)__shfl(need, qs); const int dq = __shfl((int)done, qs);
                if (!dq && S < mq && mq <= S + t) {
                    unsigned acc = S, bsel = 0u, msel = 0u, csel = 0u;
#pragma unroll
                    for (int i = 7; i >= 0; --i) { if (acc < mq && mq <= acc + cnt[i]) { bsel = (unsigned)(8 * l32 + i); msel = mq - acc; csel = cnt[i]; } acc += cnt[i]; }
                    RES[qs * 4 + 0] = bsel; RES[qs * 4 + 1] = msel; RES[qs * 4 + 2] = csel;
                }
            }
            __syncthreads();
            if (!done) { const unsigned bsel = RES[n16 * 4 + 0], msel = RES[n16 * 4 + 1], csel = RES[n16 * 4 + 2];
                prefix |= bsel << shift;
                if (csel == msel || pass == 3) { done = true; T = prefix; } else need = (int)msel; }
        }
        {
            int kb2 = w * 16 + 4 * g; asm volatile("" : "+v"(kb2));
            int c = 0;
#pragma unroll
            for (int j = 0; j < 17; ++j)
#pragma unroll
                for (int r = 0; r < 4; ++r) c += (sk[j][r] >= T) ? 1 : 0;
            const int mine = w * 4 + g;
            CNT2[n16 * 32 + mine] = (unsigned)c;
            __syncthreads();
            int off = 0;
#pragma unroll
            for (int o4 = 0; o4 < 8; ++o4) { const u32x4 cv = *(const LAS u32x4*)(CNT2 + n16 * 32 + 4 * o4);
#pragma unroll
                for (int e = 0; e < 4; ++e) off += (4 * o4 + e < mine) ? (int)cv[e] : 0; }
            LAS unsigned short* trash = (LAS unsigned short*)(lds + L3_DUMMY) + tid;
#pragma unroll
            for (int j = 0; j < 17; ++j)
#pragma unroll
                for (int r = 0; r < 4; ++r) { const bool selk = (sk[j][r] >= T) && (off < TOPK);
                    LAS unsigned short* dst = selk ? SEL + n16 * 256 + off : trash;
                    *dst = (unsigned short)(kb2 + 128 * j + r); off += (sk[j][r] >= T) ? 1 : 0; }
            __syncthreads();
        }
        const h16* ckb = F.CKV + (size_t)b * P * 128;
        for (int qq = w; qq < 16; qq += 8) {
            const size_t qrow = qrow0 + qq; const int qp = BLK + t0 + qq;
            const int nsel = (qp - NPAD + 1) < TOPK ? (qp - NPAD + 1) : TOPK, nch = (nsel + 31) >> 5;
            h16x8 qa[4];
#pragma unroll
            for (int ks = 0; ks < 4; ++ks) { const u32x4 z = {0u, 0u, 0u, 0u}; qa[ks] = (n16 < 8) ? *(const h16x8*)(F.QABS + qrow * 1024 + n16 * 128 + ks * 32 + 8 * g) : __builtin_bit_cast(h16x8, z); }
            const float rsq = __builtin_bit_cast(float, __builtin_amdgcn_readfirstlane(__builtin_bit_cast(int, F.RSQ[qrow])));
            const LAS float* tb = TB + (n16 & 7) * TBLW;
            const LAS unsigned short* selq = SEL + qq * 256;
            float m_run = -1e30f, l_run = 0.f;
            f32x4 o[8];
#pragma unroll
            for (int mt = 0; mt < 8; ++mt) o[mt] = (f32x4){0.f, 0.f, 0.f, 0.f};
            u32x4 G[8];
#define MLA_GATHER(c_) do { int i0_ = 32 * (c_) + 8 * g; const u32x4 sv_ = *(const LAS u32x4*)(selq + i0_); \
                _Pragma("unroll") for (int i = 0; i < 8; ++i) { int kp_ = (int)((sv_[i >> 1] >> (16 * (i & 1))) & 0xffffu); kp_ = (i0_ + i < nsel) ? kp_ : qp; \
                G[i] = *(const u32x4*)(ckb + (size_t)kp_ * 128 + n16 * 8); } } while (0)
#define MLA_WRITE() do { _Pragma("unroll") for (int i = 0; i < 8; ++i) *(LAS u32x4*)(stage + off_b((unsigned)(8 * g + i), (unsigned)n16)) = G[i]; } while (0)
            MLA_GATHER(0); MLA_WRITE();
            if (nch > 1) MLA_GATHER(1);
            const unsigned qd = (unsigned)(n16 >> 2), pp = (unsigned)(lane & 3);
            for (int c = 0; c < nch; ++c) {
                const int idx0 = 32 * c + 8 * g;
                const u32x4 sv = *(const LAS u32x4*)(selq + idx0);
                h16x8 ra[2][4]; h16x4 tlo[8], thi[8];
#pragma unroll
                for (int t = 0; t < 2; ++t) { const unsigned rowl = 8u * (n16 >> 2) + 4u * t + (n16 & 3);
#pragma unroll
                    for (int ks = 0; ks < 4; ++ks) ra[t][ks] = *(const LAS h16x8*)(stage + off_b(rowl, 4 * ks + g)); }
#pragma unroll
                for (int mt = 0; mt < 8; ++mt) { tlo[mt] = ds_tr16(stage + off_b(8u * g + qd, 2u * mt + (pp >> 1)) + 8u * (pp & 1));
                    thi[mt] = ds_tr16(stage + off_b(8u * g + 4u + qd, 2u * mt + (pp >> 1)) + 8u * (pp & 1)); }
                __builtin_amdgcn_sched_barrier(0);
                f32x4 st[2];
#pragma unroll
                for (int t = 0; t < 2; ++t) { st[t] = (f32x4){0.f, 0.f, 0.f, 0.f};
#pragma unroll
                    for (int ks = 0; ks < 4; ++ks) st[t] = __builtin_amdgcn_mfma_f32_16x16x32_f16(ra[t][ks], qa[ks], st[t], 0, 0, 0); }
                float bia[8];
#pragma unroll
                for (int e = 0; e < 8; ++e) { const int kp = (int)((sv[e >> 1] >> (16 * (e & 1))) & 0xffffu); int dist = qp - kp; dist = dist < 0 ? 0 : dist; dist = dist < 128 ? dist : 128; bia[e] = tb[dist]; }
                float mx = NINF;
#pragma unroll
                for (int t = 0; t < 2; ++t)
#pragma unroll
                    for (int r = 0; r < 4; ++r) { const float v0 = st[t][r] * rsq + bia[4 * t + r]; const float v = (idx0 + 4 * t + r < nsel) ? v0 : NINF; st[t][r] = v; mx = fmaxf(mx, v); }
                mx = fmaxf(mx, __shfl_xor(mx, 16)); mx = fmaxf(mx, __shfl_xor(mx, 32));
                if (__any(mx > m_run + 8.0f)) {
                    const float m_new = fmaxf(m_run, mx), alpha = __builtin_amdgcn_exp2f(m_run - m_new);
                    l_run *= alpha; m_run = m_new;
#pragma unroll
                    for (int mt = 0; mt < 8; ++mt) o[mt] = o[mt] * alpha;
                }
                float ps = 0.f;
#pragma unroll
                for (int t = 0; t < 2; ++t)
#pragma unroll
                    for (int r = 0; r < 4; ++r) { const float p = __builtin_amdgcn_exp2f(st[t][r] - m_run); st[t][r] = p; ps += p; }
                ps += __shfl_xor(ps, 16); ps += __shfl_xor(ps, 32);
                l_run += ps;
                const u32x4 pw = {pk_h2(st[0][0], st[0][1]), pk_h2(st[0][2], st[0][3]), pk_h2(st[1][0], st[1][1]), pk_h2(st[1][2], st[1][3])};
                const h16x8 pb = __builtin_bit_cast(h16x8, pw);
#pragma unroll
                for (int mt = 0; mt < 8; ++mt) {
                    const h16x8 a = {tlo[mt][0], tlo[mt][1], tlo[mt][2], tlo[mt][3], thi[mt][0], thi[mt][1], thi[mt][2], thi[mt][3]};
                    o[mt] = __builtin_amdgcn_mfma_f32_16x16x32_f16(a, pb, o[mt], 0, 0, 0); }
                if (c + 1 < nch) { MLA_WRITE(); if (c + 2 < nch) MLA_GATHER(c + 2); }
            }
#undef MLA_GATHER
#undef MLA_WRITE
            const float inv = 1.0f / l_run;
            if (n16 < 8) { h16* op = F.LAT + qrow * 1024 + n16 * 128 + 4 * g;
#pragma unroll
                for (int mt = 0; mt < 8; ++mt) { u32x2 ww; ww.x = pk_h2(o[mt][0] * inv, o[mt][1] * inv); ww.y = pk_h2(o[mt][2] * inv, o[mt][3] * inv); *(u32x2*)(op + 16 * mt) = ww; } }
        }
        __syncthreads();
    }
}

__device__ __forceinline__ void final_norm_phase(Frame& F) {
    const int gw = F.vcu * NWAVES + F.wave, NGW = F.G * NWAVES, lane = F.lane;
    f32x4 gv[4];
#pragma unroll
    for (int j = 0; j < 4; ++j) gv[j] = ((const f32x4*)F.gf)[lane + 64 * j];
    for (int row = gw; row < M; row += NGW) {
        const float rs = row_rs16(F.SSQ2 + (size_t)row * 16);
        f32x4* xr = (f32x4*)(F.out + (size_t)row * D) + lane;
#pragma unroll
        for (int j = 0; j < 4; ++j) { const f32x4 v = xr[64 * j]; xr[64 * j] = v * rs * gv[j]; }
    }
}

#ifndef MK_N_LAUNCHES
#define MK_N_LAUNCHES 1
#endif
constexpr int N_PHASES = 10;
struct Args { const float* in[22]; float* out; unsigned char* ws; int ph_lo, ph_hi; };
__global__ void __launch_bounds__(NWAVES * 64, 2) fwd_kernel(Args args) {
    extern __shared__ __attribute__((aligned(16))) unsigned char lds_raw[];
    Frame F;
    F.lds = (LAS unsigned char*)lds_raw;
    F.tid = threadIdx.x; F.lane = F.tid & 63; F.wave = __builtin_amdgcn_readfirstlane(F.tid >> 6);
    F.G = gridDim.x; { const int bx = blockIdx.x; F.vcu = (F.G % 8 == 0) ? (bx % 8) * (F.G / 8) + bx / 8 : bx; }
    unsigned char* ws = args.ws;
    F.x = args.in[0]; F.meta = args.in[1]; F.g1 = args.in[2]; F.w_in = args.in[3]; F.bg = args.in[4]; F.qg = args.in[5]; F.kvg = args.in[6]; F.w_uq = args.in[7]; F.w_uk = args.in[8];
    F.w_uv = args.in[9]; F.lng = args.in[10]; F.lnb = args.in[11]; F.sinks = args.in[12]; F.relb = args.in[13]; F.w_a = args.in[14]; F.w_b = args.in[15]; F.w_o = args.in[16];
    F.g2 = args.in[17]; F.w_g = args.in[18]; F.w_u = args.in[19]; F.w_d = args.in[20]; F.gf = args.in[21]; F.out = args.out;
    F.Win_t = (h16*)(ws + WS_WIN); F.Wqabs_t = (h16*)(ws + WS_WQABS); F.Wa_t = (h16*)(ws + WS_WA); F.Wuvb_t = (h16*)(ws + WS_WUVB); F.Wo_t = (h16*)(ws + WS_WO);
    F.Wgu_t = (h16*)(ws + WS_WGU); F.Wd_t = (h16*)(ws + WS_WD);
    F.RS1 = (float*)(ws + WS_RS1); F.RSQ = (float*)(ws + WS_RSQ); F.IWS = (float*)(ws + WS_IWS); F.SSQ1 = (float*)(ws + WS_SSQ1); F.SSQ2 = (float*)(ws + WS_SSQ2);
    F.METAP = (float*)(ws + WS_METAP); F.TBL = (float*)(ws + WS_TBL); F.RAW4 = (float*)(ws + WS_RAW4);
    F.AK = (h16*)(ws + WS_AK); F.AV = (h16*)(ws + WS_AV); F.CKV = (h16*)(ws + WS_CKV); F.IKN = (h16*)(ws + WS_IKN); F.OA = (h16*)(ws + WS_OA); F.GATES = (h16*)(ws + WS_GATES);
    F.AQ = (h16*)(ws + WS_AQ); F.BQ = (h16*)(ws + WS_BQ); F.IQ = (h16*)(ws + WS_IQ); F.H1 = (h16*)(ws + WS_H1); F.XH = (h16*)(ws + WS_XH); F.MIXED = (h16*)(ws + WS_MIXED);
    F.QABS = (h16*)(ws + WS_QABS); F.LAT = (h16*)(ws + WS_LAT); F.ACT = (h16*)(ws + WS_ACT);
    for (int u = F.tid; u < (LDS_BYTES - LDSCTL_OFF) / 4; u += NWAVES * 64) ((LAS unsigned*)(F.lds + LDSCTL_OFF))[u] = 0u;
    __syncthreads();
    XcdBarrier bar; bar.bar = (unsigned*)(ws + WS_CTL) + CW_BAR; bar.x = 0; bar.st = nullptr;
    if (MK_N_LAUNCHES == 1) bar = xcd_barrier_post((unsigned*)(ws + WS_CTL) + CW_BAR, (volatile LAS unsigned*)(F.lds + MISC_OFF) + 8);
    const int lo = args.ph_lo, hi = args.ph_hi;
#ifndef PHMASK
#define PHMASK 0x3ff
#endif
#define IN(k) ((((PHMASK) >> (k)) & 1) && lo <= (k) && (k) < hi)
#define SEAM(k) do { if (MK_N_LAUNCHES == 1) { if (IN(k) && IN((k) + 1)) xcd_barrier(bar); } } while (0)

    if (IN(0)) { p0_prologue(F); } SEAM(0);
    if (IN(1)) {
        pg8::Gemm g{F.XH, F.Win_t, M, DINP, D}; pg8::StaticOrder S; S.init(M, DINP, F.G, (int)blockIdx.x);
        EpiInProj E{F.RS1, F.AQ, F.AK, F.AV, F.BQ, F.RAW4, F.IQ, F.GATES, F.bg};
        pg8::gemm_phase<EpiInProj, pg8::StaticOrder>(F.lds + RING_OFF, g, S, E);
    } SEAM(1);
    if (IN(2)) {
#ifndef NO_NORMS
        p2_norms(F);
#endif
        { pg8::Gemm g{F.BQ, F.Wqabs_t, M, 1024, 256}; pg8::StaticOrder S; S.init(M, 1024, F.G, (int)blockIdx.x);
          EpiH16 E{F.QABS, 1024};
          pg8::gemm_phase<EpiH16, pg8::StaticOrder>(F.lds + RING_OFF, g, S, E); }
    } SEAM(2);
    if (IN(3)) {
#ifndef NO_ATTN_A
        attn_a_phase(F);
#endif
#ifndef NO_MIXER_B
        mixer_b_phase(F);
#endif
    } SEAM(3);
    if (IN(4)) {
        pg8::Gemm g{F.OA, F.Wa_t, M, D, 512}; pg8::StaticOrder S; S.init(M, D, F.G, (int)blockIdx.x);
        EpiGate<false> E{F.GATES, F.MIXED};
        pg8::gemm_phase<EpiGate<false>, pg8::StaticOrder>(F.lds + RING_OFF, g, S, E);
    } SEAM(4);
    if (IN(5)) {
        pg8::Gemm g{F.LAT, F.Wuvb_t, M, D, 1024}; pg8::StaticOrder S; S.init(M, D, F.G, (int)blockIdx.x);
        EpiGate<true> E{F.GATES + 1024, F.MIXED};
        pg8::gemm_phase<EpiGate<true>, pg8::StaticOrder>(F.lds + RING_OFF, g, S, E);
    } SEAM(5);
    if (IN(6)) {
        pg8::Gemm g{F.MIXED, F.Wo_t, M, D, D}; pg8::StaticOrder S; S.init(M, D, F.G, (int)blockIdx.x);
        EpiWo E{F.x, F.H1, F.SSQ1};
        pg8::gemm_phase<EpiWo, pg8::StaticOrder>(F.lds + RING_OFF, g, S, E);
    } SEAM(6);
    if (IN(7)) {
        pg8::Gemm g{F.H1, F.Wgu_t, M, NGU, D}; pg8::StaticOrder S; S.init(M, NGU, F.G, (int)blockIdx.x);
        EpiSwiGLU E{F.SSQ1, F.ACT};
        pg8::gemm_phase<EpiSwiGLU, pg8::StaticOrder>(F.lds + RING_OFF, g, S, E);
    } SEAM(7);
    if (IN(8)) {
        pg8::Gemm g{F.ACT, F.Wd_t, M, D, DFF}; pg8::StaticOrder S; S.init(M, D, F.G, (int)blockIdx.x);
        EpiDown E{F.H1, F.out, F.SSQ2};
        pg8::gemm_phase<EpiDown, pg8::StaticOrder>(F.lds + RING_OFF, g, S, E);
    } SEAM(8);
    if (IN(9)) { final_norm_phase(F); }
#undef IN
#undef SEAM
}

extern "C" void kernel_launch(void* const* d_in, const int* in_sizes, int n_in, void* d_out, int out_size, void* d_ws, size_t ws_size, hipStream_t stream) {
    static int grid = 0;
    if (grid == 0) {
        if (n_in != 22 || in_sizes[0] != M * D || out_size != M * D || ws_size < WS_END) {
            fprintf(stderr, "kernel_launch: built for 22 inputs, x/out of %d floats, >= %zu bytes of workspace; got n_in %d, in0 %d, out %d, ws %zu; nothing launched\n", M * D, (size_t)WS_END, n_in, n_in > 0 ? in_sizes[0] : -1, out_size, ws_size);
            grid = -1; return; }
        int dev = 0, cus = 0, per_cu = 0;
        if (hipGetDevice(&dev) != hipSuccess || hipDeviceGetAttribute(&cus, hipDeviceAttributeMultiprocessorCount, dev) != hipSuccess) { fprintf(stderr, "kernel_launch: device query failed\n"); grid = -1; return; }
        if (hipFuncSetAttribute((const void*)fwd_kernel, hipFuncAttributeMaxDynamicSharedMemorySize, LDS_BYTES) != hipSuccess) { fprintf(stderr, "kernel_launch: hipFuncSetAttribute failed\n"); grid = -1; return; }
        if (hipOccupancyMaxActiveBlocksPerMultiprocessor(&per_cu, (const void*)fwd_kernel, NWAVES * 64, LDS_BYTES) != hipSuccess || per_cu < 1)
            fprintf(stderr, "kernel_launch: note: occupancy query reports %d workgroups per CU\n", per_cu);
        (void)hipGetLastError();
        grid = cus;
    }
    if (grid < 0) return;
    if (hipMemsetAsync((char*)d_ws + WS_CTL, 0, CTL_ZERO_BYTES, stream) != hipSuccess) { fprintf(stderr, "kernel_launch: hipMemsetAsync failed\n"); return; }
    Args a{};
    for (int i = 0; i < 22; ++i) a.in[i] = (const float*)d_in[i];
    a.out = (float*)d_out; a.ws = (unsigned char*)d_ws;
    for (int li = 0; li < MK_N_LAUNCHES; ++li) {
        a.ph_lo = (MK_N_LAUNCHES == 1) ? 0 : li; a.ph_hi = (MK_N_LAUNCHES == 1) ? N_PHASES : li + 1;
        hipLaunchKernelGGL(fwd_kernel, dim3(grid), dim3(NWAVES * 64), LDS_BYTES, stream, a);
        const hipError_t le = hipPeekAtLastError();
        if (le != hipSuccess) { fprintf(stderr, "kernel_launch: launch %d failed: %s\n", li, hipGetErrorName(le)); break; }
    }
}
```

```cpp
#include <hip/hip_runtime.h>
#include <cstdio>
#include <cstdint>

#define LAS __attribute__((address_space(3)))
#define GAS __attribute__((address_space(1)))
typedef unsigned short h16;
typedef _Float16 h16x8 __attribute__((ext_vector_type(8)));
typedef _Float16 h16x4 __attribute__((ext_vector_type(4)));
typedef _Float16 h16x2 __attribute__((ext_vector_type(2)));
typedef float f32x4 __attribute__((ext_vector_type(4)));
typedef float f32x16 __attribute__((ext_vector_type(16)));
typedef unsigned u32x4 __attribute__((ext_vector_type(4)));
typedef unsigned u32x2 __attribute__((ext_vector_type(2)));
typedef short s16x4 __attribute__((ext_vector_type(4)));

constexpr int BATCH = 32, SEQ = 2048, D = 1024, NPAD = 112, NMETA = 16, BLK = 128, P = BLK + SEQ  , NBLK = P / BLK  ;
constexpr int M = BATCH * SEQ;
constexpr int DIN = 3524, DINP = 3584, DFF = 2816, NGU = 2 * DFF  ;
constexpr int TOPK = 256;
constexpr float EPS = 1e-6f, LOG2E = 1.4426950408889634f;
constexpr float QSCALE = 0.125f * LOG2E;

__device__ __forceinline__ unsigned pk_h2(float lo, float hi) { h16x2 v = {(_Float16)lo, (_Float16)hi}; return __builtin_bit_cast(unsigned, v); }
__device__ __forceinline__ u32x4 pk_h8(f32x4 a, f32x4 b) { u32x4 w; w.x = pk_h2(a[0], a[1]); w.y = pk_h2(a[2], a[3]); w.z = pk_h2(b[0], b[1]); w.w = pk_h2(b[2], b[3]); return w; }
__device__ __forceinline__ float h2f(h16 v) { return (float)__builtin_bit_cast(_Float16, v); }
__device__ __forceinline__ h16x4 ds_tr16a(const LAS unsigned char* p) { return __builtin_bit_cast(h16x4, __builtin_amdgcn_ds_read_tr16_b64_v4i16((LAS s16x4*)p)); }
__device__ __forceinline__ float sigmoidf_fast(float x) { return __builtin_amdgcn_rcpf(1.0f + __builtin_amdgcn_exp2f(-LOG2E * x)); }

#ifndef PROBE_WG
#define PROBE_WG 0
#endif
#ifdef PROBE_SEC
#define PSEC_DECL unsigned long long pt0_ = 0ull, pacc_ = 0ull; (void)pt0_; (void)pacc_
#define PSEC_BEGIN(id) do { if ((id) == PROBE_SEC) { asm volatile("s_waitcnt vmcnt(0) lgkmcnt(0)" ::: "memory"); pt0_ = __builtin_amdgcn_s_memtime(); } } while (0)
#define PSEC_END(id) do { if ((id) == PROBE_SEC) { asm volatile("s_waitcnt vmcnt(0) lgkmcnt(0)" ::: "memory"); pacc_ += __builtin_amdgcn_s_memtime() - pt0_; } } while (0)
#define PSEC_BURN(lo, hi) do { if (PROBE_SEC >= (lo) && PROBE_SEC <= (hi) && (PROBE_WG < 0 || blockIdx.x == PROBE_WG)) { const unsigned long long te_ = __builtin_amdgcn_s_memtime() + pacc_; \
        while (__builtin_amdgcn_s_memtime() < te_) __builtin_amdgcn_s_sleep(8); } } while (0)
#else
#define PSEC_DECL do {} while (0)
#define PSEC_BEGIN(id) do {} while (0)
#define PSEC_END(id) do {} while (0)
#define PSEC_BURN(lo, hi) do {} while (0)
#endif
__device__ __forceinline__ int lane_id_v() { int l; asm volatile("v_mbcnt_lo_u32_b32 %0, -1, 0\n\tv_mbcnt_hi_u32_b32 %0, -1, %0" : "=v"(l)); return l; }
namespace pg8 {
constexpr int BM = 256, BK = 64, HALF = 128, HTB = HALF * BK * 2  , STAGE_BYTES = 8 * HTB, NXCD = 8, WGM = 8;
__host__ __device__ __forceinline__ int lds_byte(int r, int c) { const int st = (r >> 4) * 2 + (c >> 5), rr = r & 15, cc = c & 31, ob = rr * 64 + cc * 2; return st * 1024 + (ob ^ (((ob >> 9) & 1) << 5)); }
__host__ __device__ __forceinline__ void stage_rc(int b, int& R, int& C) { const int st = b / 1024, sb = b % 1024, swz = sb ^ (((sb >> 9) & 1) << 5); R = (st >> 1) * 16 + swz / 64; C = (st & 1) * 32 + (swz % 64) / 2; }
__host__ __device__ __forceinline__ int perm32(int rho) { const int n = rho >> 4, i = rho & 15; return 8 * (i >> 2) + 4 * n + (i & 3); }

struct Unit { int pm, pn; };
struct Gemm { const h16* A; const h16* Bt; int M, N, K; };

struct StaticOrder {
    int nM, nN, nwg, G, c;
    __host__ __device__ __forceinline__ void init(int M_, int N_, int G_, int c_) { nM = M_ / BM; nN = N_ / BM; nwg = nM * nN; G = G_; c = c_; }
    __host__ __device__ __forceinline__ bool next(int i, Unit& u) const {
        const long L = (long)i * G + c; if (L >= nwg) return false;
        int wgid = (int)L; { const int q = nwg / NXCD, r = nwg % NXCD, xcd = wgid % NXCD, off = wgid / NXCD; wgid = (xcd < r ? xcd * (q + 1) : r * (q + 1) + (xcd - r) * q) + off; }
        const int nig = WGM * nN, gid = wgid / nig, fm = gid * WGM, gsz = (nM - fm) < WGM ? (nM - fm) : WGM;
        u.pm = fm + ((wgid % nig) % gsz); u.pn = (wgid % nig) / gsz; return true;
    }
    __device__ __forceinline__ void a_ready(const Unit&) const {}
    __device__ __forceinline__ void done(const Unit&) const {}
};

template <class Epi, class Sched, bool ALIGN_EPI = true, bool SP2 = true>
__device__ __forceinline__ void gemm_phase(LAS unsigned char* lds, const Gemm g, const Sched& S, const Epi& E, const int wid) {
    const int lane = lane_id_v(), tid = wid * 64 + lane, wr = wid >> 2, wc = wid & 3, fr = lane & 15, fq = lane >> 4;
    int K = g.K; asm volatile("" : "+s"(K));
    const int nt = K / BK;
    unsigned voffA[2], voffB[2];
#pragma unroll
    for (int i = 0; i < 2; ++i) { int R, C; stage_rc(tid * 16 + i * 8192, R, C); const int Rb = (R & ~31) + perm32(R & 31);
        voffA[i] = (unsigned)(R * K + C) * 2u; voffB[i] = (unsigned)(Rb * K + C) * 2u; }
    const size_t kstep = (size_t)(BK * 2);
    const size_t hstep = (size_t)HALF * K * 2;
    const size_t tstep = 2 * hstep;
    const unsigned ldsw = (unsigned)wid * 1024u;
    const int aoff = lds_byte(wr * 64 + fr, fq * 8), boff = lds_byte(wc * 32 + fr, fq * 8);
#define PG8_SA(b, h) (((b) * 2 + (h)) * HTB)
#define PG8_SB(b, h) ((4 + (b) * 2 + (h)) * HTB)
#define PG8_STAGE(bufoff, gbase, voff) do { _Pragma("unroll") for (int _i = 0; _i < 2; ++_i) \
        __builtin_amdgcn_global_load_lds((const unsigned*)((const char*)(gbase) + (voff)[_i]), (LAS unsigned*)(lds + (bufoff) + ldsw + _i * 8192), 16, 0, 0); } while (0)
#define PG8_LDA(dst, b, h) do { _Pragma("unroll") for (int m = 0; m < 4; ++m) _Pragma("unroll") for (int k = 0; k < 2; ++k) dst[m][k] = *(const LAS h16x8*)(lds + PG8_SA(b, h) + aoff + m * 2048 + k * 1024); } while (0)
#define PG8_LDB(dst, b, h) do { _Pragma("unroll") for (int n = 0; n < 2; ++n) _Pragma("unroll") for (int k = 0; k < 2; ++k) dst[n][k] = *(const LAS h16x8*)(lds + PG8_SB(b, h) + boff + n * 2048 + k * 1024); } while (0)
#define PG8_MMA(ai, bj, At, Bt) do { __builtin_amdgcn_s_setprio(1); _Pragma("unroll") for (int m = 0; m < 4; ++m) _Pragma("unroll") for (int n = 0; n < 2; ++n) _Pragma("unroll") for (int k = 0; k < 2; ++k) \
        acc[ai][bj][m][n] = __builtin_amdgcn_mfma_f32_16x16x32_f16(Bt[n][k], At[m][k], acc[ai][bj][m][n], 0, 0, 0); __builtin_amdgcn_s_setprio(0); } while (0)
#define PG8_WAIT_V(n) asm volatile("s_waitcnt vmcnt(" #n ")" ::: "memory")
#define PG8_WAIT_L(n) asm volatile("s_waitcnt lgkmcnt(" #n ")" ::: "memory")
#define PG8_BAR __builtin_amdgcn_s_barrier()
#define PG8_SCHED __builtin_amdgcn_sched_barrier(0)
    PSEC_DECL;
    Unit cur, nxt; int ui = 0;
    if (!S.next(0, cur)) return;
    f32x4 acc[2][2][4][2];
#pragma unroll
    for (int a = 0; a < 2; ++a)
#pragma unroll
        for (int b = 0; b < 2; ++b)
#pragma unroll
            for (int m = 0; m < 4; ++m)
#pragma unroll
                for (int n = 0; n < 2; ++n) acc[a][b][m][n] = (f32x4){0.f, 0.f, 0.f, 0.f};
    h16x8 At[4][2], B0[2][2], B1[2][2];
    const char* cA = (const char*)g.A + (size_t)cur.pm * tstep; const char* cB = (const char*)g.Bt + (size_t)cur.pn * tstep;
    S.a_ready(cur);
    typename Epi::Pre pre_cur = E.pre(cur, wr, wc, fr, fq), pre_nxt = pre_cur;
    if constexpr (SP2) {
        PG8_STAGE(PG8_SB(0, 0), cB, voffB); PG8_STAGE(PG8_SB(0, 1), cB + hstep, voffB); PG8_STAGE(PG8_SA(0, 0), cA, voffA); PG8_STAGE(PG8_SA(0, 1), cA + hstep, voffA);
        if (wr == 1) PG8_BAR;
        PG8_WAIT_V(2); PG8_BAR;
        PG8_STAGE(PG8_SB(1, 0), cB + kstep, voffB); PG8_STAGE(PG8_SA(1, 0), cA + kstep, voffA); PG8_STAGE(PG8_SB(1, 1), cB + hstep + kstep, voffB);
        PG8_WAIT_V(6); PG8_BAR;
    } else {
        PG8_STAGE(PG8_SB(0, 0), cB, voffB); PG8_STAGE(PG8_SA(0, 0), cA, voffA); PG8_STAGE(PG8_SB(0, 1), cB + hstep, voffB); PG8_STAGE(PG8_SA(0, 1), cA + hstep, voffA);
        if (wr == 1) PG8_BAR;
        PG8_WAIT_V(4); PG8_BAR;
        PG8_STAGE(PG8_SB(1, 0), cB + kstep, voffB); PG8_STAGE(PG8_SA(1, 0), cA + kstep, voffA); PG8_STAGE(PG8_SB(1, 1), cB + hstep + kstep, voffB);
        PG8_WAIT_V(6); PG8_BAR;
    }
    for (;;) {
        const bool has_next = S.next(ui + 1, nxt);
        const char* nA = has_next ? (const char*)g.A + (size_t)nxt.pm * tstep : cA; const char* nB = has_next ? (const char*)g.Bt + (size_t)nxt.pn * tstep : cB;
        for (int t = 0; t < nt; t += 2) {
            const bool last = (t == nt - 2);
            const char* a1 = cA + (size_t)(t + 1) * kstep;
            const char* a2 = last ? nA : cA + (size_t)(t + 2) * kstep; const char* b2 = last ? nB : cB + (size_t)(t + 2) * kstep;
            const char* a3 = a2 + kstep; const char* b3 = b2 + kstep;
            if (last && has_next) { S.a_ready(nxt); pre_nxt = E.pre(nxt, wr, wc, fr, fq); }
            if constexpr (SP2) {
            PG8_LDB(B0, 0, 0); PG8_LDB(B1, 0, 1); PG8_SCHED; PG8_LDA(At, 0, 0); PG8_STAGE(PG8_SA(1, 1), a1 + hstep, voffA);
            PG8_WAIT_V(8); PG8_WAIT_L(0); PG8_BAR; PG8_MMA(0, 0, At, B0); PG8_MMA(0, 1, At, B1); PG8_BAR; PG8_SCHED;
            PG8_LDA(At, 0, 1); PG8_STAGE(PG8_SB(0, 0), b2, voffB); PG8_STAGE(PG8_SB(0, 1), b2 + hstep, voffB); PG8_STAGE(PG8_SA(0, 0), a2, voffA);
            PG8_WAIT_V(8); PG8_WAIT_L(0); PG8_BAR; PG8_MMA(1, 0, At, B0); PG8_MMA(1, 1, At, B1); PG8_BAR; PG8_SCHED;
            PG8_LDB(B0, 1, 0); PG8_LDB(B1, 1, 1); PG8_SCHED; PG8_LDA(At, 1, 0); PG8_STAGE(PG8_SA(0, 1), a2 + hstep, voffA);
            PG8_WAIT_V(8); PG8_WAIT_L(0); PG8_BAR; PG8_MMA(0, 0, At, B0); PG8_MMA(0, 1, At, B1); PG8_BAR; PG8_SCHED;
            PG8_LDA(At, 1, 1); PG8_STAGE(PG8_SB(1, 0), b3, voffB); PG8_STAGE(PG8_SB(1, 1), b3 + hstep, voffB); PG8_STAGE(PG8_SA(1, 0), a3, voffA);
            PG8_WAIT_V(8); PG8_WAIT_L(0); PG8_BAR; PG8_MMA(1, 0, At, B0); PG8_MMA(1, 1, At, B1); PG8_BAR; PG8_SCHED;
            } else {
            PG8_LDB(B0, 0, 0); PG8_SCHED; PG8_LDA(At, 0, 0); PG8_STAGE(PG8_SA(1, 1), a1 + hstep, voffA);
            PG8_WAIT_L(8); PG8_BAR; PG8_WAIT_L(0); PG8_MMA(0, 0, At, B0); PG8_BAR; PG8_SCHED;
            PG8_LDB(B1, 0, 1); PG8_STAGE(PG8_SB(0, 0), b2, voffB);
            PG8_BAR; PG8_WAIT_L(0); PG8_MMA(0, 1, At, B1); PG8_BAR;
            PG8_LDA(At, 0, 1); PG8_STAGE(PG8_SA(0, 0), a2, voffA);
            PG8_BAR; PG8_WAIT_L(0); PG8_MMA(1, 0, At, B0); PG8_BAR; PG8_SCHED;
            PG8_STAGE(PG8_SB(0, 1), b2 + hstep, voffB);
            PG8_WAIT_V(6); PG8_BAR; PG8_MMA(1, 1, At, B1); PG8_BAR;
            PG8_LDB(B0, 1, 0); PG8_SCHED; PG8_LDA(At, 1, 0); PG8_STAGE(PG8_SA(0, 1), a2 + hstep, voffA);
            PG8_WAIT_L(8); PG8_BAR; PG8_WAIT_L(0); PG8_MMA(0, 0, At, B0); PG8_BAR; PG8_SCHED;
            PG8_LDB(B1, 1, 1); PG8_STAGE(PG8_SB(1, 0), b3, voffB);
            PG8_BAR; PG8_WAIT_L(0); PG8_MMA(0, 1, At, B1); PG8_BAR;
            PG8_LDA(At, 1, 1); PG8_STAGE(PG8_SA(1, 0), a3, voffA);
            PG8_BAR; PG8_WAIT_L(0); PG8_MMA(1, 0, At, B0); PG8_BAR; PG8_SCHED;
            PG8_STAGE(PG8_SB(1, 1), b3 + hstep, voffB);
            PG8_WAIT_V(6); PG8_BAR; PG8_MMA(1, 1, At, B1); PG8_BAR;
            }
        }
        if constexpr (ALIGN_EPI) { if (wr == 0) PG8_BAR; }
        PSEC_BEGIN(40); E(acc, cur, pre_cur, wr, wc, fr, fq); PSEC_END(40); S.done(cur);
        if (!has_next) break;
#pragma unroll
        for (int a = 0; a < 2; ++a)
#pragma unroll
            for (int b = 0; b < 2; ++b)
#pragma unroll
                for (int m = 0; m < 4; ++m)
#pragma unroll
                    for (int n = 0; n < 2; ++n) acc[a][b][m][n] = (f32x4){0.f, 0.f, 0.f, 0.f};
        cur = nxt; cA = nA; cB = nB; ++ui; pre_cur = pre_nxt;
        if constexpr (ALIGN_EPI) { if (wr == 1) PG8_BAR; }
    }
    PG8_WAIT_V(0);
    if constexpr (!ALIGN_EPI) { if (wr == 0) PG8_BAR; }
    PG8_BAR;
    PSEC_BURN(40, 40);
#undef PG8_SA
#undef PG8_SB
#undef PG8_STAGE
#undef PG8_LDA
#undef PG8_LDB
#undef PG8_MMA
#undef PG8_WAIT_V
#undef PG8_WAIT_L
#undef PG8_BAR
#undef PG8_SCHED
}
}

struct PreNone {};
struct PreRows { float rs[8]; };
#define EPI_NOPRE typedef PreNone Pre; __device__ __forceinline__ Pre pre(const pg8::Unit&, int, int, int, int) const { return Pre{}; }
#define EPI_ROWS _Pragma("unroll") for (int ai = 0; ai < 2; ++ai) _Pragma("unroll") for (int m = 0; m < 4; ++m)
#define EPI_BJ _Pragma("unroll") for (int bj = 0; bj < 2; ++bj)
__device__ __forceinline__ void ld_h8(const h16* p, f32x4& a, f32x4& b) { const u32x4 w = *(const u32x4*)p; const h16x8 h = __builtin_bit_cast(h16x8, w);
    a = (f32x4){(float)h[0], (float)h[1], (float)h[2], (float)h[3]}; b = (f32x4){(float)h[4], (float)h[5], (float)h[6], (float)h[7]}; }
__device__ __forceinline__ float ssq8(const f32x4& v0, const f32x4& v1) { return ((v0[0] * v0[0] + v0[1] * v0[1]) + (v0[2] * v0[2] + v0[3] * v0[3])) + ((v1[0] * v1[0] + v1[1] * v1[1]) + (v1[2] * v1[2] + v1[3] * v1[3])); }

struct EpiInProj {
    const float* rs1; h16* AQ; h16* AK; h16* AV; h16* BQ; float* RAW4; h16* IQ; unsigned char* GATES; const float* bg;
    typedef PreRows Pre;
    __device__ __forceinline__ Pre pre(const pg8::Unit& u, int wr, int wc, int fr, int fq) const { Pre p; const int row0 = u.pm * 256 + wr * 64 + fr;
        _Pragma("unroll") for (int ai = 0; ai < 2; ++ai) _Pragma("unroll") for (int m = 0; m < 4; ++m) p.rs[ai * 4 + m] = rs1[row0 + ai * 128 + m * 16]; return p; }
    __device__ __forceinline__ void operator()(const f32x4 (&acc)[2][2][4][2], const pg8::Unit& u, const Pre& P_, int wr, int wc, int fr, int fq) const {
        int ct = wc * 32 + 8 * fq; asm volatile("" : "+v"(ct));
        const int pn = u.pn, row0 = u.pm * 256 + wr * 64 + fr;
        if (pn >= 6) {
            const int gc0 = (pn - 6) * 256 + ct;
            f32x4 b[2][2];
            EPI_BJ { b[bj][0] = *(const f32x4*)(bg + gc0 + bj * 128); b[bj][1] = *(const f32x4*)(bg + gc0 + bj * 128 + 4); }
            EPI_ROWS { const int row = row0 + ai * 128 + m * 16; const float s = P_.rs[ai * 4 + m]; unsigned char* rp = GATES + (size_t)row * 2048 + gc0;
                EPI_BJ { f32x4 v0 = acc[ai][bj][m][0] * s + b[bj][0], v1 = acc[ai][bj][m][1] * s + b[bj][1];
                    unsigned q0[4], q1[4];
                    _Pragma("unroll") for (int e = 0; e < 4; ++e) { q0[e] = (unsigned)(sigmoidf_fast(v0[e]) * 255.0f + 0.5f); q1[e] = (unsigned)(sigmoidf_fast(v1[e]) * 255.0f + 0.5f); }
                    u32x2 w; w.x = q0[0] | (q0[1] << 8) | (q0[2] << 16) | (q0[3] << 24); w.y = q1[0] | (q1[1] << 8) | (q1[2] << 16) | (q1[3] << 24);
                    *(u32x2*)(rp + bj * 128) = w; } }
        } else if (pn == 4) {
            EPI_ROWS { const int row = row0 + ai * 128 + m * 16; const float s = P_.rs[ai * 4 + m]; float* rp = RAW4 + (size_t)row * 256 + ct;
                EPI_BJ { *(f32x4*)(rp + bj * 128) = acc[ai][bj][m][0] * s; *(f32x4*)(rp + bj * 128 + 4) = acc[ai][bj][m][1] * s; } }
        } else if (pn == 2) {
            EPI_ROWS { const int row = row0 + ai * 128 + m * 16; const float s = P_.rs[ai * 4 + m]; const size_t prow = (size_t)(row >> 11) * P + BLK + (row & 2047);
                *(u32x4*)(AK + prow * 128 + ct) = pk_h8(acc[ai][0][m][0] * s, acc[ai][0][m][1] * s);
                *(u32x4*)(AV + prow * 128 + ct) = pk_h8(acc[ai][1][m][0] * s, acc[ai][1][m][1] * s); }
        } else {
            h16* base = pn < 2 ? AQ + pn * 256 : (pn == 3 ? BQ : IQ); const int ld = pn < 2 ? 512 : 256;
            EPI_ROWS { const int row = row0 + ai * 128 + m * 16; const float s = P_.rs[ai * 4 + m]; h16* rp = base + (size_t)row * ld + ct;
                EPI_BJ *(u32x4*)(rp + bj * 128) = pk_h8(acc[ai][bj][m][0] * s, acc[ai][bj][m][1] * s); }
        }
    }
};
struct EpiH16 {
    h16* O; int ldc;
    EPI_NOPRE
    __device__ __forceinline__ void operator()(const f32x4 (&acc)[2][2][4][2], const pg8::Unit& u, const Pre&, int wr, int wc, int fr, int fq) const {
        const int row0 = u.pm * 256 + wr * 64 + fr, col0 = u.pn * 256 + wc * 32 + 8 * fq;
        EPI_ROWS { const int row = row0 + ai * 128 + m * 16; h16* rp = O + (size_t)row * ldc + col0;
            EPI_BJ *(u32x4*)(rp + bj * 128) = pk_h8(acc[ai][bj][m][0], acc[ai][bj][m][1]); }
    }
};
template <bool ACCUM> struct EpiGate {
    const unsigned char* G; h16* O;
    EPI_NOPRE
    __device__ __forceinline__ void operator()(const f32x4 (&acc)[2][2][4][2], const pg8::Unit& u, const Pre&, int wr, int wc, int fr, int fq) const {
        const int row0 = u.pm * 256 + wr * 64 + fr, col0 = u.pn * 256 + wc * 32 + 8 * fq;
        EPI_ROWS { const int row = row0 + ai * 128 + m * 16; const unsigned char* gp = G + (size_t)row * 2048 + col0; h16* rp = O + (size_t)row * 1024 + col0;
            EPI_BJ { const u32x2 gw = *(const u32x2*)(gp + bj * 128);
                const f32x4 g0 = (f32x4){(float)(gw.x & 255u), (float)((gw.x >> 8) & 255u), (float)((gw.x >> 16) & 255u), (float)(gw.x >> 24)} * (1.0f / 255.0f);
                const f32x4 g1 = (f32x4){(float)(gw.y & 255u), (float)((gw.y >> 8) & 255u), (float)((gw.y >> 16) & 255u), (float)(gw.y >> 24)} * (1.0f / 255.0f);
                f32x4 v0 = acc[ai][bj][m][0] * g0, v1 = acc[ai][bj][m][1] * g1;
                if (ACCUM) { f32x4 t0, t1; ld_h8(rp + bj * 128, t0, t1); v0 += t0; v1 += t1; }
                *(u32x4*)(rp + bj * 128) = pk_h8(v0, v1); } }
    }
};
struct EpiWo {
    const float* x; h16* H1; float* SSQ;
    EPI_NOPRE
    __device__ __forceinline__ void operator()(const f32x4 (&acc)[2][2][4][2], const pg8::Unit& u, const Pre&, int wr, int wc, int fr, int fq) const {
        const int row0 = u.pm * 256 + wr * 64 + fr, col0 = u.pn * 256 + wc * 32 + 8 * fq;
        EPI_ROWS { const int row = row0 + ai * 128 + m * 16; const float* xp = x + (size_t)row * 1024 + col0; h16* rp = H1 + (size_t)row * 1024 + col0; float q = 0.f;
            EPI_BJ { const f32x4 v0 = acc[ai][bj][m][0] + *(const f32x4*)(xp + bj * 128), v1 = acc[ai][bj][m][1] + *(const f32x4*)(xp + bj * 128 + 4);
                q += ssq8(v0, v1); *(u32x4*)(rp + bj * 128) = pk_h8(v0, v1); }
            q += __shfl_xor(q, 16); q += __shfl_xor(q, 32);
            if (fq == 0) SSQ[(size_t)row * 16 + u.pn * 4 + wc] = q; }
    }
};
__device__ __forceinline__ float row_rs16(const float* ssq_row) {
    const f32x4* sp = (const f32x4*)ssq_row; const f32x4 s0 = sp[0], s1 = sp[1], s2 = sp[2], s3 = sp[3];
    const float ss = (((s0[0] + s0[1]) + (s0[2] + s0[3])) + ((s1[0] + s1[1]) + (s1[2] + s1[3]))) + (((s2[0] + s2[1]) + (s2[2] + s2[3])) + ((s3[0] + s3[1]) + (s3[2] + s3[3])));
    return __builtin_amdgcn_rsqf(ss * (1.0f / 1024.0f) + EPS);
}
struct EpiSwiGLU {
    const float* RS2; h16* ACT;
    typedef PreRows Pre;
    __device__ __forceinline__ Pre pre(const pg8::Unit& u, int wr, int wc, int fr, int fq) const { Pre p; const int row0 = u.pm * 256 + wr * 64 + fr;
        _Pragma("unroll") for (int ai = 0; ai < 2; ++ai) _Pragma("unroll") for (int m = 0; m < 4; ++m) p.rs[ai * 4 + m] = RS2[row0 + ai * 128 + m * 16]; return p; }
    __device__ __forceinline__ void operator()(const f32x4 (&acc)[2][2][4][2], const pg8::Unit& u, const Pre& P_, int wr, int wc, int fr, int fq) const {
        const int row0 = u.pm * 256 + wr * 64 + fr, col0 = u.pn * 128 + wc * 32 + 8 * fq;
        EPI_ROWS { const int row = row0 + ai * 128 + m * 16; const float rs = P_.rs[ai * 4 + m];
            f32x4 o[2];
            _Pragma("unroll") for (int n = 0; n < 2; ++n)
                _Pragma("unroll") for (int e = 0; e < 4; ++e) { const float g = acc[ai][0][m][n][e] * rs, up = acc[ai][1][m][n][e] * rs; o[n][e] = g * sigmoidf_fast(g) * up; }
            *(u32x4*)(ACT + (size_t)row * DFF + col0) = pk_h8(o[0], o[1]); }
    }
};
struct EpiDown {
    const h16* H1; h16* H2; float* SSQ;
    EPI_NOPRE
    __device__ __forceinline__ void operator()(const f32x4 (&acc)[2][2][4][2], const pg8::Unit& u, const Pre&, int wr, int wc, int fr, int fq) const {
        const int row0 = u.pm * 256 + wr * 64 + fr, col0 = u.pn * 256 + wc * 32 + 8 * fq;
        EPI_ROWS { const int row = row0 + ai * 128 + m * 16; const h16* hp = H1 + (size_t)row * 1024 + col0; h16* rp = H2 + (size_t)row * 1024 + col0; float q = 0.f;
            EPI_BJ { f32x4 h0, h1; ld_h8(hp + bj * 128, h0, h1); const f32x4 v0 = acc[ai][bj][m][0] + h0, v1 = acc[ai][bj][m][1] + h1;
                q += ssq8(v0, v1); *(u32x4*)(rp + bj * 128) = pk_h8(v0, v1); }
            q += __shfl_xor(q, 16); q += __shfl_xor(q, 32);
            if (fq == 0) SSQ[(size_t)row * 16 + u.pn * 4 + wc] = q; }
    }
};

constexpr size_t MiB = 1u << 20;
constexpr size_t WS_CTL = 0, CTL_ZERO_BYTES = 65536;
constexpr size_t WS_WIN = 2 * MiB, WS_WQABS = 9 * MiB, WS_WA = 10 * MiB, WS_WUVB = 11 * MiB, WS_WO = 13 * MiB, WS_WGU = 15 * MiB, WS_WD = 26 * MiB;
constexpr size_t WS_RS1 = 32 * MiB, WS_RSQ = WS_RS1 + 256 * 1024, WS_RS2 = WS_RS1 + 512 * 1024, WS_IWS = 33 * MiB, WS_SSQ1 = 34 * MiB, WS_SSQ2 = 38 * MiB, WS_METAP = 42 * MiB, WS_TBL = WS_METAP + 512 * 1024;
constexpr size_t KVROWS = (size_t)BATCH * P;
constexpr size_t WS_AK = 44 * MiB, WS_AV = 61 * MiB, WS_CKV = 78 * MiB, WS_IKN = 95 * MiB;
constexpr size_t WS_OA = 104 * MiB, WS_GATES = 168 * MiB  , WS_H2 = 296 * MiB  ;
constexpr size_t WS_AQ = 424 * MiB, WS_BQ = 488 * MiB, WS_IQ = 520 * MiB, WS_H1 = 424 * MiB;
constexpr size_t WS_XH = 552 * MiB, WS_MIXED = 552 * MiB, WS_QABS = 680 * MiB, WS_RAW4 = 808 * MiB, WS_LAT = 808 * MiB, WS_ACT = 552 * MiB, WS_END = 936 * MiB;
static_assert(WS_WIN + (size_t)DINP * D * 2 <= WS_WQABS && WS_WGU + (size_t)NGU * D * 2 <= WS_WD && WS_WD + (size_t)D * DFF * 2 <= WS_RS1, "weights map");
static_assert(WS_AK + KVROWS * 256 <= WS_AV && WS_CKV + KVROWS * 256 <= WS_IKN && WS_IKN + KVROWS * 128 <= WS_OA, "kv map");
static_assert(WS_ACT + (size_t)M * DFF * 2 <= WS_END && WS_LAT + (size_t)M * 1024 * 2 <= WS_END && WS_TBL + 16 * 132 * 4 <= WS_AK, "act map");
constexpr int CW_TMO = 0, CW_BAR = 4096;
constexpr int TBLW = 132;

constexpr int RING_OFF = 0, RING_BYTES = 131072;
constexpr int LDSCTL_OFF = RING_BYTES, MISC_OFF = LDSCTL_OFF + 320;
constexpr int LDS_BYTES = 163840;
constexpr int NWAVES = 8;

#define RLX_AGENT __ATOMIC_RELAXED, __HIP_MEMORY_SCOPE_AGENT
#define LDS_WAIT() asm volatile("s_waitcnt lgkmcnt(0)" ::: "memory")
#define VM_WAIT() asm volatile("s_waitcnt vmcnt(0)" ::: "memory")

#define XB_TMO      128
#define XB_XCNT(j)  (256  + 64 * (j))
#define XB_XSUB(j)  (1280 + 64 * (j))
#define XB_XGEN(j)  (2304 + 64 * (j))
#define XB_TOP      3328
#define XB_TOPGEN   3392
#define XCD_BAR_WORDS 3456
#define XB_SPIN_CAP (1u << 18)
__device__ __forceinline__ unsigned xb_ld(unsigned* p)              { return __hip_atomic_load(p, __ATOMIC_RELAXED, __HIP_MEMORY_SCOPE_AGENT); }
__device__ __forceinline__ unsigned xb_add(unsigned* p, unsigned v) { return __hip_atomic_fetch_add(p, v, __ATOMIC_RELAXED, __HIP_MEMORY_SCOPE_AGENT); }
__device__ __forceinline__ unsigned xb_xcc_id() { return (unsigned)__builtin_amdgcn_s_getreg((3 << 11) | 20) & 0xFu; }
#define XB_SPIN(cond, bar) do { unsigned _sp = 0; while (cond) { __builtin_amdgcn_s_sleep(1); \
    if ((++_sp & 255u) == 0u) { if (xb_ld(&(bar)[XB_TMO])) break; if (_sp > XB_SPIN_CAP) { atomicAdd(&(bar)[XB_TMO], 1u); break; } } } } while (0)
struct XcdBarrier { unsigned* bar; unsigned x; volatile LAS unsigned* st; };
__device__ __forceinline__ XcdBarrier xcd_barrier_post(unsigned* bar, volatile LAS unsigned* st) {
    XcdBarrier b; b.bar = bar; b.x = xb_xcc_id(); b.st = st;
    if (threadIdx.x == 0) (void)xb_add(&bar[XB_XCNT(b.x)], 1u);
    return b;
}
__device__ __forceinline__ void xcd_barrier_complete(unsigned* bar, unsigned x, unsigned& nloc, unsigned& nx) {
    const unsigned G = gridDim.x * gridDim.y * gridDim.z;
    unsigned sum, cnt, mine, sp = 0u;
    for (;;) {
        sum = 0u; cnt = 0u; mine = 0u;
#pragma unroll
        for (unsigned j = 0; j < 16; ++j) { const unsigned c = xb_ld(&bar[XB_XCNT(j)]); sum += c; cnt += (c > 0u) ? 1u : 0u; mine = (j == x) ? c : mine; }
        if (sum == G) break;
        __builtin_amdgcn_s_sleep(1);
        if ((++sp & 255u) == 0u) { if (xb_ld(&bar[XB_TMO])) break; if (sp > XB_SPIN_CAP) { atomicAdd(&bar[XB_TMO], 1u); break; } }
    }
    nloc = mine > 0u ? mine : 1u; nx = cnt > 0u ? cnt : 1u;
}
__device__ __forceinline__ void xcd_barrier(const XcdBarrier& b) {
    asm volatile("s_waitcnt vmcnt(0)" ::: "memory");
    __syncthreads();
    if (threadIdx.x == 0) {
        unsigned* bar = b.bar;
        __builtin_amdgcn_s_waitcnt(0);
        unsigned nloc = b.st[0], nx = b.st[1];
        if (nloc == 0u) { xcd_barrier_complete(bar, b.x, nloc, nx); b.st[0] = nloc; b.st[1] = nx; }
        const unsigned old = xb_add(&bar[XB_XSUB(b.x)], 1u);
        const unsigned gen = old / nloc;
        if (old + 1u == (gen + 1u) * nloc) {
            __builtin_amdgcn_fence(__ATOMIC_RELEASE, "agent");
            asm volatile("s_waitcnt vmcnt(0)" ::: "memory");
            const unsigned og = xb_add(&bar[XB_TOP], 1u);
            const unsigned tg = og / nx;
            if (og + 1u == (tg + 1u) * nx) xb_add(&bar[XB_TOPGEN], 1u);
            else XB_SPIN(xb_ld(&bar[XB_TOPGEN]) == tg, bar);
            __builtin_amdgcn_fence(__ATOMIC_ACQUIRE, "agent");
            xb_add(&bar[XB_XGEN(b.x)], 1u);
            asm volatile("s_waitcnt vmcnt(0)" ::: "memory");
        } else {
            XB_SPIN(xb_ld(&bar[XB_XGEN(b.x)]) == gen, bar);
            __builtin_amdgcn_fence(__ATOMIC_ACQUIRE, "agent");
            asm volatile("s_waitcnt vmcnt(0)" ::: "memory");
        }
    }
    __syncthreads();
}

struct Args { const float* in[22]; float* out; unsigned char* ws; int ph_lo, ph_hi; };
struct Frame {
    const Args& A;
    __device__ __forceinline__ Frame(const Args& a) : A(a) {}
    LAS unsigned char* lds;
    int tid, lane, wave, vcu, G;
    __device__ __forceinline__ const float* x() const { return A.in[0]; }
    __device__ __forceinline__ const float* meta() const { return A.in[1]; }
    __device__ __forceinline__ const float* g1() const { return A.in[2]; }
    __device__ __forceinline__ const float* w_in() const { return A.in[3]; }
    __device__ __forceinline__ const float* bg() const { return A.in[4]; }
    __device__ __forceinline__ const float* qg() const { return A.in[5]; }
    __device__ __forceinline__ const float* kvg() const { return A.in[6]; }
    __device__ __forceinline__ const float* w_uq() const { return A.in[7]; }
    __device__ __forceinline__ const float* w_uk() const { return A.in[8]; }
    __device__ __forceinline__ const float* w_uv() const { return A.in[9]; }
    __device__ __forceinline__ const float* lng() const { return A.in[10]; }
    __device__ __forceinline__ const float* lnb() const { return A.in[11]; }
    __device__ __forceinline__ const float* sinks() const { return A.in[12]; }
    __device__ __forceinline__ const float* relb() const { return A.in[13]; }
    __device__ __forceinline__ const float* w_a() const { return A.in[14]; }
    __device__ __forceinline__ const float* w_b() const { return A.in[15]; }
    __device__ __forceinline__ const float* w_o() const { return A.in[16]; }
    __device__ __forceinline__ const float* g2() const { return A.in[17]; }
    __device__ __forceinline__ const float* w_g() const { return A.in[18]; }
    __device__ __forceinline__ const float* w_u() const { return A.in[19]; }
    __device__ __forceinline__ const float* w_d() const { return A.in[20]; }
    __device__ __forceinline__ const float* gf() const { return A.in[21]; }
    __device__ __forceinline__ float* out() const { return A.out; }
    unsigned char* ws;
    __device__ __forceinline__ h16* Win_t() const { return (h16*)(ws + WS_WIN); }
    __device__ __forceinline__ h16* Wqabs_t() const { return (h16*)(ws + WS_WQABS); }
    __device__ __forceinline__ h16* Wa_t() const { return (h16*)(ws + WS_WA); }
    __device__ __forceinline__ h16* Wuvb_t() const { return (h16*)(ws + WS_WUVB); }
    __device__ __forceinline__ h16* Wo_t() const { return (h16*)(ws + WS_WO); }
    __device__ __forceinline__ h16* Wgu_t() const { return (h16*)(ws + WS_WGU); }
    __device__ __forceinline__ h16* Wd_t() const { return (h16*)(ws + WS_WD); }
    __device__ __forceinline__ h16* H2() const { return (h16*)(ws + WS_H2); }
    __device__ __forceinline__ h16* AK() const { return (h16*)(ws + WS_AK); }
    __device__ __forceinline__ h16* AV() const { return (h16*)(ws + WS_AV); }
    __device__ __forceinline__ h16* CKV() const { return (h16*)(ws + WS_CKV); }
    __device__ __forceinline__ h16* IKN() const { return (h16*)(ws + WS_IKN); }
    __device__ __forceinline__ h16* OA() const { return (h16*)(ws + WS_OA); }
    __device__ __forceinline__ h16* AQ() const { return (h16*)(ws + WS_AQ); }
    __device__ __forceinline__ h16* BQ() const { return (h16*)(ws + WS_BQ); }
    __device__ __forceinline__ h16* IQ() const { return (h16*)(ws + WS_IQ); }
    __device__ __forceinline__ h16* H1() const { return (h16*)(ws + WS_H1); }
    __device__ __forceinline__ h16* XH() const { return (h16*)(ws + WS_XH); }
    __device__ __forceinline__ h16* MIXED() const { return (h16*)(ws + WS_MIXED); }
    __device__ __forceinline__ h16* QABS() const { return (h16*)(ws + WS_QABS); }
    __device__ __forceinline__ h16* LAT() const { return (h16*)(ws + WS_LAT); }
    __device__ __forceinline__ h16* ACT() const { return (h16*)(ws + WS_ACT); }
    __device__ __forceinline__ float* RS2() const { return (float*)(ws + WS_RS2); }
    __device__ __forceinline__ float* RS1() const { return (float*)(ws + WS_RS1); }
    __device__ __forceinline__ float* RSQ() const { return (float*)(ws + WS_RSQ); }
    __device__ __forceinline__ float* IWS() const { return (float*)(ws + WS_IWS); }
    __device__ __forceinline__ float* SSQ1() const { return (float*)(ws + WS_SSQ1); }
    __device__ __forceinline__ float* SSQ2() const { return (float*)(ws + WS_SSQ2); }
    __device__ __forceinline__ float* METAP() const { return (float*)(ws + WS_METAP); }
    __device__ __forceinline__ float* TBL() const { return (float*)(ws + WS_TBL); }
    __device__ __forceinline__ float* RAW4() const { return (float*)(ws + WS_RAW4); }
    __device__ __forceinline__ unsigned char* GATES() const { return ws + WS_GATES; }
};
__device__ __forceinline__ float wave_sum(float v) {
#pragma unroll
    for (int o = 1; o < 64; o <<= 1) v += __shfl_xor(v, o);
    return v;
}

__device__ __forceinline__ int inmap(int n) {
    if (n < 1152) return n;
    if (n < 1216) return 1408 + (n - 1152);
    if (n < 1220) return 1472 + (n - 1216);
    if (n < 1280) return -1;
    if (n < 1536) return 1152 + (n - 1280);
    return 1476 + (n - 1536);
}
template <int MODE> __device__ __forceinline__ void p0_transpose_item(const float* W, const float* W2, int ldw, int K, int N, const float* gain, h16* WT, LAS float* scr, int item, int lane) {
    const int nblk = N / 32, kb = item / nblk, nb = item % nblk, k0 = 64 * kb, n0 = 32 * nb;
    const int n4 = n0 + 4 * (lane & 7), kr = lane >> 3;
    const float* src = W; int oc = n4; float cs = 1.f;
    if (MODE == 0) { oc = inmap(n4); if (n4 < 512) cs = QSCALE; }
    if (MODE == 3) { const int pp = n4 >> 8, j = n4 & 255; oc = 128 * pp + (j & 127); src = (j < 128) ? W : W2; }
    f32x4 v[8];
#pragma unroll
    for (int i = 0; i < 8; ++i) { const int kk = 8 * i + kr; v[i] = (f32x4){0.f, 0.f, 0.f, 0.f}; if (oc >= 0) v[i] = *(const f32x4*)(src + (size_t)(k0 + kk) * ldw + oc); }
#pragma unroll
    for (int i = 0; i < 8; ++i) { const int kk = 8 * i + kr; const float gsc = (gain ? gain[k0 + kk] : 1.f) * cs;
#pragma unroll
        for (int e = 0; e < 4; ++e) scr[kk * 33 + 4 * (lane & 7) + e] = v[i][e] * gsc; }
    LDS_WAIT(); asm volatile("" ::: "memory");
    const int c = lane & 7;
#pragma unroll
    for (int j = 0; j < 4; ++j) { const int nn = (lane >> 3) + 8 * j; const LAS float* sp = scr + (8 * c) * 33 + nn;
        u32x4 o; o.x = pk_h2(sp[0 * 33], sp[1 * 33]); o.y = pk_h2(sp[2 * 33], sp[3 * 33]); o.z = pk_h2(sp[4 * 33], sp[5 * 33]); o.w = pk_h2(sp[6 * 33], sp[7 * 33]);
        *(u32x4*)(WT + (size_t)(n0 + nn) * K + k0 + 8 * c) = o; }
    LDS_WAIT(); asm volatile("" ::: "memory");
}
__device__ __forceinline__ int t5_bucket_d(int dist) {
    if (dist < 16) return dist;
    int large = 16 + (int)(log((double)dist / 16.0) / log(8.0) * 16.0);
    return large < 31 ? large : 31;
}
__device__ __forceinline__ void p0_prologue(Frame& F) {
    PSEC_DECL; PSEC_BEGIN(10);
    LAS float* scr = (LAS float*)(F.lds + RING_OFF + F.wave * 16384);
    const int gw = F.vcu * NWAVES + F.wave, NGW = F.G * NWAVES, lane = F.lane;
    constexpr int I_IN = (D / 64) * (DINP / 32), I_A = (512 / 64) * (D / 32), I_O = (D / 64) * (D / 32), I_GU = (D / 64) * (NGU / 32), I_D = (DFF / 64) * (D / 32);
    constexpr int I_QABS = 1024 * 4, I_UVB = 8 * 16 * 8, I_META = 7 * 8, I_TBL = 1;
    for (int it = gw; it < I_META; it += NGW) {
        int r = it;
        if (r < I_META) {
            const int cg = r >> 3, kc = r & 7, ci = cg * 64 + lane;
            const int oc = ci < 128 ? 512 + ci : (ci < 256 ? 640 + (ci - 128) : (ci < 384 ? 1024 + (ci - 256) : 1408 + (ci - 384)));
#pragma unroll 1
            for (int hf = 0; hf < 2; ++hf) {
                f32x4 mv[4], gv[4];
#pragma unroll
                for (int e4 = 0; e4 < 4; ++e4) { const int idx4 = (4 * hf + e4) * 64 + lane, q = idx4 >> 5, kk4 = idx4 & 31;
                    mv[e4] = *(const f32x4*)(F.meta() + q * 1024 + kc * 128 + 4 * kk4); gv[e4] = *(const f32x4*)(F.g1() + kc * 128 + 4 * kk4); }
#pragma unroll
                for (int e4 = 0; e4 < 4; ++e4) { const int idx4 = (4 * hf + e4) * 64 + lane, q = idx4 >> 5, kk4 = idx4 & 31;
#pragma unroll
                    for (int e = 0; e < 4; ++e) scr[(4 * kk4 + e) * 16 + q] = mv[e4][e] * gv[e4][e]; }
            }
            LDS_WAIT(); asm volatile("" ::: "memory");
            float a[16];
#pragma unroll
            for (int q = 0; q < 16; ++q) a[q] = 0.f;
            const float* wp = F.w_in() + (size_t)(kc * 128) * DIN + oc;
#pragma unroll 1
            for (int kb = 0; kb < 128; kb += 16) {
                float wv_[16];
#pragma unroll
                for (int kk = 0; kk < 16; ++kk) wv_[kk] = wp[(size_t)(kb + kk) * DIN];
#pragma unroll
                for (int kk = 0; kk < 16; ++kk) { const LAS f32x4* mp = (const LAS f32x4*)(scr + (kb + kk) * 16);
#pragma unroll
                    for (int q4 = 0; q4 < 4; ++q4) { const f32x4 m4 = mp[q4];
#pragma unroll
                        for (int e = 0; e < 4; ++e) a[4 * q4 + e] += m4[e] * wv_[kk]; }
                    if ((kk & 3) == 3) asm volatile("" ::: "memory"); } }
#pragma unroll
            for (int q = 0; q < 16; ++q) F.METAP()[(size_t)(kc * 16 + q) * 448 + ci] = a[q];
            LDS_WAIT(); asm volatile("" ::: "memory");
            continue; }
    }
    for (int it = gw; it < I_IN + I_A + I_O + I_GU + I_D; it += NGW) {
        int r = it;
        if (r < I_IN) { p0_transpose_item<0>(F.w_in(), nullptr, DIN, D, DINP, F.g1(), F.Win_t(), scr, r, lane); continue; } r -= I_IN;
        if (r < I_A) { p0_transpose_item<1>(F.w_a(), nullptr, D, 512, D, nullptr, F.Wa_t(), scr, r, lane); continue; } r -= I_A;
        if (r < I_O) { p0_transpose_item<1>(F.w_o(), nullptr, D, D, D, nullptr, F.Wo_t(), scr, r, lane); continue; } r -= I_O;
        if (r < I_GU) { p0_transpose_item<3>(F.w_g(), F.w_u(), DFF, D, NGU, F.g2(), F.Wgu_t(), scr, r, lane); continue; } r -= I_GU;
        if (r < I_D) { p0_transpose_item<1>(F.w_d(), nullptr, D, DFF, D, nullptr, F.Wd_t(), scr, r, lane); continue; }
    }
    for (int it = gw; it < I_QABS; it += NGW) {
        int r = it;
        if (r < I_QABS) {
            const int n = r >> 2, rr = (r & 3) * 64 + lane, h = n >> 7, c = n & 127;
            const f32x4* uq = (const f32x4*)(F.w_uq() + (size_t)rr * 512 + h * 64); const __attribute__((address_space(4))) f32x4* uk = (const __attribute__((address_space(4))) f32x4*)(F.w_uk() + (size_t)c * 512 + h * 64);
            float a = 0.f;
#pragma unroll 8
            for (int d = 0; d < 16; ++d) { const f32x4 p = uq[d], q = uk[d]; a += (p[0] * q[0] + p[1] * q[1]) + (p[2] * q[2] + p[3] * q[3]); }
            F.Wqabs_t()[(size_t)n * 256 + rr] = __builtin_bit_cast(h16, (_Float16)(a * QSCALE * F.qg()[rr]));
            continue; }
    }
    for (int it = (gw + NGW / 2) % NGW; it < I_UVB; it += NGW) {
        int r = it;
        if (r < I_UVB) {
            const int h = r >> 7, cg = (r >> 6) & 1, ng = r & 63, c = cg * 64 + lane, n0 = ng * 16;
            const f32x4* uvp = (const f32x4*)(F.w_uv() + (size_t)c * 512 + h * 64);
            f32x4 uv4[16];
#pragma unroll
            for (int d4 = 0; d4 < 16; ++d4) uv4[d4] = uvp[d4];
            const float* wb = F.w_b() + (size_t)(h * 64) * 1024 + n0;
            float a[16];
#pragma unroll
            for (int q = 0; q < 16; ++q) a[q] = 0.f;
#pragma unroll
            for (int d4 = 0; d4 < 16; ++d4)
#pragma unroll
                for (int e = 0; e < 4; ++e) { const __attribute__((address_space(4))) float* wr = (const __attribute__((address_space(4))) float*)(wb + (size_t)(4 * d4 + e) * 1024);
#pragma unroll
                    for (int q = 0; q < 16; ++q) a[q] += uv4[d4][e] * wr[q];
                    asm volatile("" ::: "memory"); }
            h16* op = F.Wuvb_t() + (size_t)n0 * 1024 + h * 128 + c;
#pragma unroll
            for (int q = 0; q < 16; ++q) op[(size_t)q * 1024] = __builtin_bit_cast(h16, (_Float16)a[q]);
            continue; }
    }
    if (gw >= NGW - 3) {
        const int dd = 64 * (NGW - 1 - gw) + lane;
        if (dd < 129) { const int bk = t5_bucket_d(dd);
#pragma unroll
            for (int hh = 0; hh < 16; ++hh) F.TBL()[hh * TBLW + dd] = LOG2E * F.relb()[bk * 16 + hh]; }
    }
    PSEC_END(10); PSEC_BEGIN(11);
    f32x4 vn[8];
    if (2 * gw < M) { const f32x4* xr = (const f32x4*)(F.x() + (size_t)(2 * gw) * D) + lane;
#pragma unroll
        for (int j = 0; j < 8; ++j) vn[j] = xr[64 * j]; }
    for (int row = 2 * gw; row < M; row += 2 * NGW) {
        f32x4 v[8]; float s0 = 0.f, s1 = 0.f;
#pragma unroll
        for (int j = 0; j < 8; ++j) v[j] = vn[j];
        if (row + 2 * NGW < M) { const f32x4* xr = (const f32x4*)(F.x() + (size_t)(row + 2 * NGW) * D) + lane;
#pragma unroll
            for (int j = 0; j < 8; ++j) vn[j] = xr[64 * j]; }
#pragma unroll
        for (int j = 0; j < 4; ++j) { s0 += (v[j][0] * v[j][0] + v[j][1] * v[j][1]) + (v[j][2] * v[j][2] + v[j][3] * v[j][3]);
            s1 += (v[j + 4][0] * v[j + 4][0] + v[j + 4][1] * v[j + 4][1]) + (v[j + 4][2] * v[j + 4][2] + v[j + 4][3] * v[j + 4][3]); }
#pragma unroll
        for (int o = 1; o < 64; o <<= 1) { s0 += __shfl_xor(s0, o); s1 += __shfl_xor(s1, o); }
        if (lane == 0) { F.RS1()[row] = 1.0f / sqrtf(s0 * (1.0f / D) + EPS); F.RS1()[row + 1] = 1.0f / sqrtf(s1 * (1.0f / D) + EPS); }
        u32x2* o8 = (u32x2*)(F.XH() + (size_t)row * D) + lane;
#pragma unroll
        for (int j = 0; j < 8; ++j) { u32x2 w; w.x = pk_h2(v[j][0], v[j][1]); w.y = pk_h2(v[j][2], v[j][3]); o8[64 * j] = w; }
    }
    PSEC_END(11); PSEC_BURN(10, 11);
}

__device__ __forceinline__ void p2_norms(Frame& F) {
    PSEC_DECL; PSEC_BEGIN(20);
    const int gw = F.vcu * NWAVES + F.wave, NGW = F.G * NWAVES, lane = F.lane;
    const float kg0 = F.kvg()[2 * lane], kg1 = F.kvg()[2 * lane + 1], lg = F.lng()[lane], lb = F.lnb()[lane];
    float nb0[4], nb1[4], nik[4], niw[4]; u32x2 nqw[4];
#define P2_LOAD(r4_) do { _Pragma("unroll") for (int u = 0; u < 4; ++u) { const float* rw = F.RAW4() + (size_t)((r4_) + u) * 256; \
            nb0[u] = rw[2 * lane]; nb1[u] = rw[2 * lane + 1]; nik[u] = rw[128 + lane]; niw[u] = rw[192 + (lane & 3)]; \
            nqw[u] = ((const u32x2*)(F.BQ() + (size_t)((r4_) + u) * 256))[lane]; } } while (0)
    if (4 * gw < M) P2_LOAD(4 * gw);
    for (int row4 = 4 * gw; row4 < M; row4 += 4 * NGW) {
        float b0[4], b1[4], ik[4], q0[4], q1[4], q2[4], q3[4], iw[4];
#pragma unroll
        for (int u = 0; u < 4; ++u) { b0[u] = nb0[u]; b1[u] = nb1[u]; ik[u] = nik[u]; iw[u] = niw[u]; const h16x4 qh = __builtin_bit_cast(h16x4, nqw[u]);
            q0[u] = (float)qh[0]; q1[u] = (float)qh[1]; q2[u] = (float)qh[2]; q3[u] = (float)qh[3]; }
        if (row4 + 4 * NGW < M) P2_LOAD(row4 + 4 * NGW);
        float sb[4], si[4], sq[4];
#pragma unroll
        for (int u = 0; u < 4; ++u) { sb[u] = b0[u] * b0[u] + b1[u] * b1[u]; si[u] = ik[u]; sq[u] = (q0[u] * q0[u] + q1[u] * q1[u]) + (q2[u] * q2[u] + q3[u] * q3[u]); }
#pragma unroll
        for (int o = 1; o < 64; o <<= 1) {
#pragma unroll
            for (int u = 0; u < 4; ++u) { sb[u] += __shfl_xor(sb[u], o); si[u] += __shfl_xor(si[u], o); sq[u] += __shfl_xor(sq[u], o); } }
        float dc[4], sv[4];
#pragma unroll
        for (int u = 0; u < 4; ++u) { dc[u] = ik[u] - si[u] * (1.0f / 64.0f); sv[u] = dc[u] * dc[u]; }
#pragma unroll
        for (int o = 1; o < 64; o <<= 1) {
#pragma unroll
            for (int u = 0; u < 4; ++u) sv[u] += __shfl_xor(sv[u], o); }
#pragma unroll
        for (int u = 0; u < 4; ++u) { const int row = row4 + u; const size_t prow = (size_t)(row >> 11) * P + BLK + (row & 2047);
            const float rk = 1.0f / sqrtf(sb[u] * (1.0f / 128.0f) + EPS);
            ((unsigned*)(F.CKV() + prow * 128))[lane] = pk_h2(b0[u] * rk * kg0, b1[u] * rk * kg1);
            F.IKN()[prow * 64 + lane] = __builtin_bit_cast(h16, (_Float16)(dc[u] * (1.0f / sqrtf(sv[u] * (1.0f / 64.0f) + EPS)) * lg + lb));
            if (lane < 4) F.IWS()[(size_t)row * 4 + lane] = iw[u] * 0.0625f;
            if (lane == 0) F.RSQ()[row] = 1.0f / sqrtf(sq[u] * (1.0f / 256.0f) + EPS); }
    }
#undef P2_LOAD
    for (int it = gw; it < 16 * BATCH; it += NGW) {
        const int r = it & 15, b = it >> 4;
        float mv[16]; float s = 0.f;
#pragma unroll
        for (int k = 0; k < 16; ++k) mv[k] = F.meta()[r * 1024 + k * 64 + lane];
        float v[7], pa[7][8];
#pragma unroll
        for (int cg = 0; cg < 7; ++cg)
#pragma unroll
            for (int kc = 0; kc < 8; ++kc) pa[cg][kc] = F.METAP()[(size_t)(kc * 16 + r) * 448 + cg * 64 + lane];
#pragma unroll
        for (int k = 0; k < 16; ++k) s += mv[k] * mv[k];
        const float rsm = 1.0f / sqrtf(wave_sum(s) * (1.0f / D) + EPS);
#pragma unroll
        for (int cg = 0; cg < 7; ++cg) { float a = 0.f;
#pragma unroll
            for (int kc = 0; kc < 8; ++kc) a += pa[cg][kc];
            v[cg] = a * rsm; }
        const float rk = 1.0f / sqrtf(wave_sum(v[4] * v[4] + v[5] * v[5]) * (1.0f / 128.0f) + EPS);
        const float c0 = v[4] * rk * F.kvg()[lane], c1 = v[5] * rk * F.kvg()[64 + lane];
        const float mu = wave_sum(v[6]) * (1.0f / 64.0f), dc = v[6] - mu, var = wave_sum(dc * dc) * (1.0f / 64.0f);
        const float ikn = dc * (1.0f / sqrtf(var + EPS)) * lg + lb;
        const size_t prow = (size_t)b * P + NPAD + r;
        F.AK()[prow * 128 + lane] = __builtin_bit_cast(h16, (_Float16)v[0]); F.AK()[prow * 128 + 64 + lane] = __builtin_bit_cast(h16, (_Float16)v[1]);
        F.AV()[prow * 128 + lane] = __builtin_bit_cast(h16, (_Float16)v[2]); F.AV()[prow * 128 + 64 + lane] = __builtin_bit_cast(h16, (_Float16)v[3]);
        F.CKV()[prow * 128 + lane] = __builtin_bit_cast(h16, (_Float16)c0); F.CKV()[prow * 128 + 64 + lane] = __builtin_bit_cast(h16, (_Float16)c1);
        F.IKN()[prow * 64 + lane] = __builtin_bit_cast(h16, (_Float16)ikn);
    }
    for (int it = gw; it < BATCH * NPAD; it += NGW) { const size_t prow = (size_t)(it / NPAD) * P + (it % NPAD);
        ((unsigned*)(F.AK() + prow * 128))[lane] = 0u; ((unsigned*)(F.AV() + prow * 128))[lane] = 0u; ((unsigned*)(F.CKV() + prow * 128))[lane] = 0u;
        if (lane < 32) ((unsigned*)(F.IKN() + prow * 64))[lane] = 0u; }
    PSEC_END(20); PSEC_BURN(20, 20);
}

constexpr int A_KSTR = 144, A_LDS_K = 0, A_LDS_V = 256 * A_KSTR, A_LDS_TB = 2 * 256 * A_KSTR;
__device__ __forceinline__ void attn_a_phase(Frame& F) {
    PSEC_DECL; PSEC_BEGIN(5);
    LAS unsigned char* lds = F.lds;
    const int lane = F.lane, w = F.wave, tid = F.tid, q32 = lane & 31, hh = lane >> 5;
    const float NINF = -__builtin_inff();
    const int g = w & 3;
    const int nun = BATCH * 16 * 2;
    u32x4 kreg[4], vreg[4]; float tbreg = 0.f; h16x8 qn[2][4];
#define AA_LOAD(u_) do { const int kvh_ = (u_) & 1, blk_ = 1 + (((u_) >> 1) & 15), b_ = (u_) >> 5; const size_t kb_ = (size_t)b_ * P + (size_t)(blk_ - 1) * BLK; \
        _Pragma("unroll") for (int i = 0; i < 4; ++i) { const int id = i * 512 + tid, row = id >> 3, ch = id & 7; \
            kreg[i] = *(const u32x4*)(F.AK() + (kb_ + row) * 128 + kvh_ * 64 + ch * 8); vreg[i] = *(const u32x4*)(F.AV() + (kb_ + row) * 128 + kvh_ * 64 + ch * 8); } \
        tbreg = F.TBL()[(kvh_ * 4 + (tid >> 7)) * TBLW + (tid & 127)]; \
        _Pragma("unroll") for (int qq = 0; qq < 2; ++qq) { const size_t qrow_ = (size_t)b_ * SEQ + (size_t)(blk_ - 1) * BLK + ((w >> 2) * 2 + qq) * 32 + q32; \
            _Pragma("unroll") for (int ks = 0; ks < 4; ++ks) qn[qq][ks] = *(const h16x8*)(F.AQ() + qrow_ * 512 + (kvh_ * 4 + g) * 64 + ks * 16 + hh * 8); } } while (0)
    if (F.vcu < nun) AA_LOAD(F.vcu);
    for (int u = F.vcu; u < nun; u += F.G) {
        const int kvh = u & 1, blk = 1 + ((u >> 1) & 15), b = u >> 5;
        __syncthreads();
#pragma unroll
        for (int i = 0; i < 4; ++i) { const int id = i * 512 + tid, row = id >> 3, ch = id & 7;
            *(LAS u32x4*)(lds + A_LDS_K + row * A_KSTR + ch * 16) = kreg[i]; *(LAS u32x4*)(lds + A_LDS_V + row * A_KSTR + ch * 16) = vreg[i]; }
        ((LAS float*)(lds + A_LDS_TB))[tid] = tbreg;
        h16x8 qf[2][4];
#pragma unroll
        for (int qq = 0; qq < 2; ++qq)
#pragma unroll
            for (int ks = 0; ks < 4; ++ks) qf[qq][ks] = qn[qq][ks];
        __syncthreads();
        if (u + F.G < nun) AA_LOAD(u + F.G);
        const int head = kvh * 4 + g;
        const float sink = F.sinks()[head] * LOG2E;
        const LAS float* TB = (const LAS float*)(lds + A_LDS_TB) + g * 128;
        const unsigned vtr = (unsigned)(A_LDS_V + (4 * hh + ((lane & 15) >> 2)) * A_KSTR + (16 * ((lane >> 4) & 1) + 4 * (lane & 3)) * 2);
#pragma unroll 1
        for (int qq = 0; qq < 2; ++qq) {
            h16x8 qc[4];
            if (qq == 0) { qc[0] = qf[0][0]; qc[1] = qf[0][1]; qc[2] = qf[0][2]; qc[3] = qf[0][3]; } else { qc[0] = qf[1][0]; qc[1] = qf[1][1]; qc[2] = qf[1][2]; qc[3] = qf[1][3]; }
            const int qg = (w >> 2) * 2 + qq, i_loc = qg * 32 + q32;
            const size_t qrow = (size_t)b * SEQ + (size_t)(blk - 1) * BLK + i_loc;
            float m_run = sink, l_run = 1.0f;
            f32x16 o0, o1;
#pragma unroll
            for (int r = 0; r < 16; ++r) { o0[r] = 0.f; o1[r] = 0.f; }
            for (int kt = qg; kt <= qg + 4; ++kt) {
                f32x16 sacc;
#pragma unroll
                for (int r = 0; r < 16; ++r) sacc[r] = 0.f;
#pragma unroll
                for (int ks = 0; ks < 4; ++ks) { const h16x8 kf = *(const LAS h16x8*)(lds + A_LDS_K + (kt * 32 + q32) * A_KSTR + (ks * 16 + hh * 8) * 2);
                    sacc = __builtin_amdgcn_mfma_f32_32x32x16_f16(kf, qc[ks], sacc, 0, 0, 0); }
                float mx = NINF;
                float bia[16];
#pragma unroll
                for (int r = 0; r < 16; ++r) { const int j = kt * 32 + (r & 3) + 8 * (r >> 2) + 4 * hh, dist = 128 + i_loc - j; bia[r] = TB[dist & 127]; }
                if (kt == qg || kt == qg + 4 || blk == 1) {
#pragma unroll
                    for (int r = 0; r < 16; ++r) { const int j = kt * 32 + (r & 3) + 8 * (r >> 2) + 4 * hh, dist = 128 + i_loc - j;
                        const bool valid = (dist >= 0) && (dist < 128) && ((blk - 1) * BLK + j >= NPAD);
                        const float v0 = sacc[r] + bia[r]; const float v = valid ? v0 : NINF; sacc[r] = v; mx = fmaxf(mx, v); }
                } else {
#pragma unroll
                    for (int r = 0; r < 16; ++r) { const float v = sacc[r] + bia[r]; sacc[r] = v; mx = fmaxf(mx, v); }
                }
                mx = fmaxf(mx, __shfl_xor(mx, 32));
                if (__any(mx > m_run + 8.0f)) {
                    const float m_new = fmaxf(m_run, mx), alpha = __builtin_amdgcn_exp2f(m_run - m_new);
                    l_run *= alpha; m_run = m_new;
#pragma unroll
                    for (int r = 0; r < 16; ++r) { o0[r] *= alpha; o1[r] *= alpha; }
                }
                float ps = 0.f;
#pragma unroll
                for (int r = 0; r < 16; ++r) { const float p = __builtin_amdgcn_exp2f(sacc[r] - m_run); sacc[r] = p; ps += p; }
                ps += __shfl_xor(ps, 32);
                l_run += ps;
#pragma unroll
                for (int sx = 0; sx < 2; ++sx) {
                    const u32x4 pw = {pk_h2(sacc[8 * sx], sacc[8 * sx + 1]), pk_h2(sacc[8 * sx + 2], sacc[8 * sx + 3]), pk_h2(sacc[8 * sx + 4], sacc[8 * sx + 5]), pk_h2(sacc[8 * sx + 6], sacc[8 * sx + 7])};
                    const h16x8 pf = __builtin_bit_cast(h16x8, pw);
                    const LAS unsigned char* vb = lds + vtr + (kt * 32 + 16 * sx) * A_KSTR;
                    const h16x4 a0l = ds_tr16a(vb), a0h = ds_tr16a(vb + 8 * A_KSTR), a1l = ds_tr16a(vb + 64), a1h = ds_tr16a(vb + 8 * A_KSTR + 64);
                    const h16x8 va0 = {a0l[0], a0l[1], a0l[2], a0l[3], a0h[0], a0h[1], a0h[2], a0h[3]}, va1 = {a1l[0], a1l[1], a1l[2], a1l[3], a1h[0], a1h[1], a1h[2], a1h[3]};
                    o0 = __builtin_amdgcn_mfma_f32_32x32x16_f16(va0, pf, o0, 0, 0, 0);
                    o1 = __builtin_amdgcn_mfma_f32_32x32x16_f16(va1, pf, o1, 0, 0, 0); }
            }
            const float inv = 1.0f / l_run;
            h16* op = F.OA() + qrow * 512 + head * 64 + 4 * hh;
#pragma unroll
            for (int g4 = 0; g4 < 4; ++g4) {
                u32x2 w0, w1; w0.x = pk_h2(o0[4 * g4] * inv, o0[4 * g4 + 1] * inv); w0.y = pk_h2(o0[4 * g4 + 2] * inv, o0[4 * g4 + 3] * inv);
                w1.x = pk_h2(o1[4 * g4] * inv, o1[4 * g4 + 1] * inv); w1.y = pk_h2(o1[4 * g4 + 2] * inv, o1[4 * g4 + 3] * inv);
                *(u32x2*)(op + 8 * g4) = w0; *(u32x2*)(op + 32 + 8 * g4) = w1; }
        }
    }
#undef AA_LOAD
    __syncthreads();
    PSEC_END(5); PSEC_BURN(5, 5);
}

constexpr int L3_STAGE = 0  , L3_HIST = 0  , HROW = 260, L3_DUMMY = 32 * HROW * 4,
              L3_SEL = MISC_OFF + 704  , L3_RES = L3_SEL + 32 * 256 * 2, L3_CNT2 = L3_RES + 32 * 4 * 4, L3_TB = L3_CNT2 + 32 * 32 * 4, L3_END = L3_TB + 8 * TBLW * 4;
static_assert(L3_SEL >= MISC_OFF + 128 && L3_SEL % 16 == 0 && L3_END <= LDS_BYTES && L3_DUMMY % 16 == 0 && L3_DUMMY + 4096 <= RING_BYTES, "P3 LDS map");
__device__ __forceinline__ h16x4 ds_tr16(const LAS unsigned char* p) { return __builtin_bit_cast(h16x4, __builtin_amdgcn_ds_read_tr16_b64_v4i16((LAS s16x4*)p)); }
__device__ __forceinline__ void mixer_b_phase(Frame& F) {
    PSEC_DECL;
    LAS unsigned char* lds = F.lds;
    const int w = F.wave, tid = F.tid;
    const float NINF = -__builtin_inff();
    LAS unsigned short* SEL = (LAS unsigned short*)(lds + L3_SEL);
    LAS unsigned* HIST = (LAS unsigned*)(lds + L3_HIST);
    LAS unsigned* RES = (LAS unsigned*)(lds + L3_RES);
    LAS unsigned* CNT2 = (LAS unsigned*)(lds + L3_CNT2);
    LAS float* TB = (LAS float*)(lds + L3_TB);
    LAS unsigned char* stage = lds + L3_STAGE + w * 16384;
    __syncthreads();
    for (int e = tid; e < 8 * 130; e += 512) { const int hh = e / 130, dd = e % 130; TB[hh * TBLW + dd] = dd ? F.TBL()[(8 + hh) * TBLW + dd - 1] : NINF; }
    const int nunits = BATCH * 16 * 4;
    PSEC_BEGIN(4);
    for (int it = 0; ; ++it) {
        int lane = F.lane; asm volatile("" : "+v"(lane));
        const int n16 = lane & 15, g = lane >> 4;
        int b, blk, sub;
        if (F.G == 256) {
            if (it >= 8) break; b = 4 * (F.vcu >> 5) + (F.vcu & 3); sub = (F.vcu >> 2) & 3; const int par = (F.vcu >> 4) & 1, k4 = 4 * (it >> 1);
            blk = (it & 1) ? 16 - par - k4 : 1 + par + k4; }
        else { const int uid = F.vcu + it * F.G; if (uid >= nunits) break; b = uid >> 6; sub = (uid >> 4) & 3; blk = 1 + (uid & 15); }
        const int t0 = (blk - 1) * BLK + sub * 32;
        const size_t qrow0 = (size_t)b * SEQ + t0;
        const int ntile = (blk + 1) * 8;
        const GAS h16* ikb = (const GAS h16*)(F.IKN() + (size_t)b * P * 64);
        for (int e = tid; e < 32 * HROW; e += 512) HIST[e] = 0u;
        PSEC_BEGIN(0);
        unsigned sk[2][17][4];
#pragma unroll
        for (int gq = 0; gq < 2; ++gq) {
            h16x8 qb[4][2];
#pragma unroll
            for (int h = 0; h < 4; ++h)
#pragma unroll
                for (int ks = 0; ks < 2; ++ks) qb[h][ks] = *(const GAS h16x8*)((const GAS h16*)F.IQ() + (qrow0 + 16 * gq + n16) * 256 + h * 64 + ks * 32 + 8 * g);
            const f32x4 wv = *(const GAS f32x4*)((const GAS float*)F.IWS() + (qrow0 + 16 * gq + n16) * 4);
            const int qpos = BLK + t0 + 16 * gq + n16;
            int kb1 = w * 16 + 4 * g; asm volatile("" : "+v"(kb1));
            const GAS h16* ap = ikb + (size_t)(w * 16 + n16) * 64 + 8 * g;
            h16x8 A0[22], A1[22];
            { const u32x4 z = {0u, 0u, 0u, 0u};
#pragma unroll
              for (int j = 0; j < 22; ++j) { A0[j] = __builtin_bit_cast(h16x8, z); A1[j] = A0[j]; } }
#pragma unroll
            for (int j = 0; j < 3; ++j) if (w + 8 * j < ntile) { A0[j] = *(const GAS h16x8*)(ap + 8192 * j); A1[j] = *(const GAS h16x8*)(ap + 8192 * j + 32); }
            ap += 2 * 8192;
#pragma unroll
            for (int j = 0; j < 17; ++j) {
                const int kt = w + 8 * j;
                ap += 8192; asm volatile("" : "+v"(ap));
                if (j + 3 < 17 && kt + 24 < ntile) { A0[j + 3] = *(const GAS h16x8*)ap; A1[j + 3] = *(const GAS h16x8*)(ap + 32); }
                asm volatile("" ::: "memory");
                if (kt < ntile) {
                    float sc[4] = {0.f, 0.f, 0.f, 0.f};
#pragma unroll
                    for (int h = 0; h < 4; ++h) { f32x4 c = {0.f, 0.f, 0.f, 0.f};
                        c = __builtin_amdgcn_mfma_f32_16x16x32_f16(A0[j], qb[h][0], c, 0, 0, 0); c = __builtin_amdgcn_mfma_f32_16x16x32_f16(A1[j], qb[h][1], c, 0, 0, 0);
#pragma unroll
                        for (int r = 0; r < 4; ++r) sc[r] += fmaxf(c[r], 0.f) * wv[h]; }
                    const unsigned zk = 0x7fffffffu - (unsigned)(kb1 + 128 * j);
#pragma unroll
                    for (int r = 0; r < 4; ++r) { const unsigned bits = __builtin_bit_cast(unsigned, sc[r]);
                        const unsigned key = bits ^ ((unsigned)((int)bits >> 31) | 0x80000000u);
                        sk[gq][j][r] = (sc[r] == 0.f) ? zk - (unsigned)r : key; }
                    if (kt < 7 || kt * 16 + 15 > BLK + t0 + 16 * gq) {
#pragma unroll
                        for (int r = 0; r < 4; ++r) { const int kpos = kb1 + 128 * j + r; if (kpos < NPAD || kpos > qpos) sk[gq][j][r] = 0u; }
                    }
                } else {
#pragma unroll
                    for (int r = 0; r < 4; ++r) sk[gq][j][r] = 0u;
                }
            }
        }
        PSEC_END(0); PSEC_BEGIN(1);
        unsigned prefix[2] = {0u, 0u}, T[2] = {1u, 1u}; int need[2]; bool done[2]; unsigned hbase[2];
#pragma unroll
        for (int gq = 0; gq < 2; ++gq) { const int nadm = BLK + t0 + 16 * gq + n16 - NPAD + 1; need[gq] = nadm < TOPK ? nadm : TOPK; done[gq] = (nadm <= TOPK); hbase[gq] = (unsigned)(16 * gq + n16) * (unsigned)HROW; }
        const unsigned sink = (unsigned)(L3_DUMMY - L3_HIST) / 4u + (unsigned)tid;
        __syncthreads();
#define RADIX_SCAN_UPDATE() do { \
            __syncthreads(); \
            { \
                const int qs = 4 * w + g, l16 = n16; \
                LAS u32x4* hp = (LAS u32x4*)(HIST + qs * HROW + 16 * l16); \
                const u32x4 c0 = hp[0], c1 = hp[1], c2 = hp[2], c3 = hp[3]; const u32x4 z = {0u, 0u, 0u, 0u}; hp[0] = z; hp[1] = z; hp[2] = z; hp[3] = z; \
                const unsigned cnt[16] = {c0[0], c0[1], c0[2], c0[3], c1[0], c1[1], c1[2], c1[3], c2[0], c2[1], c2[2], c2[3], c3[0], c3[1], c3[2], c3[3]}; \
                unsigned t = 0u; \
_Pragma("unroll") \
                for (int i = 0; i < 16; ++i) t += cnt[i]; \
                unsigned incl = t; \
_Pragma("unroll") \
                for (int d = 1; d < 16; d <<= 1) { const unsigned v = (unsigned)__shfl_down((int)incl, d, 16); incl += (l16 + d < 16) ? v : 0u; } \
                const unsigned S = incl - t; \
 \
                const int nq = 4 * (w & 3) + g; \
                const unsigned mq = (w >= 4) ? (unsigned)__shfl(need[1], nq) : (unsigned)__shfl(need[0], nq); \
                const int dq = (w >= 4) ? __shfl((int)done[1], nq) : __shfl((int)done[0], nq); \
                if (!dq && S < mq && mq <= S + t) { \
                    unsigned acc = S, bsel = 0u, msel = 0u, csel = 0u; \
_Pragma("unroll") \
                    for (int i = 15; i >= 0; --i) { if (acc < mq && mq <= acc + cnt[i]) { bsel = (unsigned)(16 * l16 + i); msel = mq - acc; csel = cnt[i]; } acc += cnt[i]; } \
                    RES[qs * 4 + 0] = bsel; RES[qs * 4 + 1] = msel; RES[qs * 4 + 2] = csel; \
                } \
            } \
            __syncthreads(); \
_Pragma("unroll") \
            for (int gq = 0; gq < 2; ++gq) \
                if (!done[gq]) { const int qi = 16 * gq + n16; const unsigned bsel = RES[qi * 4 + 0], msel = RES[qi * 4 + 1], csel = RES[qi * 4 + 2]; \
                    prefix[gq] |= bsel << shift; \
                    if (csel == msel || pass == 3) { done[gq] = true; T[gq] = prefix[gq]; } else need[gq] = (int)msel; } \
 \
        } while (0)
        if (__any(!done[0] || !done[1])) {
            { const int pass = 0, shift = 24;
#pragma unroll
              for (int gq = 0; gq < 2; ++gq)
#pragma unroll
                for (int j = 0; j < 17; ++j) if (w + 8 * j < ntile) {
#pragma unroll
                    for (int r = 0; r < 4; ++r) __hip_atomic_fetch_add(HIST + hbase[gq] + (sk[gq][j][r] >> 24), 1u, __ATOMIC_RELAXED, __HIP_MEMORY_SCOPE_WORKGROUP); }
              RADIX_SCAN_UPDATE(); }
#pragma unroll 1
            for (int pass = 1; pass < 4; ++pass) {
                if (!__any(!done[0] || !done[1])) break;
                const int shift = 24 - 8 * pass;
#pragma unroll
                for (int gq = 0; gq < 2; ++gq) {
                    const unsigned pfx = done[gq] ? 0xffffffffu : prefix[gq];
#pragma unroll
                    for (int j = 0; j < 17; ++j) if (w + 8 * j < ntile) {
                        unsigned mm[4];
#pragma unroll
                        for (int r = 0; r < 4; ++r) mm[r] = ((sk[gq][j][r] ^ pfx) >> shift) >> 8;
                        if (pass == 1 || __any((mm[0] == 0u) | (mm[1] == 0u) | (mm[2] == 0u) | (mm[3] == 0u))) {
#pragma unroll
                            for (int r = 0; r < 4; ++r) { const unsigned slot = mm[r] ? sink : hbase[gq] + ((sk[gq][j][r] >> shift) & 255u);
                                __hip_atomic_fetch_add(HIST + slot, 1u, __ATOMIC_RELAXED, __HIP_MEMORY_SCOPE_WORKGROUP); } } } }
                RADIX_SCAN_UPDATE();
            }
        }
#undef RADIX_SCAN_UPDATE
        PSEC_END(1); PSEC_BEGIN(2);
        {
            int kb2 = w * 16 + 4 * g; asm volatile("" : "+v"(kb2));
            const int mine = w * 4 + g;
#pragma unroll
            for (int gq = 0; gq < 2; ++gq) { int c = 0;
#pragma unroll
                for (int j = 0; j < 17; ++j) if (w + 8 * j < ntile) {
#pragma unroll
                    for (int r = 0; r < 4; ++r) c += (sk[gq][j][r] >= T[gq]) ? 1 : 0; }
                CNT2[(16 * gq + n16) * 32 + mine] = (unsigned)c; }
            __syncthreads();
#pragma unroll
            for (int gq = 0; gq < 2; ++gq) { const int qi = 16 * gq + n16; int off = 0;
#pragma unroll
                for (int o4 = 0; o4 < 8; ++o4) { const u32x4 cv = *(const LAS u32x4*)(CNT2 + qi * 32 + 4 * o4);
#pragma unroll
                    for (int e = 0; e < 4; ++e) off += (4 * o4 + e < mine) ? (int)cv[e] : 0; }
                unsigned cur = (unsigned)(L3_SEL + (qi * 256 + off) * 2); const unsigned lim = (unsigned)(L3_SEL + (qi * 256 + 255) * 2), trash = (unsigned)(L3_DUMMY + 2048 + tid * 2);
#pragma unroll
                for (int j = 0; j < 17; ++j) if (w + 8 * j < ntile) {
#pragma unroll
                    for (int r = 0; r < 4; ++r) { const bool selk = sk[gq][j][r] >= T[gq];
                        *(LAS unsigned short*)(lds + (selk ? (cur < lim ? cur : lim) : trash)) = (unsigned short)(kb2 + 128 * j + r); cur += selk ? 2u : 0u; } } }
            if (BLK + t0 - NPAD + 1 < TOPK) {
                for (int e = tid; e < 32 * 256; e += 512) { const int qpe = BLK + t0 + (e >> 8), nse = qpe - NPAD + 1; if ((e & 255) >= nse) SEL[e] = (unsigned short)(qpe + 1); }
            }
            __syncthreads();
        }
        PSEC_END(2); PSEC_BEGIN(3);
        const __amdgpu_buffer_rsrc_t crs = __builtin_amdgcn_make_buffer_rsrc((void*)(F.CKV() + (size_t)b * P * 128), 0, P * 256, 0x00020000);
            u32x4 G[16];
            const unsigned goff = (unsigned)n16 * 16u;
#define MLA_GATHER(sq_, c_) do { _Pragma("unroll") for (int kk = 0; kk < 2; ++kk) { const int i0_ = 64 * (c_) + 32 * kk + 8 * g; const u32x4 sv_ = *(const LAS u32x4*)((sq_) + i0_); \
                _Pragma("unroll") for (int i = 0; i < 8; ++i) {   \
                const unsigned vo_ = __builtin_amdgcn_perm(sv_[i >> 1], goff, (i & 1) ? 0x01070600u : 0x01050400u); \
                G[8 * kk + i] = __builtin_bit_cast(u32x4, __builtin_amdgcn_raw_buffer_load_b128(crs, (int)vo_, 0, 0)); } } } while (0)
#define MLA_WRITE() do { _Pragma("unroll") for (int kk = 0; kk < 2; ++kk) _Pragma("unroll") for (int i = 0; i < 8; ++i) *(LAS u32x4*)(stage + wbase[i >> 2] + 8192 * kk + 64 * i) = G[8 * kk + i]; } while (0)
            const unsigned qd = (unsigned)(n16 >> 2), pp = (unsigned)(lane & 3), ph = pp >> 1;
            unsigned rbase[2], tbase[2][2], wbase[2];
#pragma unroll
            for (int t = 0; t < 2; ++t) { rbase[t] = 2048u * qd + 64u * (4u * t + (n16 & 3)) + 16u * ((unsigned)g ^ ((2u * qd + t) & 3u));
                wbase[t] = 2048u * g + 512u * qd + 16u * ((unsigned)(n16 & 3) ^ (2u * (g & 1) + t));
#pragma unroll
                for (int mp = 0; mp < 2; ++mp) tbase[mp][t] = 2048u * g + 64u * (4u * t + qd) + 16u * ((2u * mp + ph) ^ (2u * (g & 1) + t)) + 8u * (pp & 1); }
            h16x8 qan[4]; float rsqn;
#define MLA_QLOAD(qr_) do { _Pragma("unroll") for (int ks = 0; ks < 4; ++ks) { const u32x4 z = {0u, 0u, 0u, 0u}; \
                qan[ks] = (n16 < 8) ? *(const GAS h16x8*)((const GAS h16*)F.QABS() + (qr_) * 1024 + n16 * 128 + ks * 32 + 8 * g) : __builtin_bit_cast(h16x8, z); } rsqn = F.RSQ()[(qr_)]; } while (0)
            MLA_QLOAD(qrow0 + w);
            MLA_GATHER(SEL + w * 256, 0);
#pragma unroll 1
        for (int qq = w; qq < 32; qq += 8) {
            const size_t qrow = qrow0 + qq; const int qp = BLK + t0 + qq;
            const int nsel = (qp - NPAD + 1) < TOPK ? (qp - NPAD + 1) : TOPK, nch = (nsel + 63) >> 6;
            h16x8 qa[4];
#pragma unroll
            for (int ks = 0; ks < 4; ++ks) qa[ks] = qan[ks];
            const float rsq = __builtin_bit_cast(float, __builtin_amdgcn_readfirstlane(__builtin_bit_cast(int, rsqn)));
            const LAS float* tb = TB + (n16 & 7) * TBLW + 1;
            const LAS unsigned short* selq = SEL + qq * 256;
            float m_run = -1e30f, l_run = 0.f;
            f32x4 o[8];
#pragma unroll
            for (int mt = 0; mt < 8; ++mt) o[mt] = (f32x4){0.f, 0.f, 0.f, 0.f};
            MLA_WRITE();
            if (nch > 1) MLA_GATHER(selq, 1); else if (qq + 8 < 32) { MLA_GATHER(selq + 8 * 256, 0); MLA_QLOAD(qrow + 8); }
            for (int c = 0; c < nch; ++c) {
                h16x8 af[16];
#pragma unroll
                for (int q8 = 0; q8 < 8; ++q8) af[q8] = *(const LAS h16x8*)(stage + rbase[(q8 >> 2) & 1] + 8192 * (q8 >> 3) + 512 * (q8 & 3));
                __builtin_amdgcn_sched_barrier(0);
#pragma unroll
                for (int q8 = 8; q8 < 16; ++q8) af[q8] = *(const LAS h16x8*)(stage + rbase[(q8 >> 2) & 1] + 8192 * (q8 >> 3) + 512 * (q8 & 3));
                f32x4 st[4];
#pragma unroll
                for (int tt = 0; tt < 2; ++tt) { st[tt] = (f32x4){0.f, 0.f, 0.f, 0.f};
#pragma unroll
                    for (int ks = 0; ks < 4; ++ks) st[tt] = __builtin_amdgcn_mfma_f32_16x16x32_f16(af[4 * tt + ks], qa[ks], st[tt], 0, 0, 0); }
                __builtin_amdgcn_sched_barrier(0);
                float bia[2][8];
#pragma unroll
                for (int kk = 0; kk < 2; ++kk) {
                    const u32x4 sv = *(const LAS u32x4*)(selq + 64 * c + 32 * kk + 8 * g);
#pragma unroll
                    for (int e = 0; e < 8; ++e) { const int kp = (int)((sv[e >> 1] >> (16 * (e & 1))) & 0xffffu); int dist = qp - kp; dist = dist < -1 ? -1 : dist; dist = dist < 128 ? dist : 128; bia[kk][e] = tb[dist]; }
                }
                h16x4 vlo[2][8], vhi[2][8];
#pragma unroll
                for (int mt = 0; mt < 8; ++mt) { vlo[0][mt] = ds_tr16(stage + tbase[mt & 1][0] + 512 * (mt >> 1)); vhi[0][mt] = ds_tr16(stage + tbase[mt & 1][1] + 512 * (mt >> 1)); }
#pragma unroll
                for (int tt = 2; tt < 4; ++tt) { st[tt] = (f32x4){0.f, 0.f, 0.f, 0.f};
#pragma unroll
                    for (int ks = 0; ks < 4; ++ks) st[tt] = __builtin_amdgcn_mfma_f32_16x16x32_f16(af[4 * tt + ks], qa[ks], st[tt], 0, 0, 0); }
                __builtin_amdgcn_sched_barrier(0);
                float mx = NINF;
#pragma unroll
                for (int kk = 0; kk < 2; ++kk) {
#pragma unroll
                    for (int t = 0; t < 2; ++t)
#pragma unroll
                        for (int r = 0; r < 4; ++r) { const float v = st[2 * kk + t][r] * rsq + bia[kk][4 * t + r]; st[2 * kk + t][r] = v; mx = fmaxf(mx, v); }
                }
                mx = fmaxf(mx, __shfl_xor(mx, 16)); mx = fmaxf(mx, __shfl_xor(mx, 32));
                if (__any(mx > m_run + 8.0f)) {
                    const float m_new = fmaxf(m_run, mx), alpha = __builtin_amdgcn_exp2f(m_run - m_new);
                    l_run *= alpha; m_run = m_new;
#pragma unroll
                    for (int mt = 0; mt < 8; ++mt) o[mt] = o[mt] * alpha;
                }
                float ps = 0.f;
#pragma unroll
                for (int tt = 0; tt < 4; ++tt)
#pragma unroll
                    for (int r = 0; r < 4; ++r) { const float p = __builtin_amdgcn_exp2f(st[tt][r] - m_run); st[tt][r] = p; ps += p; }
                ps += __shfl_xor(ps, 16); ps += __shfl_xor(ps, 32);
                l_run += ps;
                __builtin_amdgcn_sched_barrier(0);
#pragma unroll
                for (int mt = 0; mt < 8; ++mt) { vlo[1][mt] = ds_tr16(stage + tbase[mt & 1][0] + 8192 + 512 * (mt >> 1)); vhi[1][mt] = ds_tr16(stage + tbase[mt & 1][1] + 8192 + 512 * (mt >> 1)); }
#pragma unroll
                for (int kk = 0; kk < 2; ++kk) {
                    const u32x4 pw = {pk_h2(st[2 * kk][0], st[2 * kk][1]), pk_h2(st[2 * kk][2], st[2 * kk][3]), pk_h2(st[2 * kk + 1][0], st[2 * kk + 1][1]), pk_h2(st[2 * kk + 1][2], st[2 * kk + 1][3])};
                    const h16x8 pb = __builtin_bit_cast(h16x8, pw);
#pragma unroll
                    for (int mt = 0; mt < 8; ++mt) {
                        const h16x4 lo4 = vlo[kk][mt], hi4 = vhi[kk][mt];
                        const h16x8 a = {lo4[0], lo4[1], lo4[2], lo4[3], hi4[0], hi4[1], hi4[2], hi4[3]};
                        o[mt] = __builtin_amdgcn_mfma_f32_16x16x32_f16(a, pb, o[mt], 0, 0, 0); }
                    if (kk == 0) __builtin_amdgcn_sched_barrier(0);
                }
                if (c + 1 < nch) { MLA_WRITE(); if (c + 2 < nch) MLA_GATHER(selq, c + 2); else if (qq + 8 < 32) { MLA_GATHER(selq + 8 * 256, 0); MLA_QLOAD(qrow + 8); } }
            }
#undef MLA_GATHER
#undef MLA_WRITE
            const float inv = 1.0f / l_run;
            if (n16 < 8) { h16* op = F.LAT() + qrow * 1024 + n16 * 128 + 4 * g;
#pragma unroll
                for (int mt = 0; mt < 8; ++mt) { u32x2 ww; ww.x = pk_h2(o[mt][0] * inv, o[mt][1] * inv); ww.y = pk_h2(o[mt][2] * inv, o[mt][3] * inv); *(u32x2*)(op + 16 * mt) = ww; } }
        }
        PSEC_END(3);
        __syncthreads();
    }
    PSEC_END(4); PSEC_BURN(0, 4);
}

__device__ __forceinline__ void final_norm_phase(Frame& F) {
    const int gw = F.vcu * NWAVES + F.wave, NGW = F.G * NWAVES, lane = F.lane;
    const f32x4 g4[4] = {((const f32x4*)F.gf())[2 * lane], ((const f32x4*)F.gf())[2 * lane + 1], ((const f32x4*)F.gf())[128 + 2 * lane], ((const f32x4*)F.gf())[128 + 2 * lane + 1]};
    u32x4 hn[2][2]; f32x4 sn[2][4];
#define P9_LOAD(r0_) do { _Pragma("unroll") for (int q = 0; q < 2; ++q) { const int r_ = (r0_) + q * NGW; if (r_ < M) { \
        const u32x4* hr_ = (const u32x4*)(F.H2() + (size_t)r_ * D) + lane; hn[q][0] = hr_[0]; hn[q][1] = hr_[64];       \
        const f32x4* sp_ = (const f32x4*)(F.SSQ2() + (size_t)r_ * 16); sn[q][0] = sp_[0]; sn[q][1] = sp_[1]; sn[q][2] = sp_[2]; sn[q][3] = sp_[3]; } } } while (0)
    P9_LOAD(gw);
    for (int row = gw; row < M; row += 2 * NGW) {
        u32x4 hc[2][2]; f32x4 sc[2][4];
#pragma unroll
        for (int q = 0; q < 2; ++q) { hc[q][0] = hn[q][0]; hc[q][1] = hn[q][1]; sc[q][0] = sn[q][0]; sc[q][1] = sn[q][1]; sc[q][2] = sn[q][2]; sc[q][3] = sn[q][3]; }
        if (row + 2 * NGW < M) P9_LOAD(row + 2 * NGW);
#pragma unroll
        for (int q = 0; q < 2; ++q) { const int r = row + q * NGW; if (r < M) {
            const f32x4 t = (sc[q][0] + sc[q][1]) + (sc[q][2] + sc[q][3]);
            const float rs = __builtin_amdgcn_rsqf(((t[0] + t[1]) + (t[2] + t[3])) * (1.0f / 1024.0f) + EPS);
            f32x4* orow = (f32x4*)(F.out() + (size_t)r * D);
#pragma unroll
            for (int j = 0; j < 2; ++j) { const h16x8 h = __builtin_bit_cast(h16x8, hc[q][j]);
                orow[128 * j + 2 * lane] = (f32x4){(float)h[0], (float)h[1], (float)h[2], (float)h[3]} * rs * g4[2 * j];
                orow[128 * j + 2 * lane + 1] = (f32x4){(float)h[4], (float)h[5], (float)h[6], (float)h[7]} * rs * g4[2 * j + 1]; } } }
    }
#undef P9_LOAD
}

#ifndef MK_N_LAUNCHES
#define MK_N_LAUNCHES 1
#endif
constexpr int N_PHASES = 10;
__global__ void __launch_bounds__(NWAVES * 64, 2) fwd_kernel(Args args) {
    extern __shared__ __attribute__((aligned(16))) unsigned char lds_raw[];
    Frame F(args);
    F.lds = (LAS unsigned char*)lds_raw;
    F.tid = threadIdx.x; F.lane = F.tid & 63; F.wave = __builtin_amdgcn_readfirstlane(F.tid >> 6);
    F.G = gridDim.x; { const int bx = blockIdx.x; F.vcu = (F.G % 8 == 0) ? (bx % 8) * (F.G / 8) + bx / 8 : bx; }
    unsigned char* ws = args.ws;
    F.ws = ws;
    for (int u = F.tid; u < (LDS_BYTES - LDSCTL_OFF) / 4; u += NWAVES * 64) ((LAS unsigned*)(F.lds + LDSCTL_OFF))[u] = 0u;
    __syncthreads();
    XcdBarrier bar; bar.bar = (unsigned*)(ws + WS_CTL) + CW_BAR; bar.x = 0; bar.st = nullptr;
    if (MK_N_LAUNCHES == 1) bar = xcd_barrier_post((unsigned*)(ws + WS_CTL) + CW_BAR, (volatile LAS unsigned*)(F.lds + MISC_OFF) + 8);
    const int lo = args.ph_lo, hi = args.ph_hi;
#ifndef PHMASK
#define PHMASK 0x3ff
#endif
#define IN(k) ((((PHMASK) >> (k)) & 1) && lo <= (k) && (k) < hi)
#ifdef PROBE_PH
    unsigned long long ppt0_ = 0ull, ppacc_ = 0ull;
#define SEAM(k) do { if ((k) + 1 == PROBE_PH) { if (IN(k) && IN((k) + 1)) xcd_barrier(bar); ppt0_ = __builtin_amdgcn_s_memtime(); } \
        else if ((k) == PROBE_PH) { if (IN(k) && IN((k) + 1)) xcd_barrier(bar); ppacc_ = __builtin_amdgcn_s_memtime() - ppt0_; } \
        else { if (IN(k) && IN((k) + 1)) xcd_barrier(bar); } } while (0)
    if (PROBE_PH == 0) ppt0_ = __builtin_amdgcn_s_memtime();
#else
#define SEAM(k) do { if (MK_N_LAUNCHES == 1) { if (IN(k) && IN((k) + 1)) xcd_barrier(bar); } } while (0)
#endif

    if (IN(0)) { p0_prologue(F); } SEAM(0);
    if (IN(1)) {
        pg8::Gemm g{F.XH(), F.Win_t(), M, DINP, D}; pg8::StaticOrder S; S.init(M, DINP, F.G, (int)blockIdx.x);
        EpiInProj E{F.RS1(), F.AQ(), F.AK(), F.AV(), F.BQ(), F.RAW4(), F.IQ(), F.GATES(), F.bg()};
        pg8::gemm_phase<EpiInProj, pg8::StaticOrder>(F.lds + RING_OFF, g, S, E, F.wave);
    } SEAM(1);
    if (IN(2)) {
#ifndef NO_NORMS
        p2_norms(F);
#endif
        { pg8::Gemm g{F.BQ(), F.Wqabs_t(), M, 1024, 256}; pg8::StaticOrder S; S.init(M, 1024, F.G, (int)blockIdx.x);
          EpiH16 E{F.QABS(), 1024};
          pg8::gemm_phase<EpiH16, pg8::StaticOrder>(F.lds + RING_OFF, g, S, E, F.wave); }
    } SEAM(2);
    if (IN(3)) {
#ifndef NO_ATTN_A
        attn_a_phase(F);
#endif
#ifndef NO_MIXER_B
        mixer_b_phase(F);
#endif
    } SEAM(3);
    if (IN(4)) {
        { pg8::Gemm g{F.OA(), F.Wa_t(), M, D, 512}; pg8::StaticOrder S; S.init(M, D, F.G, (int)blockIdx.x);
          EpiGate<false> E{F.GATES(), F.MIXED()};
          pg8::gemm_phase<EpiGate<false>, pg8::StaticOrder>(F.lds + RING_OFF, g, S, E, F.wave); }
        { pg8::Gemm g{F.LAT(), F.Wuvb_t(), M, D, 1024}; pg8::StaticOrder S; S.init(M, D, F.G, (int)blockIdx.x);
          EpiGate<true> E{F.GATES() + 1024, F.MIXED()};
          pg8::gemm_phase<EpiGate<true>, pg8::StaticOrder>(F.lds + RING_OFF, g, S, E, F.wave); }
    } SEAM(4);
    if (IN(6)) {
        pg8::Gemm g{F.MIXED(), F.Wo_t(), M, D, D}; pg8::StaticOrder S; S.init(M, D, F.G, (int)blockIdx.x);
        EpiWo E{F.x(), F.H1(), F.SSQ1()};
        pg8::gemm_phase<EpiWo, pg8::StaticOrder>(F.lds + RING_OFF, g, S, E, F.wave);
    } SEAM(6);
    if (IN(7)) {
        pg8::Gemm g{F.H1(), F.Wgu_t(), M, NGU, D}; pg8::StaticOrder S; S.init(M, NGU, F.G, (int)blockIdx.x);
        {
            int last_pm = -1;
            for (int i = 0; ; ++i) { pg8::Unit u; if (!S.next(i, u)) break; if (u.pm == last_pm) continue; last_pm = u.pm;
                if (F.tid < 256) { const int row = u.pm * 256 + F.tid; F.RS2()[row] = row_rs16(F.SSQ1() + (size_t)row * 16); } }
            asm volatile("s_waitcnt vmcnt(0)" ::: "memory"); __syncthreads();
            __builtin_amdgcn_fence(__ATOMIC_ACQUIRE, "agent"); asm volatile("s_waitcnt vmcnt(0)" ::: "memory"); __syncthreads();
        }
        EpiSwiGLU E{F.RS2(), F.ACT()};
        pg8::gemm_phase<EpiSwiGLU, pg8::StaticOrder>(F.lds + RING_OFF, g, S, E, F.wave);
    } SEAM(7);
    if (IN(8)) {
        pg8::Gemm g{F.ACT(), F.Wd_t(), M, D, DFF}; pg8::StaticOrder S; S.init(M, D, F.G, (int)blockIdx.x);
        EpiDown E{F.H1(), F.H2(), F.SSQ2()};
        pg8::gemm_phase<EpiDown, pg8::StaticOrder>(F.lds + RING_OFF, g, S, E, F.wave);
    } SEAM(8);
    if (IN(9)) { final_norm_phase(F); }
#ifdef PROBE_PH
    if (PROBE_PH == 9) { asm volatile("s_waitcnt vmcnt(0)" ::: "memory"); ppacc_ = __builtin_amdgcn_s_memtime() - ppt0_; }
    if (blockIdx.x == 0) { const unsigned long long te = __builtin_amdgcn_s_memtime() + ppacc_; while (__builtin_amdgcn_s_memtime() < te) __builtin_amdgcn_s_sleep(8); }
#endif
#undef IN
#undef SEAM
}

extern "C" void kernel_launch(void* const* d_in, const int* in_sizes, int n_in, void* d_out, int out_size, void* d_ws, size_t ws_size, hipStream_t stream) {
    static int grid = 0;
    if (grid == 0) {
        if (n_in != 22 || in_sizes[0] != M * D || out_size != M * D || ws_size < WS_END) {
            fprintf(stderr, "kernel_launch: built for 22 inputs, x/out of %d floats, >= %zu bytes of workspace; got n_in %d, in0 %d, out %d, ws %zu; nothing launched\n", M * D, (size_t)WS_END, n_in, n_in > 0 ? in_sizes[0] : -1, out_size, ws_size);
            grid = -1; return; }
        int dev = 0, cus = 0, per_cu = 0;
        if (hipGetDevice(&dev) != hipSuccess || hipDeviceGetAttribute(&cus, hipDeviceAttributeMultiprocessorCount, dev) != hipSuccess) { fprintf(stderr, "kernel_launch: device query failed\n"); grid = -1; return; }
        if (hipFuncSetAttribute((const void*)fwd_kernel, hipFuncAttributeMaxDynamicSharedMemorySize, LDS_BYTES) != hipSuccess) { fprintf(stderr, "kernel_launch: hipFuncSetAttribute failed\n"); grid = -1; return; }
        if (hipOccupancyMaxActiveBlocksPerMultiprocessor(&per_cu, (const void*)fwd_kernel, NWAVES * 64, LDS_BYTES) != hipSuccess || per_cu < 1)
            fprintf(stderr, "kernel_launch: note: occupancy query reports %d workgroups per CU\n", per_cu);
        (void)hipGetLastError();
        grid = cus;
    }
    if (grid < 0) return;
    if (hipMemsetAsync((char*)d_ws + WS_CTL, 0, CTL_ZERO_BYTES, stream) != hipSuccess) { fprintf(stderr, "kernel_launch: hipMemsetAsync failed\n"); return; }
    Args a{};
    for (int i = 0; i < 22; ++i) a.in[i] = (const float*)d_in[i];
    a.out = (float*)d_out; a.ws = (unsigned char*)d_ws;
    for (int li = 0; li < MK_N_LAUNCHES; ++li) {
        a.ph_lo = (MK_N_LAUNCHES == 1) ? 0 : li; a.ph_hi = (MK_N_LAUNCHES == 1) ? N_PHASES : li + 1;
        hipLaunchKernelGGL(fwd_kernel, dim3(grid), dim3(NWAVES * 64), LDS_BYTES, stream, a);
        const hipError_t le = hipPeekAtLastError();
        if (le != hipSuccess) { fprintf(stderr, "kernel_launch: launch %d failed: %s\n", li, hipGetErrorName(le)); break; }
    }
}
```

```cpp
#include <hip/hip_runtime.h>
#include <cstdio>
#include <cstdint>

#define LAS __attribute__((address_space(3)))
#define GAS __attribute__((address_space(1)))
typedef unsigned short h16;
typedef _Float16 h16x8 __attribute__((ext_vector_type(8)));
typedef _Float16 h16x4 __attribute__((ext_vector_type(4)));
typedef _Float16 h16x2 __attribute__((ext_vector_type(2)));
typedef float f32x4 __attribute__((ext_vector_type(4)));
typedef float f32x16 __attribute__((ext_vector_type(16)));
typedef unsigned u32x4 __attribute__((ext_vector_type(4)));
typedef unsigned u32x2 __attribute__((ext_vector_type(2)));
typedef short s16x4 __attribute__((ext_vector_type(4)));

constexpr int BATCH = 32, SEQ = 2048, D = 1024, NPAD = 112, NMETA = 16, BLK = 128, P = BLK + SEQ  , NBLK = P / BLK  ;
constexpr int M = BATCH * SEQ;
constexpr int DIN = 3524, DINP = 3584, DFF = 2816, NGU = 2 * DFF  ;
constexpr int TOPK = 256;
constexpr float EPS = 1e-6f, LOG2E = 1.4426950408889634f;
constexpr float QSCALE = 0.125f * LOG2E;

__device__ __forceinline__ unsigned pk_h2(float lo, float hi) { h16x2 v = {(_Float16)lo, (_Float16)hi}; return __builtin_bit_cast(unsigned, v); }
__device__ __forceinline__ u32x4 pk_h8(f32x4 a, f32x4 b) { u32x4 w; w.x = pk_h2(a[0], a[1]); w.y = pk_h2(a[2], a[3]); w.z = pk_h2(b[0], b[1]); w.w = pk_h2(b[2], b[3]); return w; }
__device__ __forceinline__ float h2f(h16 v) { return (float)__builtin_bit_cast(_Float16, v); }
__device__ __forceinline__ h16x4 ds_tr16a(const LAS unsigned char* p) { return __builtin_bit_cast(h16x4, __builtin_amdgcn_ds_read_tr16_b64_v4i16((LAS s16x4*)p)); }
__device__ __forceinline__ float sigmoidf_fast(float x) { return __builtin_amdgcn_rcpf(1.0f + __builtin_amdgcn_exp2f(-LOG2E * x)); }

#ifndef PROBE_WG
#define PROBE_WG 0
#endif
#ifdef PROBE_SEC
#define PSEC_DECL unsigned long long pt0_ = 0ull, pacc_ = 0ull; (void)pt0_; (void)pacc_
#define PSEC_BEGIN(id) do { if ((id) == PROBE_SEC) { asm volatile("s_waitcnt vmcnt(0) lgkmcnt(0)" ::: "memory"); pt0_ = __builtin_amdgcn_s_memtime(); } } while (0)
#define PSEC_END(id) do { if ((id) == PROBE_SEC) { asm volatile("s_waitcnt vmcnt(0) lgkmcnt(0)" ::: "memory"); pacc_ += __builtin_amdgcn_s_memtime() - pt0_; } } while (0)
#define PSEC_BURN(lo, hi) do { if (PROBE_SEC >= (lo) && PROBE_SEC <= (hi) && (PROBE_WG < 0 || blockIdx.x == PROBE_WG)) { const unsigned long long te_ = __builtin_amdgcn_s_memtime() + pacc_; \
        while (__builtin_amdgcn_s_memtime() < te_) __builtin_amdgcn_s_sleep(8); } } while (0)
#else
#define PSEC_DECL do {} while (0)
#define PSEC_BEGIN(id) do {} while (0)
#define PSEC_END(id) do {} while (0)
#define PSEC_BURN(lo, hi) do {} while (0)
#endif
__device__ __forceinline__ int lane_id_v() { int l; asm volatile("v_mbcnt_lo_u32_b32 %0, -1, 0\n\tv_mbcnt_hi_u32_b32 %0, -1, %0" : "=v"(l)); return l; }
namespace pg8 {
constexpr int BM = 256, BK = 64, HALF = 128, HTB = HALF * BK * 2  , STAGE_BYTES = 8 * HTB, NXCD = 8, WGM = 8;
__host__ __device__ __forceinline__ int lds_byte(int r, int c) { const int st = (r >> 4) * 2 + (c >> 5), rr = r & 15, cc = c & 31, ob = rr * 64 + cc * 2; return st * 1024 + (ob ^ (((ob >> 9) & 1) << 5)); }
__host__ __device__ __forceinline__ void stage_rc(int b, int& R, int& C) { const int st = b / 1024, sb = b % 1024, swz = sb ^ (((sb >> 9) & 1) << 5); R = (st >> 1) * 16 + swz / 64; C = (st & 1) * 32 + (swz % 64) / 2; }
__host__ __device__ __forceinline__ int perm32(int rho) { const int n = rho >> 4, i = rho & 15; return 8 * (i >> 2) + 4 * n + (i & 3); }

struct Unit { int pm, pn; };
struct Gemm { const h16* A; const h16* Bt; int M, N, K; };

struct StaticOrder {
    int nM, nN, nwg, G, c;
    __host__ __device__ __forceinline__ void init(int M_, int N_, int G_, int c_) { nM = M_ / BM; nN = N_ / BM; nwg = nM * nN; G = G_; c = c_; }
    __host__ __device__ __forceinline__ bool next(int i, Unit& u) const {
        const long L = (long)i * G + c; if (L >= nwg) return false;
        int wgid = (int)L; { const int q = nwg / NXCD, r = nwg % NXCD, xcd = wgid % NXCD, off = wgid / NXCD; wgid = (xcd < r ? xcd * (q + 1) : r * (q + 1) + (xcd - r) * q) + off; }
        const int nig = WGM * nN, gid = wgid / nig, fm = gid * WGM, gsz = (nM - fm) < WGM ? (nM - fm) : WGM;
        u.pm = fm + ((wgid % nig) % gsz); u.pn = (wgid % nig) / gsz; return true;
    }
    __device__ __forceinline__ void a_ready(const Unit&) const {}
    __device__ __forceinline__ void done(const Unit&) const {}
};

template <class Epi, class Sched, bool ALIGN_EPI = true, bool SP2 = true>
__device__ __forceinline__ void gemm_phase(LAS unsigned char* lds, const Gemm g, const Sched& S, const Epi& E, const int wid) {
    const int lane = lane_id_v(), tid = wid * 64 + lane, wr = wid >> 2, wc = wid & 3, fr = lane & 15, fq = lane >> 4;
    int K = g.K; asm volatile("" : "+s"(K));
    const int nt = K / BK;
    unsigned voffA[2], voffB[2];
#pragma unroll
    for (int i = 0; i < 2; ++i) { int R, C; stage_rc(tid * 16 + i * 8192, R, C); const int Rb = (R & ~31) + perm32(R & 31);
        voffA[i] = (unsigned)(R * K + C) * 2u; voffB[i] = (unsigned)(Rb * K + C) * 2u; }
    const size_t kstep = (size_t)(BK * 2);
    const size_t hstep = (size_t)HALF * K * 2;
    const size_t tstep = 2 * hstep;
    const unsigned ldsw = (unsigned)wid * 1024u;
    const int aoff = lds_byte(wr * 64 + fr, fq * 8), boff = lds_byte(wc * 32 + fr, fq * 8);
#define PG8_SA(b, h) (((b) * 2 + (h)) * HTB)
#define PG8_SB(b, h) ((4 + (b) * 2 + (h)) * HTB)
#define PG8_STAGE(bufoff, gbase, voff) do { _Pragma("unroll") for (int _i = 0; _i < 2; ++_i) \
        __builtin_amdgcn_global_load_lds((const unsigned*)((const char*)(gbase) + (voff)[_i]), (LAS unsigned*)(lds + (bufoff) + ldsw + _i * 8192), 16, 0, 0); } while (0)
#define PG8_LDA(dst, b, h) do { _Pragma("unroll") for (int m = 0; m < 4; ++m) _Pragma("unroll") for (int k = 0; k < 2; ++k) dst[m][k] = *(const LAS h16x8*)(lds + PG8_SA(b, h) + aoff + m * 2048 + k * 1024); } while (0)
#define PG8_LDB(dst, b, h) do { _Pragma("unroll") for (int n = 0; n < 2; ++n) _Pragma("unroll") for (int k = 0; k < 2; ++k) dst[n][k] = *(const LAS h16x8*)(lds + PG8_SB(b, h) + boff + n * 2048 + k * 1024); } while (0)
#define PG8_MMA(ai, bj, At, Bt) do { __builtin_amdgcn_s_setprio(1); _Pragma("unroll") for (int m = 0; m < 4; ++m) _Pragma("unroll") for (int n = 0; n < 2; ++n) _Pragma("unroll") for (int k = 0; k < 2; ++k) \
        acc[ai][bj][m][n] = __builtin_amdgcn_mfma_f32_16x16x32_f16(Bt[n][k], At[m][k], acc[ai][bj][m][n], 0, 0, 0); __builtin_amdgcn_s_setprio(0); } while (0)
#define PG8_WAIT_V(n) asm volatile("s_waitcnt vmcnt(" #n ")" ::: "memory")
#define PG8_WAIT_L(n) asm volatile("s_waitcnt lgkmcnt(" #n ")" ::: "memory")
#define PG8_BAR __builtin_amdgcn_s_barrier()
#define PG8_SCHED __builtin_amdgcn_sched_barrier(0)
    PSEC_DECL;
    Unit cur, nxt; int ui = 0;
    if (!S.next(0, cur)) return;
    f32x4 acc[2][2][4][2];
#pragma unroll
    for (int a = 0; a < 2; ++a)
#pragma unroll
        for (int b = 0; b < 2; ++b)
#pragma unroll
            for (int m = 0; m < 4; ++m)
#pragma unroll
                for (int n = 0; n < 2; ++n) acc[a][b][m][n] = (f32x4){0.f, 0.f, 0.f, 0.f};
    h16x8 At[4][2], B0[2][2], B1[2][2];
    const char* cA = (const char*)g.A + (size_t)cur.pm * tstep; const char* cB = (const char*)g.Bt + (size_t)cur.pn * tstep;
    S.a_ready(cur);
    typename Epi::Pre pre_cur = E.pre(cur, wr, wc, fr, fq), pre_nxt = pre_cur;
    if constexpr (SP2) {
        PG8_STAGE(PG8_SB(0, 0), cB, voffB); PG8_STAGE(PG8_SB(0, 1), cB + hstep, voffB); PG8_STAGE(PG8_SA(0, 0), cA, voffA); PG8_STAGE(PG8_SA(0, 1), cA + hstep, voffA);
        if (wr == 1) PG8_BAR;
        PG8_WAIT_V(2); PG8_BAR;
        PG8_STAGE(PG8_SB(1, 0), cB + kstep, voffB); PG8_STAGE(PG8_SA(1, 0), cA + kstep, voffA); PG8_STAGE(PG8_SB(1, 1), cB + hstep + kstep, voffB);
        PG8_WAIT_V(6); PG8_BAR;
    } else {
        PG8_STAGE(PG8_SB(0, 0), cB, voffB); PG8_STAGE(PG8_SA(0, 0), cA, voffA); PG8_STAGE(PG8_SB(0, 1), cB + hstep, voffB); PG8_STAGE(PG8_SA(0, 1), cA + hstep, voffA);
        if (wr == 1) PG8_BAR;
        PG8_WAIT_V(4); PG8_BAR;
        PG8_STAGE(PG8_SB(1, 0), cB + kstep, voffB); PG8_STAGE(PG8_SA(1, 0), cA + kstep, voffA); PG8_STAGE(PG8_SB(1, 1), cB + hstep + kstep, voffB);
        PG8_WAIT_V(6); PG8_BAR;
    }
    for (;;) {
        const bool has_next = S.next(ui + 1, nxt);
        const char* nA = has_next ? (const char*)g.A + (size_t)nxt.pm * tstep : cA; const char* nB = has_next ? (const char*)g.Bt + (size_t)nxt.pn * tstep : cB;
        for (int t = 0; t < nt; t += 2) {
            const bool last = (t == nt - 2);
            const char* a1 = cA + (size_t)(t + 1) * kstep;
            const char* a2 = last ? nA : cA + (size_t)(t + 2) * kstep; const char* b2 = last ? nB : cB + (size_t)(t + 2) * kstep;
            const char* a3 = a2 + kstep; const char* b3 = b2 + kstep;
            if (last && has_next) { S.a_ready(nxt); pre_nxt = E.pre(nxt, wr, wc, fr, fq); }
            if constexpr (SP2) {
            PG8_LDB(B0, 0, 0); PG8_LDB(B1, 0, 1); PG8_SCHED; PG8_LDA(At, 0, 0); PG8_STAGE(PG8_SA(1, 1), a1 + hstep, voffA);
            PG8_WAIT_V(8); PG8_WAIT_L(0); PG8_BAR; PG8_MMA(0, 0, At, B0); PG8_MMA(0, 1, At, B1); PG8_BAR; PG8_SCHED;
            PG8_LDA(At, 0, 1); PG8_STAGE(PG8_SB(0, 0), b2, voffB); PG8_STAGE(PG8_SB(0, 1), b2 + hstep, voffB); PG8_STAGE(PG8_SA(0, 0), a2, voffA);
            PG8_WAIT_V(8); PG8_WAIT_L(0); PG8_BAR; PG8_MMA(1, 0, At, B0); PG8_MMA(1, 1, At, B1); PG8_BAR; PG8_SCHED;
            PG8_LDB(B0, 1, 0); PG8_LDB(B1, 1, 1); PG8_SCHED; PG8_LDA(At, 1, 0); PG8_STAGE(PG8_SA(0, 1), a2 + hstep, voffA);
            PG8_WAIT_V(8); PG8_WAIT_L(0); PG8_BAR; PG8_MMA(0, 0, At, B0); PG8_MMA(0, 1, At, B1); PG8_BAR; PG8_SCHED;
            PG8_LDA(At, 1, 1); PG8_STAGE(PG8_SB(1, 0), b3, voffB); PG8_STAGE(PG8_SB(1, 1), b3 + hstep, voffB); PG8_STAGE(PG8_SA(1, 0), a3, voffA);
            PG8_WAIT_V(8); PG8_WAIT_L(0); PG8_BAR; PG8_MMA(1, 0, At, B0); PG8_MMA(1, 1, At, B1); PG8_BAR; PG8_SCHED;
            } else {
            PG8_LDB(B0, 0, 0); PG8_SCHED; PG8_LDA(At, 0, 0); PG8_STAGE(PG8_SA(1, 1), a1 + hstep, voffA);
            PG8_WAIT_L(8); PG8_BAR; PG8_WAIT_L(0); PG8_MMA(0, 0, At, B0); PG8_BAR; PG8_SCHED;
            PG8_LDB(B1, 0, 1); PG8_STAGE(PG8_SB(0, 0), b2, voffB);
            PG8_BAR; PG8_WAIT_L(0); PG8_MMA(0, 1, At, B1); PG8_BAR;
            PG8_LDA(At, 0, 1); PG8_STAGE(PG8_SA(0, 0), a2, voffA);
            PG8_BAR; PG8_WAIT_L(0); PG8_MMA(1, 0, At, B0); PG8_BAR; PG8_SCHED;
            PG8_STAGE(PG8_SB(0, 1), b2 + hstep, voffB);
            PG8_WAIT_V(6); PG8_BAR; PG8_MMA(1, 1, At, B1); PG8_BAR;
            PG8_LDB(B0, 1, 0); PG8_SCHED; PG8_LDA(At, 1, 0); PG8_STAGE(PG8_SA(0, 1), a2 + hstep, voffA);
            PG8_WAIT_L(8); PG8_BAR; PG8_WAIT_L(0); PG8_MMA(0, 0, At, B0); PG8_BAR; PG8_SCHED;
            PG8_LDB(B1, 1, 1); PG8_STAGE(PG8_SB(1, 0), b3, voffB);
            PG8_BAR; PG8_WAIT_L(0); PG8_MMA(0, 1, At, B1); PG8_BAR;
            PG8_LDA(At, 1, 1); PG8_STAGE(PG8_SA(1, 0), a3, voffA);
            PG8_BAR; PG8_WAIT_L(0); PG8_MMA(1, 0, At, B0); PG8_BAR; PG8_SCHED;
            PG8_STAGE(PG8_SB(1, 1), b3 + hstep, voffB);
            PG8_WAIT_V(6); PG8_BAR; PG8_MMA(1, 1, At, B1); PG8_BAR;
            }
        }
        if constexpr (ALIGN_EPI) { if (wr == 0) PG8_BAR; }
        PSEC_BEGIN(40); E(acc, cur, pre_cur, wr, wc, fr, fq); PSEC_END(40); S.done(cur);
        if (!has_next) break;
#pragma unroll
        for (int a = 0; a < 2; ++a)
#pragma unroll
            for (int b = 0; b < 2; ++b)
#pragma unroll
                for (int m = 0; m < 4; ++m)
#pragma unroll
                    for (int n = 0; n < 2; ++n) acc[a][b][m][n] = (f32x4){0.f, 0.f, 0.f, 0.f};
        cur = nxt; cA = nA; cB = nB; ++ui; pre_cur = pre_nxt;
        if constexpr (ALIGN_EPI) { if (wr == 1) PG8_BAR; }
    }
    PG8_WAIT_V(0);
    if constexpr (!ALIGN_EPI) { if (wr == 0) PG8_BAR; }
    PG8_BAR;
    PSEC_BURN(40, 40);
#undef PG8_SA
#undef PG8_SB
#undef PG8_STAGE
#undef PG8_LDA
#undef PG8_LDB
#undef PG8_MMA
#undef PG8_WAIT_V
#undef PG8_WAIT_L
#undef PG8_BAR
#undef PG8_SCHED
}
}

struct PreNone {};
struct PreRows { float rs[8]; };
#define EPI_NOPRE typedef PreNone Pre; __device__ __forceinline__ Pre pre(const pg8::Unit&, int, int, int, int) const { return Pre{}; }
#define EPI_ROWS _Pragma("unroll") for (int ai = 0; ai < 2; ++ai) _Pragma("unroll") for (int m = 0; m < 4; ++m)
#define EPI_BJ _Pragma("unroll") for (int bj = 0; bj < 2; ++bj)
__device__ __forceinline__ void ld_h8(const h16* p, f32x4& a, f32x4& b) { const u32x4 w = *(const u32x4*)p; const h16x8 h = __builtin_bit_cast(h16x8, w);
    a = (f32x4){(float)h[0], (float)h[1], (float)h[2], (float)h[3]}; b = (f32x4){(float)h[4], (float)h[5], (float)h[6], (float)h[7]}; }
__device__ __forceinline__ float ssq8(const f32x4& v0, const f32x4& v1) { return ((v0[0] * v0[0] + v0[1] * v0[1]) + (v0[2] * v0[2] + v0[3] * v0[3])) + ((v1[0] * v1[0] + v1[1] * v1[1]) + (v1[2] * v1[2] + v1[3] * v1[3])); }

struct EpiInProj {
    const float* rs1; h16* AQ; h16* AK; h16* AV; h16* BQ; float* RAW4; h16* IQ; unsigned char* GATES; const float* bg;
    typedef PreRows Pre;
    __device__ __forceinline__ Pre pre(const pg8::Unit& u, int wr, int wc, int fr, int fq) const { Pre p; const int row0 = u.pm * 256 + wr * 64 + fr;
        _Pragma("unroll") for (int ai = 0; ai < 2; ++ai) _Pragma("unroll") for (int m = 0; m < 4; ++m) p.rs[ai * 4 + m] = rs1[row0 + ai * 128 + m * 16]; return p; }
    __device__ __forceinline__ void operator()(const f32x4 (&acc)[2][2][4][2], const pg8::Unit& u, const Pre& P_, int wr, int wc, int fr, int fq) const {
        int ct = wc * 32 + 8 * fq; asm volatile("" : "+v"(ct));
        const int pn = u.pn, row0 = u.pm * 256 + wr * 64 + fr;
        if (pn >= 6) {
            const int gc0 = (pn - 6) * 256 + ct;
            f32x4 b[2][2];
            EPI_BJ { b[bj][0] = *(const f32x4*)(bg + gc0 + bj * 128); b[bj][1] = *(const f32x4*)(bg + gc0 + bj * 128 + 4); }
            EPI_ROWS { const int row = row0 + ai * 128 + m * 16; const float s = P_.rs[ai * 4 + m]; unsigned char* rp = GATES + (size_t)row * 2048 + gc0;
                EPI_BJ { f32x4 v0 = acc[ai][bj][m][0] * s + b[bj][0], v1 = acc[ai][bj][m][1] * s + b[bj][1];
                    unsigned q0[4], q1[4];
                    _Pragma("unroll") for (int e = 0; e < 4; ++e) { q0[e] = (unsigned)(sigmoidf_fast(v0[e]) * 255.0f + 0.5f); q1[e] = (unsigned)(sigmoidf_fast(v1[e]) * 255.0f + 0.5f); }
                    u32x2 w; w.x = q0[0] | (q0[1] << 8) | (q0[2] << 16) | (q0[3] << 24); w.y = q1[0] | (q1[1] << 8) | (q1[2] << 16) | (q1[3] << 24);
                    *(u32x2*)(rp + bj * 128) = w; } }
        } else if (pn == 4) {
            EPI_ROWS { const int row = row0 + ai * 128 + m * 16; const float s = P_.rs[ai * 4 + m]; float* rp = RAW4 + (size_t)row * 256 + ct;
                EPI_BJ { *(f32x4*)(rp + bj * 128) = acc[ai][bj][m][0] * s; *(f32x4*)(rp + bj * 128 + 4) = acc[ai][bj][m][1] * s; } }
        } else if (pn == 2) {
            EPI_ROWS { const int row = row0 + ai * 128 + m * 16; const float s = P_.rs[ai * 4 + m]; const size_t prow = (size_t)(row >> 11) * P + BLK + (row & 2047);
                *(u32x4*)(AK + prow * 128 + ct) = pk_h8(acc[ai][0][m][0] * s, acc[ai][0][m][1] * s);
                *(u32x4*)(AV + prow * 128 + ct) = pk_h8(acc[ai][1][m][0] * s, acc[ai][1][m][1] * s); }
        } else {
            h16* base = pn < 2 ? AQ + pn * 256 : (pn == 3 ? BQ : IQ); const int ld = pn < 2 ? 512 : 256;
            EPI_ROWS { const int row = row0 + ai * 128 + m * 16; const float s = P_.rs[ai * 4 + m]; h16* rp = base + (size_t)row * ld + ct;
                EPI_BJ *(u32x4*)(rp + bj * 128) = pk_h8(acc[ai][bj][m][0] * s, acc[ai][bj][m][1] * s); }
        }
    }
};
struct EpiH16 {
    h16* O; int ldc;
    EPI_NOPRE
    __device__ __forceinline__ void operator()(const f32x4 (&acc)[2][2][4][2], const pg8::Unit& u, const Pre&, int wr, int wc, int fr, int fq) const {
        const int row0 = u.pm * 256 + wr * 64 + fr, col0 = u.pn * 256 + wc * 32 + 8 * fq;
        EPI_ROWS { const int row = row0 + ai * 128 + m * 16; h16* rp = O + (size_t)row * ldc + col0;
            EPI_BJ *(u32x4*)(rp + bj * 128) = pk_h8(acc[ai][bj][m][0], acc[ai][bj][m][1]); }
    }
};
template <bool ACCUM> struct EpiGate {
    const unsigned char* G; h16* O;
    EPI_NOPRE
    __device__ __forceinline__ void operator()(const f32x4 (&acc)[2][2][4][2], const pg8::Unit& u, const Pre&, int wr, int wc, int fr, int fq) const {
        const int row0 = u.pm * 256 + wr * 64 + fr, col0 = u.pn * 256 + wc * 32 + 8 * fq;
        EPI_ROWS { const int row = row0 + ai * 128 + m * 16; const unsigned char* gp = G + (size_t)row * 2048 + col0; h16* rp = O + (size_t)row * 1024 + col0;
            EPI_BJ { const u32x2 gw = *(const u32x2*)(gp + bj * 128);
                const f32x4 g0 = (f32x4){(float)(gw.x & 255u), (float)((gw.x >> 8) & 255u), (float)((gw.x >> 16) & 255u), (float)(gw.x >> 24)} * (1.0f / 255.0f);
                const f32x4 g1 = (f32x4){(float)(gw.y & 255u), (float)((gw.y >> 8) & 255u), (float)((gw.y >> 16) & 255u), (float)(gw.y >> 24)} * (1.0f / 255.0f);
                f32x4 v0 = acc[ai][bj][m][0] * g0, v1 = acc[ai][bj][m][1] * g1;
                if (ACCUM) { f32x4 t0, t1; ld_h8(rp + bj * 128, t0, t1); v0 += t0; v1 += t1; }
                *(u32x4*)(rp + bj * 128) = pk_h8(v0, v1); } }
    }
};
struct EpiWo {
    const float* x; h16* H1; float* SSQ;
    EPI_NOPRE
    __device__ __forceinline__ void operator()(const f32x4 (&acc)[2][2][4][2], const pg8::Unit& u, const Pre&, int wr, int wc, int fr, int fq) const {
        const int row0 = u.pm * 256 + wr * 64 + fr, col0 = u.pn * 256 + wc * 32 + 8 * fq;
        EPI_ROWS { const int row = row0 + ai * 128 + m * 16; const float* xp = x + (size_t)row * 1024 + col0; h16* rp = H1 + (size_t)row * 1024 + col0; float q = 0.f;
            EPI_BJ { const f32x4 v0 = acc[ai][bj][m][0] + *(const f32x4*)(xp + bj * 128), v1 = acc[ai][bj][m][1] + *(const f32x4*)(xp + bj * 128 + 4);
                q += ssq8(v0, v1); *(u32x4*)(rp + bj * 128) = pk_h8(v0, v1); }
            q += __shfl_xor(q, 16); q += __shfl_xor(q, 32);
            if (fq == 0) SSQ[(size_t)row * 16 + u.pn * 4 + wc] = q; }
    }
};
__device__ __forceinline__ float row_rs16(const float* ssq_row) {
    const f32x4* sp = (const f32x4*)ssq_row; const f32x4 s0 = sp[0], s1 = sp[1], s2 = sp[2], s3 = sp[3];
    const float ss = (((s0[0] + s0[1]) + (s0[2] + s0[3])) + ((s1[0] + s1[1]) + (s1[2] + s1[3]))) + (((s2[0] + s2[1]) + (s2[2] + s2[3])) + ((s3[0] + s3[1]) + (s3[2] + s3[3])));
    return __builtin_amdgcn_rsqf(ss * (1.0f / 1024.0f) + EPS);
}
struct EpiSwiGLU {
    const float* RS2; h16* ACT;
    typedef PreRows Pre;
    __device__ __forceinline__ Pre pre(const pg8::Unit& u, int wr, int wc, int fr, int fq) const { Pre p; const int row0 = u.pm * 256 + wr * 64 + fr;
        _Pragma("unroll") for (int ai = 0; ai < 2; ++ai) _Pragma("unroll") for (int m = 0; m < 4; ++m) p.rs[ai * 4 + m] = RS2[row0 + ai * 128 + m * 16]; return p; }
    __device__ __forceinline__ void operator()(const f32x4 (&acc)[2][2][4][2], const pg8::Unit& u, const Pre& P_, int wr, int wc, int fr, int fq) const {
        const int row0 = u.pm * 256 + wr * 64 + fr, col0 = u.pn * 128 + wc * 32 + 8 * fq;
        EPI_ROWS { const int row = row0 + ai * 128 + m * 16; const float rs = P_.rs[ai * 4 + m];
            f32x4 o[2];
            _Pragma("unroll") for (int n = 0; n < 2; ++n)
                _Pragma("unroll") for (int e = 0; e < 4; ++e) { const float g = acc[ai][0][m][n][e] * rs, up = acc[ai][1][m][n][e] * rs; o[n][e] = g * sigmoidf_fast(g) * up; }
            *(u32x4*)(ACT + (size_t)row * DFF + col0) = pk_h8(o[0], o[1]); }
    }
};
struct EpiDown {
    const h16* H1; h16* H2; float* SSQ;
    EPI_NOPRE
    __device__ __forceinline__ void operator()(const f32x4 (&acc)[2][2][4][2], const pg8::Unit& u, const Pre&, int wr, int wc, int fr, int fq) const {
        const int row0 = u.pm * 256 + wr * 64 + fr, col0 = u.pn * 256 + wc * 32 + 8 * fq;
        EPI_ROWS { const int row = row0 + ai * 128 + m * 16; const h16* hp = H1 + (size_t)row * 1024 + col0; h16* rp = H2 + (size_t)row * 1024 + col0; float q = 0.f;
            EPI_BJ { f32x4 h0, h1; ld_h8(hp + bj * 128, h0, h1); const f32x4 v0 = acc[ai][bj][m][0] + h0, v1 = acc[ai][bj][m][1] + h1;
                q += ssq8(v0, v1); *(u32x4*)(rp + bj * 128) = pk_h8(v0, v1); }
            q += __shfl_xor(q, 16); q += __shfl_xor(q, 32);
            if (fq == 0) SSQ[(size_t)row * 16 + u.pn * 4 + wc] = q; }
    }
};

constexpr size_t MiB = 1u << 20;
constexpr size_t WS_CTL = 0, CTL_ZERO_BYTES = 65536;
constexpr size_t WS_WIN = 2 * MiB, WS_WQABS = 9 * MiB, WS_WA = 10 * MiB, WS_WUVB = 11 * MiB, WS_WO = 13 * MiB, WS_WGU = 15 * MiB, WS_WD = 26 * MiB;
constexpr size_t WS_RS1 = 32 * MiB, WS_RSQ = WS_RS1 + 256 * 1024, WS_RS2 = WS_RS1 + 512 * 1024, WS_IWS = 33 * MiB, WS_SSQ1 = 34 * MiB, WS_SSQ2 = 38 * MiB, WS_METAP = 42 * MiB, WS_TBL = WS_METAP + 512 * 1024;
constexpr size_t KVROWS = (size_t)BATCH * P;
constexpr size_t WS_AK = 44 * MiB, WS_AV = 61 * MiB, WS_CKV = 78 * MiB, WS_IKN = 95 * MiB;
constexpr size_t WS_OA = 104 * MiB, WS_GATES = 168 * MiB  , WS_H2 = 296 * MiB  ;
constexpr size_t WS_AQ = 424 * MiB, WS_BQ = 488 * MiB, WS_IQ = 520 * MiB, WS_H1 = 424 * MiB;
constexpr size_t WS_XH = 552 * MiB, WS_MIXED = 552 * MiB, WS_QABS = 680 * MiB, WS_RAW4 = 808 * MiB, WS_LAT = 808 * MiB, WS_ACT = 552 * MiB, WS_END = 936 * MiB;
static_assert(WS_WIN + (size_t)DINP * D * 2 <= WS_WQABS && WS_WGU + (size_t)NGU * D * 2 <= WS_WD && WS_WD + (size_t)D * DFF * 2 <= WS_RS1, "weights map");
static_assert(WS_AK + KVROWS * 256 <= WS_AV && WS_CKV + KVROWS * 256 <= WS_IKN && WS_IKN + KVROWS * 128 <= WS_OA, "kv map");
static_assert(WS_ACT + (size_t)M * DFF * 2 <= WS_END && WS_LAT + (size_t)M * 1024 * 2 <= WS_END && WS_TBL + 16 * 132 * 4 <= WS_AK, "act map");
constexpr int CW_TMO = 0, CW_BAR = 4096;
constexpr int TBLW = 132;

constexpr int RING_OFF = 0, RING_BYTES = 131072;
constexpr int LDSCTL_OFF = RING_BYTES, MISC_OFF = LDSCTL_OFF + 320;
constexpr int LDS_BYTES = 163840;
constexpr int NWAVES = 8;

#define RLX_AGENT __ATOMIC_RELAXED, __HIP_MEMORY_SCOPE_AGENT
#define LDS_WAIT() asm volatile("s_waitcnt lgkmcnt(0)" ::: "memory")
#define VM_WAIT() asm volatile("s_waitcnt vmcnt(0)" ::: "memory")

#define XB_TMO      128
#define XB_XCNT(j)  (256  + 64 * (j))
#define XB_XSUB(j)  (1280 + 64 * (j))
#define XB_XGEN(j)  (2304 + 64 * (j))
#define XB_TOP      3328
#define XB_TOPGEN   3392
#define XCD_BAR_WORDS 3456
#define XB_SPIN_CAP (1u << 18)
__device__ __forceinline__ unsigned xb_ld(unsigned* p)              { return __hip_atomic_load(p, __ATOMIC_RELAXED, __HIP_MEMORY_SCOPE_AGENT); }
__device__ __forceinline__ unsigned xb_add(unsigned* p, unsigned v) { return __hip_atomic_fetch_add(p, v, __ATOMIC_RELAXED, __HIP_MEMORY_SCOPE_AGENT); }
__device__ __forceinline__ unsigned xb_xcc_id() { return (unsigned)__builtin_amdgcn_s_getreg((3 << 11) | 20) & 0xFu; }
#define XB_SPIN(cond, bar) do { unsigned _sp = 0; while (cond) { __builtin_amdgcn_s_sleep(1); \
    if ((++_sp & 255u) == 0u) { if (xb_ld(&(bar)[XB_TMO])) break; if (_sp > XB_SPIN_CAP) { atomicAdd(&(bar)[XB_TMO], 1u); break; } } } } while (0)
struct XcdBarrier { unsigned* bar; unsigned x; volatile LAS unsigned* st; int wave; };
__device__ __forceinline__ XcdBarrier xcd_barrier_post(unsigned* bar, volatile LAS unsigned* st, int wave) {
    XcdBarrier b; b.bar = bar; b.x = xb_xcc_id(); b.st = st; b.wave = wave;
    if (wave == 0 && lane_id_v() == 0) (void)xb_add(&bar[XB_XCNT(b.x)], 1u);
    return b;
}
__device__ __forceinline__ void xcd_barrier_complete(unsigned* bar, unsigned x, unsigned& nloc, unsigned& nx) {
    const unsigned G = gridDim.x * gridDim.y * gridDim.z;
    unsigned sum, cnt, mine, sp = 0u;
    for (;;) {
        sum = 0u; cnt = 0u; mine = 0u;
#pragma unroll
        for (unsigned j = 0; j < 16; ++j) { const unsigned c = xb_ld(&bar[XB_XCNT(j)]); sum += c; cnt += (c > 0u) ? 1u : 0u; mine = (j == x) ? c : mine; }
        if (sum == G) break;
        __builtin_amdgcn_s_sleep(1);
        if ((++sp & 255u) == 0u) { if (xb_ld(&bar[XB_TMO])) break; if (sp > XB_SPIN_CAP) { atomicAdd(&bar[XB_TMO], 1u); break; } }
    }
    nloc = mine > 0u ? mine : 1u; nx = cnt > 0u ? cnt : 1u;
}
__device__ __forceinline__ void xcd_barrier(const XcdBarrier& b) {
    asm volatile("s_waitcnt vmcnt(0)" ::: "memory");
    __syncthreads();
    if (b.wave == 0 && lane_id_v() == 0) {
        unsigned* bar = b.bar;
        __builtin_amdgcn_s_waitcnt(0);
        unsigned nloc = b.st[0], nx = b.st[1];
        if (nloc == 0u) { xcd_barrier_complete(bar, b.x, nloc, nx); b.st[0] = nloc; b.st[1] = nx; }
        const unsigned old = xb_add(&bar[XB_XSUB(b.x)], 1u);
        const unsigned gen = old / nloc;
        if (old + 1u == (gen + 1u) * nloc) {
            __builtin_amdgcn_fence(__ATOMIC_RELEASE, "agent");
            asm volatile("s_waitcnt vmcnt(0)" ::: "memory");
            const unsigned og = xb_add(&bar[XB_TOP], 1u);
            const unsigned tg = og / nx;
            if (og + 1u == (tg + 1u) * nx) xb_add(&bar[XB_TOPGEN], 1u);
            else XB_SPIN(xb_ld(&bar[XB_TOPGEN]) == tg, bar);
            __builtin_amdgcn_fence(__ATOMIC_ACQUIRE, "agent");
            xb_add(&bar[XB_XGEN(b.x)], 1u);
            asm volatile("s_waitcnt vmcnt(0)" ::: "memory");
        } else {
            XB_SPIN(xb_ld(&bar[XB_XGEN(b.x)]) == gen, bar);
            __builtin_amdgcn_fence(__ATOMIC_ACQUIRE, "agent");
            asm volatile("s_waitcnt vmcnt(0)" ::: "memory");
        }
    }
    __syncthreads();
}

struct Args { const float* in[22]; float* out; unsigned char* ws; int ph_lo, ph_hi; };
struct Frame {
    const Args& A;
    __device__ __forceinline__ Frame(const Args& a) : A(a) {}
    LAS unsigned char* lds;
    int wave, vcu, G;
    __device__ __forceinline__ int lane() const { return lane_id_v(); }
    __device__ __forceinline__ int tid() const { return wave * 64 + lane_id_v(); }
    __device__ __forceinline__ const float* x() const { return A.in[0]; }
    __device__ __forceinline__ const float* meta() const { return A.in[1]; }
    __device__ __forceinline__ const float* g1() const { return A.in[2]; }
    __device__ __forceinline__ const float* w_in() const { return A.in[3]; }
    __device__ __forceinline__ const float* bg() const { return A.in[4]; }
    __device__ __forceinline__ const float* qg() const { return A.in[5]; }
    __device__ __forceinline__ const float* kvg() const { return A.in[6]; }
    __device__ __forceinline__ const float* w_uq() const { return A.in[7]; }
    __device__ __forceinline__ const float* w_uk() const { return A.in[8]; }
    __device__ __forceinline__ const float* w_uv() const { return A.in[9]; }
    __device__ __forceinline__ const float* lng() const { return A.in[10]; }
    __device__ __forceinline__ const float* lnb() const { return A.in[11]; }
    __device__ __forceinline__ const float* sinks() const { return A.in[12]; }
    __device__ __forceinline__ const float* relb() const { return A.in[13]; }
    __device__ __forceinline__ const float* w_a() const { return A.in[14]; }
    __device__ __forceinline__ const float* w_b() const { return A.in[15]; }
    __device__ __forceinline__ const float* w_o() const { return A.in[16]; }
    __device__ __forceinline__ const float* g2() const { return A.in[17]; }
    __device__ __forceinline__ const float* w_g() const { return A.in[18]; }
    __device__ __forceinline__ const float* w_u() const { return A.in[19]; }
    __device__ __forceinline__ const float* w_d() const { return A.in[20]; }
    __device__ __forceinline__ const float* gf() const { return A.in[21]; }
    __device__ __forceinline__ float* out() const { return A.out; }
    unsigned char* ws;
    __device__ __forceinline__ h16* Win_t() const { return (h16*)(ws + WS_WIN); }
    __device__ __forceinline__ h16* Wqabs_t() const { return (h16*)(ws + WS_WQABS); }
    __device__ __forceinline__ h16* Wa_t() const { return (h16*)(ws + WS_WA); }
    __device__ __forceinline__ h16* Wuvb_t() const { return (h16*)(ws + WS_WUVB); }
    __device__ __forceinline__ h16* Wo_t() const { return (h16*)(ws + WS_WO); }
    __device__ __forceinline__ h16* Wgu_t() const { return (h16*)(ws + WS_WGU); }
    __device__ __forceinline__ h16* Wd_t() const { return (h16*)(ws + WS_WD); }
    __device__ __forceinline__ h16* H2() const { return (h16*)(ws + WS_H2); }
    __device__ __forceinline__ h16* AK() const { return (h16*)(ws + WS_AK); }
    __device__ __forceinline__ h16* AV() const { return (h16*)(ws + WS_AV); }
    __device__ __forceinline__ h16* CKV() const { return (h16*)(ws + WS_CKV); }
    __device__ __forceinline__ h16* IKN() const { return (h16*)(ws + WS_IKN); }
    __device__ __forceinline__ h16* OA() const { return (h16*)(ws + WS_OA); }
    __device__ __forceinline__ h16* AQ() const { return (h16*)(ws + WS_AQ); }
    __device__ __forceinline__ h16* BQ() const { return (h16*)(ws + WS_BQ); }
    __device__ __forceinline__ h16* IQ() const { return (h16*)(ws + WS_IQ); }
    __device__ __forceinline__ h16* H1() const { return (h16*)(ws + WS_H1); }
    __device__ __forceinline__ h16* XH() const { return (h16*)(ws + WS_XH); }
    __device__ __forceinline__ h16* MIXED() const { return (h16*)(ws + WS_MIXED); }
    __device__ __forceinline__ h16* QABS() const { return (h16*)(ws + WS_QABS); }
    __device__ __forceinline__ h16* LAT() const { return (h16*)(ws + WS_LAT); }
    __device__ __forceinline__ h16* ACT() const { return (h16*)(ws + WS_ACT); }
    __device__ __forceinline__ float* RS2() const { return (float*)(ws + WS_RS2); }
    __device__ __forceinline__ float* RS1() const { return (float*)(ws + WS_RS1); }
    __device__ __forceinline__ float* RSQ() const { return (float*)(ws + WS_RSQ); }
    __device__ __forceinline__ float* IWS() const { return (float*)(ws + WS_IWS); }
    __device__ __forceinline__ float* SSQ1() const { return (float*)(ws + WS_SSQ1); }
    __device__ __forceinline__ float* SSQ2() const { return (float*)(ws + WS_SSQ2); }
    __device__ __forceinline__ float* METAP() const { return (float*)(ws + WS_METAP); }
    __device__ __forceinline__ float* TBL() const { return (float*)(ws + WS_TBL); }
    __device__ __forceinline__ float* RAW4() const { return (float*)(ws + WS_RAW4); }
    __device__ __forceinline__ unsigned char* GATES() const { return ws + WS_GATES; }
};
__device__ __forceinline__ float wave_sum(float v) {
#pragma unroll
    for (int o = 1; o < 64; o <<= 1) v += __shfl_xor(v, o);
    return v;
}

__device__ __forceinline__ int inmap(int n) {
    if (n < 1152) return n;
    if (n < 1216) return 1408 + (n - 1152);
    if (n < 1220) return 1472 + (n - 1216);
    if (n < 1280) return -1;
    if (n < 1536) return 1152 + (n - 1280);
    return 1476 + (n - 1536);
}
template <int MODE> __device__ __forceinline__ void p0_transpose_item(const float* W, const float* W2, int ldw, int K, int N, const float* gain, h16* WT, LAS float* scr, int item, int lane) {
    const int nblk = N / 32, kb = item / nblk, nb = item % nblk, k0 = 64 * kb, n0 = 32 * nb;
    const int n4 = n0 + 4 * (lane & 7), kr = lane >> 3;
    const float* src = W; int oc = n4; float cs = 1.f;
    if (MODE == 0) { oc = inmap(n4); if (n4 < 512) cs = QSCALE; }
    if (MODE == 3) { const int pp = n4 >> 8, j = n4 & 255; oc = 128 * pp + (j & 127); src = (j < 128) ? W : W2; }
    f32x4 v[8];
#pragma unroll
    for (int i = 0; i < 8; ++i) { const int kk = 8 * i + kr; v[i] = (f32x4){0.f, 0.f, 0.f, 0.f}; if (oc >= 0) v[i] = *(const f32x4*)(src + (size_t)(k0 + kk) * ldw + oc); }
#pragma unroll
    for (int i = 0; i < 8; ++i) { const int kk = 8 * i + kr; const float gsc = (gain ? gain[k0 + kk] : 1.f) * cs;
#pragma unroll
        for (int e = 0; e < 4; ++e) scr[kk * 33 + 4 * (lane & 7) + e] = v[i][e] * gsc; }
    LDS_WAIT(); asm volatile("" ::: "memory");
    const int c = lane & 7;
#pragma unroll
    for (int j = 0; j < 4; ++j) { const int nn = (lane >> 3) + 8 * j; const LAS float* sp = scr + (8 * c) * 33 + nn;
        u32x4 o; o.x = pk_h2(sp[0 * 33], sp[1 * 33]); o.y = pk_h2(sp[2 * 33], sp[3 * 33]); o.z = pk_h2(sp[4 * 33], sp[5 * 33]); o.w = pk_h2(sp[6 * 33], sp[7 * 33]);
        *(u32x4*)(WT + (size_t)(n0 + nn) * K + k0 + 8 * c) = o; }
    LDS_WAIT(); asm volatile("" ::: "memory");
}
__device__ __forceinline__ int t5_bucket_d(int dist) {
    if (dist < 16) return dist;
    int large = 16 + (int)(log((double)dist / 16.0) / log(8.0) * 16.0);
    return large < 31 ? large : 31;
}
__device__ __forceinline__ void p0_prologue(Frame& F) {
    PSEC_DECL; PSEC_BEGIN(10);
    LAS float* scr = (LAS float*)(F.lds + RING_OFF + F.wave * 16384);
    const int gw = F.vcu * NWAVES + F.wave, NGW = F.G * NWAVES;
    constexpr int I_IN = (D / 64) * (DINP / 32), I_A = (512 / 64) * (D / 32), I_O = (D / 64) * (D / 32), I_GU = (D / 64) * (NGU / 32), I_D = (DFF / 64) * (D / 32);
    constexpr int I_QABS = 1024 * 4, I_UVB = 8 * 16 * 8, I_META = 7 * 8, I_TBL = 1;
    for (int it = gw; it < I_META; it += NGW) {
        const int lane = F.lane();
        int r = it;
        if (r < I_META) {
            const int cg = r >> 3, kc = r & 7, ci = cg * 64 + lane;
            const int oc = ci < 128 ? 512 + ci : (ci < 256 ? 640 + (ci - 128) : (ci < 384 ? 1024 + (ci - 256) : 1408 + (ci - 384)));
#pragma unroll 1
            for (int hf = 0; hf < 2; ++hf) {
                f32x4 mv[4], gv[4];
#pragma unroll
                for (int e4 = 0; e4 < 4; ++e4) { const int idx4 = (4 * hf + e4) * 64 + lane, q = idx4 >> 5, kk4 = idx4 & 31;
                    mv[e4] = *(const f32x4*)(F.meta() + q * 1024 + kc * 128 + 4 * kk4); gv[e4] = *(const f32x4*)(F.g1() + kc * 128 + 4 * kk4); }
#pragma unroll
                for (int e4 = 0; e4 < 4; ++e4) { const int idx4 = (4 * hf + e4) * 64 + lane, q = idx4 >> 5, kk4 = idx4 & 31;
#pragma unroll
                    for (int e = 0; e < 4; ++e) scr[(4 * kk4 + e) * 16 + q] = mv[e4][e] * gv[e4][e]; }
            }
            LDS_WAIT(); asm volatile("" ::: "memory");
            float a[16];
#pragma unroll
            for (int q = 0; q < 16; ++q) a[q] = 0.f;
            const float* wp = F.w_in() + (size_t)(kc * 128) * DIN + oc;
#pragma unroll 1
            for (int kb = 0; kb < 128; kb += 16) {
                float wv_[16];
#pragma unroll
                for (int kk = 0; kk < 16; ++kk) wv_[kk] = wp[(size_t)(kb + kk) * DIN];
#pragma unroll
                for (int kk = 0; kk < 16; ++kk) { const LAS f32x4* mp = (const LAS f32x4*)(scr + (kb + kk) * 16);
#pragma unroll
                    for (int q4 = 0; q4 < 4; ++q4) { const f32x4 m4 = mp[q4];
#pragma unroll
                        for (int e = 0; e < 4; ++e) a[4 * q4 + e] += m4[e] * wv_[kk]; }
                    if ((kk & 3) == 3) asm volatile("" ::: "memory"); } }
#pragma unroll
            for (int q = 0; q < 16; ++q) F.METAP()[(size_t)(kc * 16 + q) * 448 + ci] = a[q];
            LDS_WAIT(); asm volatile("" ::: "memory");
            continue; }
    }
    for (int it = gw; it < I_IN + I_A + I_O + I_GU + I_D; it += NGW) {
        const int lane = F.lane();
        int r = it;
        if (r < I_IN) { p0_transpose_item<0>(F.w_in(), nullptr, DIN, D, DINP, F.g1(), F.Win_t(), scr, r, lane); continue; } r -= I_IN;
        if (r < I_A) { p0_transpose_item<1>(F.w_a(), nullptr, D, 512, D, nullptr, F.Wa_t(), scr, r, lane); continue; } r -= I_A;
        if (r < I_O) { p0_transpose_item<1>(F.w_o(), nullptr, D, D, D, nullptr, F.Wo_t(), scr, r, lane); continue; } r -= I_O;
        if (r < I_GU) { p0_transpose_item<3>(F.w_g(), F.w_u(), DFF, D, NGU, F.g2(), F.Wgu_t(), scr, r, lane); continue; } r -= I_GU;
        if (r < I_D) { p0_transpose_item<1>(F.w_d(), nullptr, D, DFF, D, nullptr, F.Wd_t(), scr, r, lane); continue; }
    }
    for (int it = gw; it < I_QABS; it += NGW) {
        const int lane = F.lane();
        int r = it;
        if (r < I_QABS) {
            const int n = r >> 2, rr = (r & 3) * 64 + lane, h = n >> 7, c = n & 127;
            const f32x4* uq = (const f32x4*)(F.w_uq() + (size_t)rr * 512 + h * 64); const __attribute__((address_space(4))) f32x4* uk = (const __attribute__((address_space(4))) f32x4*)(F.w_uk() + (size_t)c * 512 + h * 64);
            float a = 0.f;
#pragma unroll 8
            for (int d = 0; d < 16; ++d) { const f32x4 p = uq[d], q = uk[d]; a += (p[0] * q[0] + p[1] * q[1]) + (p[2] * q[2] + p[3] * q[3]); }
            F.Wqabs_t()[(size_t)n * 256 + rr] = __builtin_bit_cast(h16, (_Float16)(a * QSCALE * F.qg()[rr]));
            continue; }
    }
    for (int it = (gw + NGW / 2) % NGW; it < I_UVB; it += NGW) {
        const int lane = F.lane();
        int r = it;
        if (r < I_UVB) {
            const int h = r >> 7, cg = (r >> 6) & 1, ng = r & 63, c = cg * 64 + lane, n0 = ng * 16;
            const f32x4* uvp = (const f32x4*)(F.w_uv() + (size_t)c * 512 + h * 64);
            f32x4 uv4[16];
#pragma unroll
            for (int d4 = 0; d4 < 16; ++d4) uv4[d4] = uvp[d4];
            const f32x4* wbp = (const f32x4*)(F.w_b() + (size_t)(h * 64 + lane) * 1024 + n0);
            const f32x4 wv0 = wbp[0], wv1 = wbp[1], wv2 = wbp[2], wv3 = wbp[3];
            { LAS f32x4* sp = (LAS f32x4*)scr + lane * 4; sp[0] = wv0; sp[1] = wv1; sp[2] = wv2; sp[3] = wv3; }
            LDS_WAIT(); asm volatile("" ::: "memory");
            float a[16];
#pragma unroll
            for (int q = 0; q < 16; ++q) a[q] = 0.f;
#pragma unroll
            for (int d4 = 0; d4 < 16; ++d4) {
#pragma unroll
                for (int e = 0; e < 4; ++e) { const LAS f32x4* rp = (const LAS f32x4*)scr + (4 * d4 + e) * 4; const f32x4 w0 = rp[0], w1 = rp[1], w2 = rp[2], w3 = rp[3]; const float u = uv4[d4][e];
#pragma unroll
                    for (int q = 0; q < 4; ++q) { a[q] += u * w0[q]; a[4 + q] += u * w1[q]; a[8 + q] += u * w2[q]; a[12 + q] += u * w3[q]; } }
                asm volatile("" ::: "memory"); }
            h16* op = F.Wuvb_t() + (size_t)n0 * 1024 + h * 128 + c;
#pragma unroll
            for (int q = 0; q < 16; ++q) op[(size_t)q * 1024] = __builtin_bit_cast(h16, (_Float16)a[q]);
            continue; }
    }
    if (gw >= NGW - 3) {
        const int dd = 64 * (NGW - 1 - gw) + F.lane();
        if (dd < 129) { const int bk = t5_bucket_d(dd);
#pragma unroll
            for (int hh = 0; hh < 16; ++hh) F.TBL()[hh * TBLW + dd] = LOG2E * F.relb()[bk * 16 + hh]; }
    }
    PSEC_END(10); PSEC_BEGIN(11);
    const int lane = F.lane();
    f32x4 vn[8];
    if (2 * gw < M) { const f32x4* xr = (const f32x4*)(F.x() + (size_t)(2 * gw) * D) + lane;
#pragma unroll
        for (int j = 0; j < 8; ++j) vn[j] = xr[64 * j]; }
    for (int row = 2 * gw; row < M; row += 2 * NGW) {
        f32x4 v[8]; float s0 = 0.f, s1 = 0.f;
#pragma unroll
        for (int j = 0; j < 8; ++j) v[j] = vn[j];
        if (row + 2 * NGW < M) { const f32x4* xr = (const f32x4*)(F.x() + (size_t)(row + 2 * NGW) * D) + lane;
#pragma unroll
            for (int j = 0; j < 8; ++j) vn[j] = xr[64 * j]; }
#pragma unroll
        for (int j = 0; j < 4; ++j) { s0 += (v[j][0] * v[j][0] + v[j][1] * v[j][1]) + (v[j][2] * v[j][2] + v[j][3] * v[j][3]);
            s1 += (v[j + 4][0] * v[j + 4][0] + v[j + 4][1] * v[j + 4][1]) + (v[j + 4][2] * v[j + 4][2] + v[j + 4][3] * v[j + 4][3]); }
#pragma unroll
        for (int o = 1; o < 64; o <<= 1) { s0 += __shfl_xor(s0, o); s1 += __shfl_xor(s1, o); }
        if (lane == 0) { F.RS1()[row] = 1.0f / sqrtf(s0 * (1.0f / D) + EPS); F.RS1()[row + 1] = 1.0f / sqrtf(s1 * (1.0f / D) + EPS); }
        u32x2* o8 = (u32x2*)(F.XH() + (size_t)row * D) + lane;
#pragma unroll
        for (int j = 0; j < 8; ++j) { u32x2 w; w.x = pk_h2(v[j][0], v[j][1]); w.y = pk_h2(v[j][2], v[j][3]); o8[64 * j] = w; }
    }
    PSEC_END(11); PSEC_BURN(10, 11);
}

__device__ __forceinline__ void p2_norms(Frame& F) {
    PSEC_DECL; PSEC_BEGIN(20);
    const int gw = F.vcu * NWAVES + F.wave, NGW = F.G * NWAVES, lane = F.lane();
    const float kg0 = F.kvg()[2 * lane], kg1 = F.kvg()[2 * lane + 1], lg = F.lng()[lane], lb = F.lnb()[lane];
    float nb0[4], nb1[4], nik[4], niw[4]; u32x2 nqw[4];
#define P2_LOAD(r4_) do { _Pragma("unroll") for (int u = 0; u < 4; ++u) { const float* rw = F.RAW4() + (size_t)((r4_) + u) * 256; \
            nb0[u] = rw[2 * lane]; nb1[u] = rw[2 * lane + 1]; nik[u] = rw[128 + lane]; niw[u] = rw[192 + (lane & 3)]; \
            nqw[u] = ((const u32x2*)(F.BQ() + (size_t)((r4_) + u) * 256))[lane]; } } while (0)
    if (4 * gw < M) P2_LOAD(4 * gw);
    for (int row4 = 4 * gw; row4 < M; row4 += 4 * NGW) {
        float b0[4], b1[4], ik[4], q0[4], q1[4], q2[4], q3[4], iw[4];
#pragma unroll
        for (int u = 0; u < 4; ++u) { b0[u] = nb0[u]; b1[u] = nb1[u]; ik[u] = nik[u]; iw[u] = niw[u]; const h16x4 qh = __builtin_bit_cast(h16x4, nqw[u]);
            q0[u] = (float)qh[0]; q1[u] = (float)qh[1]; q2[u] = (float)qh[2]; q3[u] = (float)qh[3]; }
        if (row4 + 4 * NGW < M) P2_LOAD(row4 + 4 * NGW);
        float sb[4], si[4], sq[4];
#pragma unroll
        for (int u = 0; u < 4; ++u) { sb[u] = b0[u] * b0[u] + b1[u] * b1[u]; si[u] = ik[u]; sq[u] = (q0[u] * q0[u] + q1[u] * q1[u]) + (q2[u] * q2[u] + q3[u] * q3[u]); }
#pragma unroll
        for (int o = 1; o < 64; o <<= 1) {
#pragma unroll
            for (int u = 0; u < 4; ++u) { sb[u] += __shfl_xor(sb[u], o); si[u] += __shfl_xor(si[u], o); sq[u] += __shfl_xor(sq[u], o); } }
        float dc[4], sv[4];
#pragma unroll
        for (int u = 0; u < 4; ++u) { dc[u] = ik[u] - si[u] * (1.0f / 64.0f); sv[u] = dc[u] * dc[u]; }
#pragma unroll
        for (int o = 1; o < 64; o <<= 1) {
#pragma unroll
            for (int u = 0; u < 4; ++u) sv[u] += __shfl_xor(sv[u], o); }
#pragma unroll
        for (int u = 0; u < 4; ++u) { const int row = row4 + u; const size_t prow = (size_t)(row >> 11) * P + BLK + (row & 2047);
            const float rk = 1.0f / sqrtf(sb[u] * (1.0f / 128.0f) + EPS);
            ((unsigned*)(F.CKV() + prow * 128))[lane] = pk_h2(b0[u] * rk * kg0, b1[u] * rk * kg1);
            F.IKN()[prow * 64 + lane] = __builtin_bit_cast(h16, (_Float16)(dc[u] * (1.0f / sqrtf(sv[u] * (1.0f / 64.0f) + EPS)) * lg + lb));
            if (lane < 4) F.IWS()[(size_t)row * 4 + lane] = iw[u] * 0.0625f;
            if (lane == 0) F.RSQ()[row] = 1.0f / sqrtf(sq[u] * (1.0f / 256.0f) + EPS); }
    }
#undef P2_LOAD
    for (int it = gw; it < 16 * BATCH; it += NGW) {
        const int r = it & 15, b = it >> 4;
        float mv[16]; float s = 0.f;
#pragma unroll
        for (int k = 0; k < 16; ++k) mv[k] = F.meta()[r * 1024 + k * 64 + lane];
        float v[7], pa[7][8];
#pragma unroll
        for (int cg = 0; cg < 7; ++cg)
#pragma unroll
            for (int kc = 0; kc < 8; ++kc) pa[cg][kc] = F.METAP()[(size_t)(kc * 16 + r) * 448 + cg * 64 + lane];
#pragma unroll
        for (int k = 0; k < 16; ++k) s += mv[k] * mv[k];
        const float rsm = 1.0f / sqrtf(wave_sum(s) * (1.0f / D) + EPS);
#pragma unroll
        for (int cg = 0; cg < 7; ++cg) { float a = 0.f;
#pragma unroll
            for (int kc = 0; kc < 8; ++kc) a += pa[cg][kc];
            v[cg] = a * rsm; }
        const float rk = 1.0f / sqrtf(wave_sum(v[4] * v[4] + v[5] * v[5]) * (1.0f / 128.0f) + EPS);
        const float c0 = v[4] * rk * F.kvg()[lane], c1 = v[5] * rk * F.kvg()[64 + lane];
        const float mu = wave_sum(v[6]) * (1.0f / 64.0f), dc = v[6] - mu, var = wave_sum(dc * dc) * (1.0f / 64.0f);
        const float ikn = dc * (1.0f / sqrtf(var + EPS)) * lg + lb;
        const size_t prow = (size_t)b * P + NPAD + r;
        F.AK()[prow * 128 + lane] = __builtin_bit_cast(h16, (_Float16)v[0]); F.AK()[prow * 128 + 64 + lane] = __builtin_bit_cast(h16, (_Float16)v[1]);
        F.AV()[prow * 128 + lane] = __builtin_bit_cast(h16, (_Float16)v[2]); F.AV()[prow * 128 + 64 + lane] = __builtin_bit_cast(h16, (_Float16)v[3]);
        F.CKV()[prow * 128 + lane] = __builtin_bit_cast(h16, (_Float16)c0); F.CKV()[prow * 128 + 64 + lane] = __builtin_bit_cast(h16, (_Float16)c1);
        F.IKN()[prow * 64 + lane] = __builtin_bit_cast(h16, (_Float16)ikn);
    }
    for (int it = gw; it < BATCH * NPAD; it += NGW) { const size_t prow = (size_t)(it / NPAD) * P + (it % NPAD);
        ((unsigned*)(F.AK() + prow * 128))[lane] = 0u; ((unsigned*)(F.AV() + prow * 128))[lane] = 0u; ((unsigned*)(F.CKV() + prow * 128))[lane] = 0u;
        if (lane < 32) ((unsigned*)(F.IKN() + prow * 64))[lane] = 0u; }
    PSEC_END(20); PSEC_BURN(20, 20);
}

constexpr int A_KSTR = 144, A_LDS_K = 0, A_LDS_V = 256 * A_KSTR, A_LDS_TB = 2 * 256 * A_KSTR;
__device__ __forceinline__ void attn_a_phase(Frame& F) {
    PSEC_DECL; PSEC_BEGIN(5);
    LAS unsigned char* lds = F.lds;
    const int lane = F.lane(), w = F.wave, tid = F.tid(), q32 = lane & 31, hh = lane >> 5;
    const float NINF = -__builtin_inff();
    const int g = w & 3;
    const int nun = BATCH * 16 * 2;
    u32x4 kreg[4], vreg[4]; float tbreg = 0.f; h16x8 qn[2][4];
#define AA_LOAD(u_) do { const int kvh_ = (u_) & 1, blk_ = 1 + (((u_) >> 1) & 15), b_ = (u_) >> 5; const size_t kb_ = (size_t)b_ * P + (size_t)(blk_ - 1) * BLK; \
        _Pragma("unroll") for (int i = 0; i < 4; ++i) { const int id = i * 512 + tid, row = id >> 3, ch = id & 7; \
            kreg[i] = *(const u32x4*)(F.AK() + (kb_ + row) * 128 + kvh_ * 64 + ch * 8); vreg[i] = *(const u32x4*)(F.AV() + (kb_ + row) * 128 + kvh_ * 64 + ch * 8); } \
        tbreg = F.TBL()[(kvh_ * 4 + (tid >> 7)) * TBLW + (tid & 127)]; \
        _Pragma("unroll") for (int qq = 0; qq < 2; ++qq) { const size_t qrow_ = (size_t)b_ * SEQ + (size_t)(blk_ - 1) * BLK + ((w >> 2) * 2 + qq) * 32 + q32; \
            _Pragma("unroll") for (int ks = 0; ks < 4; ++ks) qn[qq][ks] = *(const h16x8*)(F.AQ() + qrow_ * 512 + (kvh_ * 4 + g) * 64 + ks * 16 + hh * 8); } } while (0)
    if (F.vcu < nun) AA_LOAD(F.vcu);
    for (int u = F.vcu; u < nun; u += F.G) {
        const int kvh = u & 1, blk = 1 + ((u >> 1) & 15), b = u >> 5;
        __syncthreads();
#pragma unroll
        for (int i = 0; i < 4; ++i) { const int id = i * 512 + tid, row = id >> 3, ch = id & 7;
            *(LAS u32x4*)(lds + A_LDS_K + row * A_KSTR + ch * 16) = kreg[i]; *(LAS u32x4*)(lds + A_LDS_V + row * A_KSTR + ch * 16) = vreg[i]; }
        ((LAS float*)(lds + A_LDS_TB))[tid] = tbreg;
        h16x8 qf[2][4];
#pragma unroll
        for (int qq = 0; qq < 2; ++qq)
#pragma unroll
            for (int ks = 0; ks < 4; ++ks) qf[qq][ks] = qn[qq][ks];
        __syncthreads();
        if (u + F.G < nun) AA_LOAD(u + F.G);
        const int head = kvh * 4 + g;
        const float sink = F.sinks()[head] * LOG2E;
        const LAS float* TB = (const LAS float*)(lds + A_LDS_TB) + g * 128;
        const unsigned vtr = (unsigned)(A_LDS_V + (4 * hh + ((lane & 15) >> 2)) * A_KSTR + (16 * ((lane >> 4) & 1) + 4 * (lane & 3)) * 2);
#pragma unroll 1
        for (int qq = 0; qq < 2; ++qq) {
            h16x8 qc[4];
            if (qq == 0) { qc[0] = qf[0][0]; qc[1] = qf[0][1]; qc[2] = qf[0][2]; qc[3] = qf[0][3]; } else { qc[0] = qf[1][0]; qc[1] = qf[1][1]; qc[2] = qf[1][2]; qc[3] = qf[1][3]; }
            const int qg = (w >> 2) * 2 + qq, i_loc = qg * 32 + q32;
            const size_t qrow = (size_t)b * SEQ + (size_t)(blk - 1) * BLK + i_loc;
            float m_run = sink, l_run = 1.0f;
            f32x16 o0, o1;
#pragma unroll
            for (int r = 0; r < 16; ++r) { o0[r] = 0.f; o1[r] = 0.f; }
            for (int kt = qg; kt <= qg + 4; ++kt) {
                f32x16 sacc;
#pragma unroll
                for (int r = 0; r < 16; ++r) sacc[r] = 0.f;
#pragma unroll
                for (int ks = 0; ks < 4; ++ks) { const h16x8 kf = *(const LAS h16x8*)(lds + A_LDS_K + (kt * 32 + q32) * A_KSTR + (ks * 16 + hh * 8) * 2);
                    sacc = __builtin_amdgcn_mfma_f32_32x32x16_f16(kf, qc[ks], sacc, 0, 0, 0); }
                float mx = NINF;
                float bia[16];
#pragma unroll
                for (int r = 0; r < 16; ++r) { const int j = kt * 32 + (r & 3) + 8 * (r >> 2) + 4 * hh, dist = 128 + i_loc - j; bia[r] = TB[dist & 127]; }
                if (kt == qg || kt == qg + 4 || blk == 1) {
#pragma unroll
                    for (int r = 0; r < 16; ++r) { const int j = kt * 32 + (r & 3) + 8 * (r >> 2) + 4 * hh, dist = 128 + i_loc - j;
                        const bool valid = (dist >= 0) && (dist < 128) && ((blk - 1) * BLK + j >= NPAD);
                        const float v0 = sacc[r] + bia[r]; const float v = valid ? v0 : NINF; sacc[r] = v; mx = fmaxf(mx, v); }
                } else {
#pragma unroll
                    for (int r = 0; r < 16; ++r) { const float v = sacc[r] + bia[r]; sacc[r] = v; mx = fmaxf(mx, v); }
                }
                mx = fmaxf(mx, __shfl_xor(mx, 32));
                if (__any(mx > m_run + 8.0f)) {
                    const float m_new = fmaxf(m_run, mx), alpha = __builtin_amdgcn_exp2f(m_run - m_new);
                    l_run *= alpha; m_run = m_new;
#pragma unroll
                    for (int r = 0; r < 16; ++r) { o0[r] *= alpha; o1[r] *= alpha; }
                }
                float ps = 0.f;
#pragma unroll
                for (int r = 0; r < 16; ++r) { const float p = __builtin_amdgcn_exp2f(sacc[r] - m_run); sacc[r] = p; ps += p; }
                ps += __shfl_xor(ps, 32);
                l_run += ps;
#pragma unroll
                for (int sx = 0; sx < 2; ++sx) {
                    const u32x4 pw = {pk_h2(sacc[8 * sx], sacc[8 * sx + 1]), pk_h2(sacc[8 * sx + 2], sacc[8 * sx + 3]), pk_h2(sacc[8 * sx + 4], sacc[8 * sx + 5]), pk_h2(sacc[8 * sx + 6], sacc[8 * sx + 7])};
                    const h16x8 pf = __builtin_bit_cast(h16x8, pw);
                    const LAS unsigned char* vb = lds + vtr + (kt * 32 + 16 * sx) * A_KSTR;
                    const h16x4 a0l = ds_tr16a(vb), a0h = ds_tr16a(vb + 8 * A_KSTR), a1l = ds_tr16a(vb + 64), a1h = ds_tr16a(vb + 8 * A_KSTR + 64);
                    const h16x8 va0 = {a0l[0], a0l[1], a0l[2], a0l[3], a0h[0], a0h[1], a0h[2], a0h[3]}, va1 = {a1l[0], a1l[1], a1l[2], a1l[3], a1h[0], a1h[1], a1h[2], a1h[3]};
                    o0 = __builtin_amdgcn_mfma_f32_32x32x16_f16(va0, pf, o0, 0, 0, 0);
                    o1 = __builtin_amdgcn_mfma_f32_32x32x16_f16(va1, pf, o1, 0, 0, 0); }
            }
            const float inv = 1.0f / l_run;
            h16* op = F.OA() + qrow * 512 + head * 64 + 4 * hh;
#pragma unroll
            for (int g4 = 0; g4 < 4; ++g4) {
                u32x2 w0, w1; w0.x = pk_h2(o0[4 * g4] * inv, o0[4 * g4 + 1] * inv); w0.y = pk_h2(o0[4 * g4 + 2] * inv, o0[4 * g4 + 3] * inv);
                w1.x = pk_h2(o1[4 * g4] * inv, o1[4 * g4 + 1] * inv); w1.y = pk_h2(o1[4 * g4 + 2] * inv, o1[4 * g4 + 3] * inv);
                *(u32x2*)(op + 8 * g4) = w0; *(u32x2*)(op + 32 + 8 * g4) = w1; }
        }
    }
#undef AA_LOAD
    __syncthreads();
    PSEC_END(5); PSEC_BURN(5, 5);
}

constexpr int L3_STAGE = 0  , L3_HIST = 0  , HROW = 260, L3_DUMMY = 32 * HROW * 4,
              L3_SEL = MISC_OFF + 704  , L3_RES = L3_SEL + 32 * 256 * 2, L3_CNT2 = L3_RES + 32 * 4 * 4, L3_TB = L3_CNT2 + 32 * 32 * 4, L3_END = L3_TB + 8 * TBLW * 4;
static_assert(L3_SEL >= MISC_OFF + 128 && L3_SEL % 16 == 0 && L3_END <= LDS_BYTES && L3_DUMMY % 16 == 0 && L3_DUMMY + 4096 <= RING_BYTES, "P3 LDS map");
__device__ __forceinline__ h16x4 ds_tr16(const LAS unsigned char* p) { return __builtin_bit_cast(h16x4, __builtin_amdgcn_ds_read_tr16_b64_v4i16((LAS s16x4*)p)); }
__device__ __forceinline__ void mixer_b_phase(Frame& F) {
    PSEC_DECL;
    LAS unsigned char* lds = F.lds;
    const int w = F.wave, tid = F.tid();
    const float NINF = -__builtin_inff();
    LAS unsigned short* SEL = (LAS unsigned short*)(lds + L3_SEL);
    LAS unsigned* HIST = (LAS unsigned*)(lds + L3_HIST);
    LAS unsigned* RES = (LAS unsigned*)(lds + L3_RES);
    LAS unsigned* CNT2 = (LAS unsigned*)(lds + L3_CNT2);
    LAS float* TB = (LAS float*)(lds + L3_TB);
    LAS unsigned char* stage = lds + L3_STAGE + w * 16384;
    __syncthreads();
    for (int e = tid; e < 8 * 130; e += 512) { const int hh = e / 130, dd = e % 130; TB[hh * TBLW + dd] = dd ? F.TBL()[(8 + hh) * TBLW + dd - 1] : NINF; }
    const int nunits = BATCH * 16 * 4;
    PSEC_BEGIN(4);
    for (int it = 0; ; ++it) {
        const int lane = F.lane();
        const int n16 = lane & 15, g = lane >> 4;
        int b, blk, sub;
        if (F.G == 256) {
            if (it >= 8) break; b = 4 * (F.vcu >> 5) + (F.vcu & 3); sub = (F.vcu >> 2) & 3; const int par = (F.vcu >> 4) & 1, k4 = 4 * (it >> 1);
            blk = (it & 1) ? 16 - par - k4 : 1 + par + k4; }
        else { const int uid = F.vcu + it * F.G; if (uid >= nunits) break; b = uid >> 6; sub = (uid >> 4) & 3; blk = 1 + (uid & 15); }
        const int t0 = (blk - 1) * BLK + sub * 32;
        const size_t qrow0 = (size_t)b * SEQ + t0;
        const int ntile = (blk + 1) * 8;
        const GAS h16* ikb = (const GAS h16*)(F.IKN() + (size_t)b * P * 64);
        for (int e = tid; e < 32 * HROW; e += 512) HIST[e] = 0u;
        PSEC_BEGIN(0);
        unsigned sk[2][17][4];
#pragma unroll
        for (int gq = 0; gq < 2; ++gq) {
            h16x8 qb[4][2];
#pragma unroll
            for (int h = 0; h < 4; ++h)
#pragma unroll
                for (int ks = 0; ks < 2; ++ks) qb[h][ks] = *(const GAS h16x8*)((const GAS h16*)F.IQ() + (qrow0 + 16 * gq + n16) * 256 + h * 64 + ks * 32 + 8 * g);
            const f32x4 wv = *(const GAS f32x4*)((const GAS float*)F.IWS() + (qrow0 + 16 * gq + n16) * 4);
            const int qpos = BLK + t0 + 16 * gq + n16;
            int kb1 = w * 16 + 4 * g; asm volatile("" : "+v"(kb1));
            const GAS h16* ap = ikb + (size_t)(w * 16 + n16) * 64 + 8 * g;
            h16x8 A0[22], A1[22];
            { const u32x4 z = {0u, 0u, 0u, 0u};
#pragma unroll
              for (int j = 0; j < 22; ++j) { A0[j] = __builtin_bit_cast(h16x8, z); A1[j] = A0[j]; } }
#pragma unroll
            for (int j = 0; j < 3; ++j) if (w + 8 * j < ntile) { A0[j] = *(const GAS h16x8*)(ap + 8192 * j); A1[j] = *(const GAS h16x8*)(ap + 8192 * j + 32); }
            ap += 2 * 8192;
#pragma unroll
            for (int j = 0; j < 17; ++j) {
                const int kt = w + 8 * j;
                ap += 8192; asm volatile("" : "+v"(ap));
                if (j + 3 < 17 && kt + 24 < ntile) { A0[j + 3] = *(const GAS h16x8*)ap; A1[j + 3] = *(const GAS h16x8*)(ap + 32); }
                asm volatile("" ::: "memory");
                if (kt < ntile) {
                    float sc[4] = {0.f, 0.f, 0.f, 0.f};
#pragma unroll
                    for (int h = 0; h < 4; ++h) { f32x4 c = {0.f, 0.f, 0.f, 0.f};
                        c = __builtin_amdgcn_mfma_f32_16x16x32_f16(A0[j], qb[h][0], c, 0, 0, 0); c = __builtin_amdgcn_mfma_f32_16x16x32_f16(A1[j], qb[h][1], c, 0, 0, 0);
#pragma unroll
                        for (int r = 0; r < 4; ++r) sc[r] += fmaxf(c[r], 0.f) * wv[h]; }
                    const unsigned zk = 0x7fffffffu - (unsigned)(kb1 + 128 * j);
#pragma unroll
                    for (int r = 0; r < 4; ++r) { const unsigned bits = __builtin_bit_cast(unsigned, sc[r]);
                        const unsigned key = bits ^ ((unsigned)((int)bits >> 31) | 0x80000000u);
                        sk[gq][j][r] = (sc[r] == 0.f) ? zk - (unsigned)r : key; }
                    if (kt < 7 || kt * 16 + 15 > BLK + t0 + 16 * gq) {
#pragma unroll
                        for (int r = 0; r < 4; ++r) { const int kpos = kb1 + 128 * j + r; if (kpos < NPAD || kpos > qpos) sk[gq][j][r] = 0u; }
                    }
                } else {
#pragma unroll
                    for (int r = 0; r < 4; ++r) sk[gq][j][r] = 0u;
                }
            }
        }
        PSEC_END(0); PSEC_BEGIN(1);
        unsigned prefix[2] = {0u, 0u}, T[2] = {1u, 1u}; int need[2]; bool done[2]; unsigned hbase[2];
#pragma unroll
        for (int gq = 0; gq < 2; ++gq) { const int nadm = BLK + t0 + 16 * gq + n16 - NPAD + 1; need[gq] = nadm < TOPK ? nadm : TOPK; done[gq] = (nadm <= TOPK); hbase[gq] = (unsigned)(16 * gq + n16) * (unsigned)HROW; }
        const unsigned sink = (unsigned)(L3_DUMMY - L3_HIST) / 4u + (unsigned)tid;
        __syncthreads();
#define RADIX_SCAN_UPDATE() do { \
            __syncthreads(); \
            { \
                const int qs = 4 * w + g, l16 = n16; \
                LAS u32x4* hp = (LAS u32x4*)(HIST + qs * HROW + 16 * l16); \
                const u32x4 c0 = hp[0], c1 = hp[1], c2 = hp[2], c3 = hp[3]; const u32x4 z = {0u, 0u, 0u, 0u}; hp[0] = z; hp[1] = z; hp[2] = z; hp[3] = z; \
                const unsigned cnt[16] = {c0[0], c0[1], c0[2], c0[3], c1[0], c1[1], c1[2], c1[3], c2[0], c2[1], c2[2], c2[3], c3[0], c3[1], c3[2], c3[3]}; \
                unsigned t = 0u; \
_Pragma("unroll") \
                for (int i = 0; i < 16; ++i) t += cnt[i]; \
                unsigned incl = t; \
_Pragma("unroll") \
                for (int d = 1; d < 16; d <<= 1) { const unsigned v = (unsigned)__shfl_down((int)incl, d, 16); incl += (l16 + d < 16) ? v : 0u; } \
                const unsigned S = incl - t; \
 \
                const int nq = 4 * (w & 3) + g; \
                const unsigned mq = (w >= 4) ? (unsigned)__shfl(need[1], nq) : (unsigned)__shfl(need[0], nq); \
                const int dq = (w >= 4) ? __shfl((int)done[1], nq) : __shfl((int)done[0], nq); \
                if (!dq && S < mq && mq <= S + t) { \
                    unsigned acc = S, bsel = 0u, msel = 0u, csel = 0u; \
_Pragma("unroll") \
                    for (int i = 15; i >= 0; --i) { if (acc < mq && mq <= acc + cnt[i]) { bsel = (unsigned)(16 * l16 + i); msel = mq - acc; csel = cnt[i]; } acc += cnt[i]; } \
                    RES[qs * 4 + 0] = bsel; RES[qs * 4 + 1] = msel; RES[qs * 4 + 2] = csel; \
                } \
            } \
            __syncthreads(); \
_Pragma("unroll") \
            for (int gq = 0; gq < 2; ++gq) \
                if (!done[gq]) { const int qi = 16 * gq + n16; const unsigned bsel = RES[qi * 4 + 0], msel = RES[qi * 4 + 1], csel = RES[qi * 4 + 2]; \
                    prefix[gq] |= bsel << shift; \
                    if (csel == msel || pass == 3) { done[gq] = true; T[gq] = prefix[gq]; } else need[gq] = (int)msel; } \
 \
        } while (0)
        if (__any(!done[0] || !done[1])) {
            { const int pass = 0, shift = 24;
#pragma unroll
              for (int gq = 0; gq < 2; ++gq)
#pragma unroll
                for (int j = 0; j < 17; ++j) if (w + 8 * j < ntile) {
#pragma unroll
                    for (int r = 0; r < 4; ++r) __hip_atomic_fetch_add(HIST + hbase[gq] + (sk[gq][j][r] >> 24), 1u, __ATOMIC_RELAXED, __HIP_MEMORY_SCOPE_WORKGROUP); }
              RADIX_SCAN_UPDATE(); }
#pragma unroll 1
            for (int pass = 1; pass < 4; ++pass) {
                if (!__any(!done[0] || !done[1])) break;
                const int shift = 24 - 8 * pass;
#pragma unroll
                for (int gq = 0; gq < 2; ++gq) {
                    const unsigned pfx = done[gq] ? 0xffffffffu : prefix[gq];
#pragma unroll
                    for (int j = 0; j < 17; ++j) if (w + 8 * j < ntile) {
                        unsigned mm[4];
#pragma unroll
                        for (int r = 0; r < 4; ++r) mm[r] = ((sk[gq][j][r] ^ pfx) >> shift) >> 8;
                        if (pass == 1 || __any((mm[0] == 0u) | (mm[1] == 0u) | (mm[2] == 0u) | (mm[3] == 0u))) {
#pragma unroll
                            for (int r = 0; r < 4; ++r) { const unsigned slot = mm[r] ? sink : hbase[gq] + ((sk[gq][j][r] >> shift) & 255u);
                                __hip_atomic_fetch_add(HIST + slot, 1u, __ATOMIC_RELAXED, __HIP_MEMORY_SCOPE_WORKGROUP); } } } }
                RADIX_SCAN_UPDATE();
            }
        }
#undef RADIX_SCAN_UPDATE
        PSEC_END(1); PSEC_BEGIN(2);
        {
            int kb2 = w * 16 + 4 * g; asm volatile("" : "+v"(kb2));
            const int mine = w * 4 + g;
#pragma unroll
            for (int gq = 0; gq < 2; ++gq) { int c = 0;
#pragma unroll
                for (int j = 0; j < 17; ++j) if (w + 8 * j < ntile) {
#pragma unroll
                    for (int r = 0; r < 4; ++r) c += (sk[gq][j][r] >= T[gq]) ? 1 : 0; }
                CNT2[(16 * gq + n16) * 32 + mine] = (unsigned)c; }
            __syncthreads();
#pragma unroll
            for (int gq = 0; gq < 2; ++gq) { const int qi = 16 * gq + n16; int off = 0;
#pragma unroll
                for (int o4 = 0; o4 < 8; ++o4) { const u32x4 cv = *(const LAS u32x4*)(CNT2 + qi * 32 + 4 * o4);
#pragma unroll
                    for (int e = 0; e < 4; ++e) off += (4 * o4 + e < mine) ? (int)cv[e] : 0; }
                unsigned cur = (unsigned)(L3_SEL + (qi * 256 + off) * 2); const unsigned lim = (unsigned)(L3_SEL + (qi * 256 + 255) * 2), trash = (unsigned)(L3_DUMMY + 2048 + tid * 2);
#pragma unroll
                for (int j = 0; j < 17; ++j) if (w + 8 * j < ntile) {
#pragma unroll
                    for (int r = 0; r < 4; ++r) { const bool selk = sk[gq][j][r] >= T[gq];
                        *(LAS unsigned short*)(lds + (selk ? (cur < lim ? cur : lim) : trash)) = (unsigned short)(kb2 + 128 * j + r); cur += selk ? 2u : 0u; } } }
            if (BLK + t0 - NPAD + 1 < TOPK) {
                for (int e = tid; e < 32 * 256; e += 512) { const int qpe = BLK + t0 + (e >> 8), nse = qpe - NPAD + 1; if ((e & 255) >= nse) SEL[e] = (unsigned short)(qpe + 1); }
            }
            __syncthreads();
        }
        PSEC_END(2); PSEC_BEGIN(3);
        const __amdgpu_buffer_rsrc_t crs = __builtin_amdgcn_make_buffer_rsrc((void*)(F.CKV() + (size_t)b * P * 128), 0, P * 256, 0x00020000);
            u32x4 G[16];
            const unsigned goff = (unsigned)n16 * 16u;
#define MLA_GATHER(sq_, c_) do { _Pragma("unroll") for (int kk = 0; kk < 2; ++kk) { const int i0_ = 64 * (c_) + 32 * kk + 8 * g; const u32x4 sv_ = *(const LAS u32x4*)((sq_) + i0_); \
                _Pragma("unroll") for (int i = 0; i < 8; ++i) {   \
                const unsigned vo_ = __builtin_amdgcn_perm(sv_[i >> 1], goff, (i & 1) ? 0x01070600u : 0x01050400u); \
                G[8 * kk + i] = __builtin_bit_cast(u32x4, __builtin_amdgcn_raw_buffer_load_b128(crs, (int)vo_, 0, 0)); } } } while (0)
#define MLA_WRITE() do { _Pragma("unroll") for (int kk = 0; kk < 2; ++kk) _Pragma("unroll") for (int i = 0; i < 8; ++i) *(LAS u32x4*)(stage + wbase[i >> 2] + 8192 * kk + 64 * i) = G[8 * kk + i]; } while (0)
            const unsigned qd = (unsigned)(n16 >> 2), pp = (unsigned)(lane & 3), ph = pp >> 1;
            unsigned rbase[2], tbase[2][2], wbase[2];
#pragma unroll
            for (int t = 0; t < 2; ++t) { rbase[t] = 2048u * qd + 64u * (4u * t + (n16 & 3)) + 16u * ((unsigned)g ^ ((2u * qd + t) & 3u));
                wbase[t] = 2048u * g + 512u * qd + 16u * ((unsigned)(n16 & 3) ^ (2u * (g & 1) + t));
#pragma unroll
                for (int mp = 0; mp < 2; ++mp) tbase[mp][t] = 2048u * g + 64u * (4u * t + qd) + 16u * ((2u * mp + ph) ^ (2u * (g & 1) + t)) + 8u * (pp & 1); }
            MLA_GATHER(SEL + w * 256, 0);
#pragma unroll 1
        for (int qq = w; qq < 32; qq += 8) {
            const size_t qrow = qrow0 + qq; const int qp = BLK + t0 + qq;
            const int nsel = (qp - NPAD + 1) < TOPK ? (qp - NPAD + 1) : TOPK, nch = (nsel + 63) >> 6;
            h16x8 qa[4];
#pragma unroll
            for (int ks = 0; ks < 4; ++ks) { const u32x4 z = {0u, 0u, 0u, 0u}; qa[ks] = (n16 < 8) ? *(const GAS h16x8*)((const GAS h16*)F.QABS() + qrow * 1024 + n16 * 128 + ks * 32 + 8 * g) : __builtin_bit_cast(h16x8, z); }
            const float rsq = __builtin_bit_cast(float, __builtin_amdgcn_readfirstlane(__builtin_bit_cast(int, F.RSQ()[qrow])));
            const LAS float* tb = TB + (n16 & 7) * TBLW + 1;
            const LAS unsigned short* selq = SEL + qq * 256;
            float m_run = -1e30f, l_run = 0.f;
            f32x4 o[8];
#pragma unroll
            for (int mt = 0; mt < 8; ++mt) o[mt] = (f32x4){0.f, 0.f, 0.f, 0.f};
            MLA_WRITE();
            if (nch > 1) MLA_GATHER(selq, 1); else if (qq + 8 < 32) MLA_GATHER(selq + 8 * 256, 0);
            for (int c = 0; c < nch; ++c) {
                h16x8 af[16];
#pragma unroll
                for (int q8 = 0; q8 < 8; ++q8) af[q8] = *(const LAS h16x8*)(stage + rbase[(q8 >> 2) & 1] + 8192 * (q8 >> 3) + 512 * (q8 & 3));
                __builtin_amdgcn_sched_barrier(0);
#pragma unroll
                for (int q8 = 8; q8 < 16; ++q8) af[q8] = *(const LAS h16x8*)(stage + rbase[(q8 >> 2) & 1] + 8192 * (q8 >> 3) + 512 * (q8 & 3));
                f32x4 st[4];
#pragma unroll
                for (int tt = 0; tt < 2; ++tt) { st[tt] = (f32x4){0.f, 0.f, 0.f, 0.f};
#pragma unroll
                    for (int ks = 0; ks < 4; ++ks) st[tt] = __builtin_amdgcn_mfma_f32_16x16x32_f16(af[4 * tt + ks], qa[ks], st[tt], 0, 0, 0); }
                __builtin_amdgcn_sched_barrier(0);
                float bia[2][8];
#pragma unroll
                for (int kk = 0; kk < 2; ++kk) {
                    const u32x4 sv = *(const LAS u32x4*)(selq + 64 * c + 32 * kk + 8 * g);
#pragma unroll
                    for (int e = 0; e < 8; ++e) { const int kp = (int)((sv[e >> 1] >> (16 * (e & 1))) & 0xffffu); int dist = qp - kp; dist = dist < -1 ? -1 : dist; dist = dist < 128 ? dist : 128; bia[kk][e] = tb[dist]; }
                }
                h16x4 vlo[2][8], vhi[2][8];
#pragma unroll
                for (int mt = 0; mt < 8; ++mt) { vlo[0][mt] = ds_tr16(stage + tbase[mt & 1][0] + 512 * (mt >> 1)); vhi[0][mt] = ds_tr16(stage + tbase[mt & 1][1] + 512 * (mt >> 1)); }
#pragma unroll
                for (int tt = 2; tt < 4; ++tt) { st[tt] = (f32x4){0.f, 0.f, 0.f, 0.f};
#pragma unroll
                    for (int ks = 0; ks < 4; ++ks) st[tt] = __builtin_amdgcn_mfma_f32_16x16x32_f16(af[4 * tt + ks], qa[ks], st[tt], 0, 0, 0); }
                __builtin_amdgcn_sched_barrier(0);
                float mx = NINF;
#pragma unroll
                for (int kk = 0; kk < 2; ++kk) {
#pragma unroll
                    for (int t = 0; t < 2; ++t)
#pragma unroll
                        for (int r = 0; r < 4; ++r) { const float v = st[2 * kk + t][r] * rsq + bia[kk][4 * t + r]; st[2 * kk + t][r] = v; mx = fmaxf(mx, v); }
                }
                mx = fmaxf(mx, __shfl_xor(mx, 16)); mx = fmaxf(mx, __shfl_xor(mx, 32));
                if (__any(mx > m_run + 8.0f)) {
                    const float m_new = fmaxf(m_run, mx), alpha = __builtin_amdgcn_exp2f(m_run - m_new);
                    l_run *= alpha; m_run = m_new;
#pragma unroll
                    for (int mt = 0; mt < 8; ++mt) o[mt] = o[mt] * alpha;
                }
                float ps = 0.f;
#pragma unroll
                for (int tt = 0; tt < 4; ++tt)
#pragma unroll
                    for (int r = 0; r < 4; ++r) { const float p = __builtin_amdgcn_exp2f(st[tt][r] - m_run); st[tt][r] = p; ps += p; }
                ps += __shfl_xor(ps, 16); ps += __shfl_xor(ps, 32);
                l_run += ps;
                __builtin_amdgcn_sched_barrier(0);
#pragma unroll
                for (int mt = 0; mt < 8; ++mt) { vlo[1][mt] = ds_tr16(stage + tbase[mt & 1][0] + 8192 + 512 * (mt >> 1)); vhi[1][mt] = ds_tr16(stage + tbase[mt & 1][1] + 8192 + 512 * (mt >> 1)); }
#pragma unroll
                for (int kk = 0; kk < 2; ++kk) {
                    const u32x4 pw = {pk_h2(st[2 * kk][0], st[2 * kk][1]), pk_h2(st[2 * kk][2], st[2 * kk][3]), pk_h2(st[2 * kk + 1][0], st[2 * kk + 1][1]), pk_h2(st[2 * kk + 1][2], st[2 * kk + 1][3])};
                    const h16x8 pb = __builtin_bit_cast(h16x8, pw);
#pragma unroll
                    for (int mt = 0; mt < 8; ++mt) {
                        const h16x4 lo4 = vlo[kk][mt], hi4 = vhi[kk][mt];
                        const h16x8 a = {lo4[0], lo4[1], lo4[2], lo4[3], hi4[0], hi4[1], hi4[2], hi4[3]};
                        o[mt] = __builtin_amdgcn_mfma_f32_16x16x32_f16(a, pb, o[mt], 0, 0, 0); }
                    if (kk == 0) __builtin_amdgcn_sched_barrier(0);
                }
                if (c + 1 < nch) { MLA_WRITE(); if (c + 2 < nch) MLA_GATHER(selq, c + 2); else if (qq + 8 < 32) MLA_GATHER(selq + 8 * 256, 0); }
            }
#undef MLA_GATHER
#undef MLA_WRITE
            const float inv = 1.0f / l_run;
            if (n16 < 8) { h16* op = F.LAT() + qrow * 1024 + n16 * 128 + 4 * g;
#pragma unroll
                for (int mt = 0; mt < 8; ++mt) { u32x2 ww; ww.x = pk_h2(o[mt][0] * inv, o[mt][1] * inv); ww.y = pk_h2(o[mt][2] * inv, o[mt][3] * inv); *(u32x2*)(op + 16 * mt) = ww; } }
        }
        PSEC_END(3);
        __syncthreads();
    }
    PSEC_END(4); PSEC_BURN(0, 4);
}

__device__ __forceinline__ void final_norm_phase(Frame& F) {
    const int gw = F.vcu * NWAVES + F.wave, NGW = F.G * NWAVES, lane = F.lane();
    const f32x4 g4[4] = {((const f32x4*)F.gf())[2 * lane], ((const f32x4*)F.gf())[2 * lane + 1], ((const f32x4*)F.gf())[128 + 2 * lane], ((const f32x4*)F.gf())[128 + 2 * lane + 1]};
    u32x4 hn[2][2]; f32x4 sn[2][4];
#define P9_LOAD(r0_) do { _Pragma("unroll") for (int q = 0; q < 2; ++q) { const int r_ = (r0_) + q * NGW; if (r_ < M) { \
        const u32x4* hr_ = (const u32x4*)(F.H2() + (size_t)r_ * D) + lane; hn[q][0] = hr_[0]; hn[q][1] = hr_[64];       \
        const f32x4* sp_ = (const f32x4*)(F.SSQ2() + (size_t)r_ * 16); sn[q][0] = sp_[0]; sn[q][1] = sp_[1]; sn[q][2] = sp_[2]; sn[q][3] = sp_[3]; } } } while (0)
    P9_LOAD(gw);
    for (int row = gw; row < M; row += 2 * NGW) {
        u32x4 hc[2][2]; f32x4 sc[2][4];
#pragma unroll
        for (int q = 0; q < 2; ++q) { hc[q][0] = hn[q][0]; hc[q][1] = hn[q][1]; sc[q][0] = sn[q][0]; sc[q][1] = sn[q][1]; sc[q][2] = sn[q][2]; sc[q][3] = sn[q][3]; }
        if (row + 2 * NGW < M) P9_LOAD(row + 2 * NGW);
#pragma unroll
        for (int q = 0; q < 2; ++q) { const int r = row + q * NGW; if (r < M) {
            const f32x4 t = (sc[q][0] + sc[q][1]) + (sc[q][2] + sc[q][3]);
            const float rs = __builtin_amdgcn_rsqf(((t[0] + t[1]) + (t[2] + t[3])) * (1.0f / 1024.0f) + EPS);
            f32x4* orow = (f32x4*)(F.out() + (size_t)r * D);
#pragma unroll
            for (int j = 0; j < 2; ++j) { const h16x8 h = __builtin_bit_cast(h16x8, hc[q][j]);
                orow[128 * j + 2 * lane] = (f32x4){(float)h[0], (float)h[1], (float)h[2], (float)h[3]} * rs * g4[2 * j];
                orow[128 * j + 2 * lane + 1] = (f32x4){(float)h[4], (float)h[5], (float)h[6], (float)h[7]} * rs * g4[2 * j + 1]; } } }
    }
#undef P9_LOAD
}

#ifndef MK_N_LAUNCHES
#define MK_N_LAUNCHES 1
#endif
constexpr int N_PHASES = 10;
__global__ void __launch_bounds__(NWAVES * 64, 2) fwd_kernel(Args args) {
    extern __shared__ __attribute__((aligned(16))) unsigned char lds_raw[];
    Frame F(args);
    F.lds = (LAS unsigned char*)lds_raw;
    F.wave = __builtin_amdgcn_readfirstlane((int)threadIdx.x >> 6);
    F.G = gridDim.x; { const int bx = blockIdx.x; F.vcu = (F.G % 8 == 0) ? (bx % 8) * (F.G / 8) + bx / 8 : bx; }
    unsigned char* ws = args.ws;
    F.ws = ws;
    for (int u = F.tid(); u < (LDS_BYTES - LDSCTL_OFF) / 4; u += NWAVES * 64) ((LAS unsigned*)(F.lds + LDSCTL_OFF))[u] = 0u;
    __syncthreads();
    XcdBarrier bar; bar.bar = (unsigned*)(ws + WS_CTL) + CW_BAR; bar.x = 0; bar.st = nullptr;
    if (MK_N_LAUNCHES == 1) bar = xcd_barrier_post((unsigned*)(ws + WS_CTL) + CW_BAR, (volatile LAS unsigned*)(F.lds + MISC_OFF) + 8, F.wave);
    const int lo = args.ph_lo, hi = args.ph_hi;
#ifndef PHMASK
#define PHMASK 0x3ff
#endif
#define IN(k) ((((PHMASK) >> (k)) & 1) && lo <= (k) && (k) < hi)
#ifdef PROBE_PH
    unsigned long long ppt0_ = 0ull, ppacc_ = 0ull;
#define SEAM(k) do { if ((k) + 1 == PROBE_PH) { if (IN(k) && IN((k) + 1)) xcd_barrier(bar); ppt0_ = __builtin_amdgcn_s_memtime(); } \
        else if ((k) == PROBE_PH) { if (IN(k) && IN((k) + 1)) xcd_barrier(bar); ppacc_ = __builtin_amdgcn_s_memtime() - ppt0_; } \
        else { if (IN(k) && IN((k) + 1)) xcd_barrier(bar); } } while (0)
    if (PROBE_PH == 0) ppt0_ = __builtin_amdgcn_s_memtime();
#else
#define SEAM(k) do { if (MK_N_LAUNCHES == 1) { if (IN(k) && IN((k) + 1)) xcd_barrier(bar); } } while (0)
#endif

    if (IN(0)) { p0_prologue(F); } SEAM(0);
    if (IN(1)) {
        pg8::Gemm g{F.XH(), F.Win_t(), M, DINP, D}; pg8::StaticOrder S; S.init(M, DINP, F.G, (int)blockIdx.x);
        EpiInProj E{F.RS1(), F.AQ(), F.AK(), F.AV(), F.BQ(), F.RAW4(), F.IQ(), F.GATES(), F.bg()};
        pg8::gemm_phase<EpiInProj, pg8::StaticOrder>(F.lds + RING_OFF, g, S, E, F.wave);
    } SEAM(1);
    if (IN(2)) {
#ifndef NO_NORMS
        p2_norms(F);
#endif
        { pg8::Gemm g{F.BQ(), F.Wqabs_t(), M, 1024, 256}; pg8::StaticOrder S; S.init(M, 1024, F.G, (int)blockIdx.x);
          EpiH16 E{F.QABS(), 1024};
          pg8::gemm_phase<EpiH16, pg8::StaticOrder>(F.lds + RING_OFF, g, S, E, F.wave); }
    } SEAM(2);
    if (IN(3)) {
#ifndef NO_ATTN_A
        attn_a_phase(F);
#endif
#ifndef NO_MIXER_B
        mixer_b_phase(F);
#endif
    } SEAM(3);
    if (IN(4)) {
        { pg8::Gemm g{F.OA(), F.Wa_t(), M, D, 512}; pg8::StaticOrder S; S.init(M, D, F.G, (int)blockIdx.x);
          EpiGate<false> E{F.GATES(), F.MIXED()};
          pg8::gemm_phase<EpiGate<false>, pg8::StaticOrder>(F.lds + RING_OFF, g, S, E, F.wave); }
        { pg8::Gemm g{F.LAT(), F.Wuvb_t(), M, D, 1024}; pg8::StaticOrder S; S.init(M, D, F.G, (int)blockIdx.x);
          EpiGate<true> E{F.GATES() + 1024, F.MIXED()};
          pg8::gemm_phase<EpiGate<true>, pg8::StaticOrder>(F.lds + RING_OFF, g, S, E, F.wave); }
    } SEAM(4);
    if (IN(6)) {
        pg8::Gemm g{F.MIXED(), F.Wo_t(), M, D, D}; pg8::StaticOrder S; S.init(M, D, F.G, (int)blockIdx.x);
        EpiWo E{F.x(), F.H1(), F.SSQ1()};
        pg8::gemm_phase<EpiWo, pg8::StaticOrder>(F.lds + RING_OFF, g, S, E, F.wave);
    } SEAM(6);
    if (IN(7)) {
        pg8::Gemm g{F.H1(), F.Wgu_t(), M, NGU, D}; pg8::StaticOrder S; S.init(M, NGU, F.G, (int)blockIdx.x);
        {
            int last_pm = -1;
            for (int i = 0; ; ++i) { pg8::Unit u; if (!S.next(i, u)) break; if (u.pm == last_pm) continue; last_pm = u.pm;
                if (F.tid() < 256) { const int row = u.pm * 256 + F.tid(); F.RS2()[row] = row_rs16(F.SSQ1() + (size_t)row * 16); } }
            asm volatile("s_waitcnt vmcnt(0)" ::: "memory"); __syncthreads();
            __builtin_amdgcn_fence(__ATOMIC_ACQUIRE, "agent"); asm volatile("s_waitcnt vmcnt(0)" ::: "memory"); __syncthreads();
        }
        EpiSwiGLU E{F.RS2(), F.ACT()};
        pg8::gemm_phase<EpiSwiGLU, pg8::StaticOrder>(F.lds + RING_OFF, g, S, E, F.wave);
    } SEAM(7);
    if (IN(8)) {
        pg8::Gemm g{F.ACT(), F.Wd_t(), M, D, DFF}; pg8::StaticOrder S; S.init(M, D, F.G, (int)blockIdx.x);
        EpiDown E{F.H1(), F.H2(), F.SSQ2()};
        pg8::gemm_phase<EpiDown, pg8::StaticOrder>(F.lds + RING_OFF, g, S, E, F.wave);
    } SEAM(8);
    if (IN(9)) { final_norm_phase(F); }
#ifdef PROBE_PH
    if (PROBE_PH == 9) { asm volatile("s_waitcnt vmcnt(0)" ::: "memory"); ppacc_ = __builtin_amdgcn_s_memtime() - ppt0_; }
    if (blockIdx.x == 0) { const unsigned long long te = __builtin_amdgcn_s_memtime() + ppacc_; while (__builtin_amdgcn_s_memtime() < te) __builtin_amdgcn_s_sleep(8); }
#endif
#undef IN
#undef SEAM
}

extern "C" void kernel_launch(void* const* d_in, const int* in_sizes, int n_in, void* d_out, int out_size, void* d_ws, size_t ws_size, hipStream_t stream) {
    static int grid = 0;
    if (grid == 0) {
        if (n_in != 22 || in_sizes[0] != M * D || out_size != M * D || ws_size < WS_END) {
            fprintf(stderr, "kernel_launch: built for 22 inputs, x/out of %d floats, >= %zu bytes of workspace; got n_in %d, in0 %d, out %d, ws %zu; nothing launched\n", M * D, (size_t)WS_END, n_in, n_in > 0 ? in_sizes[0] : -1, out_size, ws_size);
            grid = -1; return; }
        int dev = 0, cus = 0, per_cu = 0;
        if (hipGetDevice(&dev) != hipSuccess || hipDeviceGetAttribute(&cus, hipDeviceAttributeMultiprocessorCount, dev) != hipSuccess) { fprintf(stderr, "kernel_launch: device query failed\n"); grid = -1; return; }
        if (hipFuncSetAttribute((const void*)fwd_kernel, hipFuncAttributeMaxDynamicSharedMemorySize, LDS_BYTES) != hipSuccess) { fprintf(stderr, "kernel_launch: hipFuncSetAttribute failed\n"); grid = -1; return; }
        if (hipOccupancyMaxActiveBlocksPerMultiprocessor(&per_cu, (const void*)fwd_kernel, NWAVES * 64, LDS_BYTES) != hipSuccess || per_cu < 1)
            fprintf(stderr, "kernel_launch: note: occupancy query reports %d workgroups per CU\n", per_cu);
        (void)hipGetLastError();
        grid = cus;
    }
    if (grid < 0) return;
    if (hipMemsetAsync((char*)d_ws + WS_CTL, 0, CTL_ZERO_BYTES, stream) != hipSuccess) { fprintf(stderr, "kernel_launch: hipMemsetAsync failed\n"); return; }
    Args a{};
    for (int i = 0; i < 22; ++i) a.in[i] = (const float*)d_in[i];
    a.out = (float*)d_out; a.ws = (unsigned char*)d_ws;
    for (int li = 0; li < MK_N_LAUNCHES; ++li) {
        a.ph_lo = (MK_N_LAUNCHES == 1) ? 0 : li; a.ph_hi = (MK_N_LAUNCHES == 1) ? N_PHASES : li + 1;
        hipLaunchKernelGGL(fwd_kernel, dim3(grid), dim3(NWAVES * 64), LDS_BYTES, stream, a);
        const hipError_t le = hipPeekAtLastError();
        if (le != hipSuccess) { fprintf(stderr, "kernel_launch: launch %d failed: %s\n", li, hipGetErrorName(le)); break; }
    }
}
```

```cpp
#include <hip/hip_runtime.h>
#include <cstdio>
#include <cstdint>

#define LAS __attribute__((address_space(3)))
#define GAS __attribute__((address_space(1)))
typedef unsigned short h16;
typedef _Float16 h16x8 __attribute__((ext_vector_type(8)));
typedef _Float16 h16x4 __attribute__((ext_vector_type(4)));
typedef _Float16 h16x2 __attribute__((ext_vector_type(2)));
typedef float f32x4 __attribute__((ext_vector_type(4)));
typedef float f32x16 __attribute__((ext_vector_type(16)));
typedef unsigned u32x4 __attribute__((ext_vector_type(4)));
typedef unsigned u32x2 __attribute__((ext_vector_type(2)));
typedef short s16x4 __attribute__((ext_vector_type(4)));

constexpr int BATCH = 32, SEQ = 2048, D = 1024, NPAD = 112, NMETA = 16, BLK = 128, P = BLK + SEQ  , NBLK = P / BLK  ;
constexpr int M = BATCH * SEQ;
constexpr int DIN = 3524, DINP = 3584, DFF = 2816, NGU = 2 * DFF  ;
constexpr int TOPK = 256;
constexpr float EPS = 1e-6f, LOG2E = 1.4426950408889634f;
constexpr float QSCALE = 0.125f * LOG2E;

__device__ __forceinline__ unsigned pk_h2(float lo, float hi) { h16x2 v = {(_Float16)lo, (_Float16)hi}; return __builtin_bit_cast(unsigned, v); }
__device__ __forceinline__ u32x4 pk_h8(f32x4 a, f32x4 b) { u32x4 w; w.x = pk_h2(a[0], a[1]); w.y = pk_h2(a[2], a[3]); w.z = pk_h2(b[0], b[1]); w.w = pk_h2(b[2], b[3]); return w; }
__device__ __forceinline__ float h2f(h16 v) { return (float)__builtin_bit_cast(_Float16, v); }
__device__ __forceinline__ h16x4 ds_tr16a(const LAS unsigned char* p) { return __builtin_bit_cast(h16x4, __builtin_amdgcn_ds_read_tr16_b64_v4i16((LAS s16x4*)p)); }
__device__ __forceinline__ float sigmoidf_fast(float x) { return __builtin_amdgcn_rcpf(1.0f + __builtin_amdgcn_exp2f(-LOG2E * x)); }

#ifndef PROBE_WG
#define PROBE_WG 0
#endif
#ifdef PROBE_SEC
#define PSEC_DECL unsigned long long pt0_ = 0ull, pacc_ = 0ull; (void)pt0_; (void)pacc_
#define PSEC_BEGIN(id) do { if ((id) == PROBE_SEC) { asm volatile("s_waitcnt vmcnt(0) lgkmcnt(0)" ::: "memory"); pt0_ = __builtin_amdgcn_s_memtime(); } } while (0)
#define PSEC_END(id) do { if ((id) == PROBE_SEC) { asm volatile("s_waitcnt vmcnt(0) lgkmcnt(0)" ::: "memory"); pacc_ += __builtin_amdgcn_s_memtime() - pt0_; } } while (0)
#define PSEC_BURN(lo, hi) do { if (PROBE_SEC >= (lo) && PROBE_SEC <= (hi) && (PROBE_WG < 0 || blockIdx.x == PROBE_WG)) { const unsigned long long te_ = __builtin_amdgcn_s_memtime() + pacc_; \
        while (__builtin_amdgcn_s_memtime() < te_) __builtin_amdgcn_s_sleep(8); } } while (0)
#else
#define PSEC_DECL do {} while (0)
#define PSEC_BEGIN(id) do {} while (0)
#define PSEC_END(id) do {} while (0)
#define PSEC_BURN(lo, hi) do {} while (0)
#endif
__device__ __forceinline__ int lane_id_v() { int l; asm volatile("v_mbcnt_lo_u32_b32 %0, -1, 0\n\tv_mbcnt_hi_u32_b32 %0, -1, %0" : "=v"(l)); return l; }
__device__ __forceinline__ float xor16_sum(float q) { float a = q, b = q; asm volatile("v_nop\n\tv_nop\n\tv_permlane16_swap_b32 %0, %1" : "+v"(a), "+v"(b)); return a + b; }
__device__ __forceinline__ float xor32_sum(float q) { float a = q, b = q; asm volatile("v_nop\n\tv_nop\n\tv_permlane32_swap_b32 %0, %1" : "+v"(a), "+v"(b)); return a + b; }
template <int CTRL> __device__ __forceinline__ float dpp_f(float v) { return __builtin_bit_cast(float, __builtin_amdgcn_update_dpp(0, __builtin_bit_cast(int, v), CTRL, 0xf, 0xf, true)); }
__device__ __forceinline__ float row16_sum(float v) { v += dpp_f<0xB1>(v); v += dpp_f<0x4E>(v); v += dpp_f<0x141>(v); v += dpp_f<0x140>(v); return v; }
__device__ __forceinline__ float wave_sum_all(float v) { return xor32_sum(xor16_sum(row16_sum(v))); }
__device__ __forceinline__ float relu1(float x) { const int b = __builtin_bit_cast(int, x); return __builtin_bit_cast(float, b > 0 ? b : 0); }
namespace pg8 {
constexpr int BM = 256, BK = 64, HALF = 128, HTB = HALF * BK * 2  , STAGE_BYTES = 8 * HTB, NXCD = 8, WGM = 8;
__host__ __device__ __forceinline__ int lds_byte(int r, int c) { const int st = (r >> 4) * 2 + (c >> 5), rr = r & 15, cc = c & 31, ob = rr * 64 + cc * 2; return st * 1024 + (ob ^ (((ob >> 9) & 1) << 5)); }
__host__ __device__ __forceinline__ void stage_rc(int b, int& R, int& C) { const int st = b / 1024, sb = b % 1024, swz = sb ^ (((sb >> 9) & 1) << 5); R = (st >> 1) * 16 + swz / 64; C = (st & 1) * 32 + (swz % 64) / 2; }
__host__ __device__ __forceinline__ int perm32(int rho) { const int n = rho >> 4, i = rho & 15; return 8 * (i >> 2) + 4 * n + (i & 3); }

struct Unit { int pm, pn; };
struct Gemm { const h16* A; const h16* Bt; int M, N, K; };

struct StaticOrder {
    int nM, nN, nwg, G, c;
    __host__ __device__ __forceinline__ void init(int M_, int N_, int G_, int c_) { nM = M_ / BM; nN = N_ / BM; nwg = nM * nN; G = G_; c = c_; }
    __host__ __device__ __forceinline__ bool next(int i, Unit& u) const {
        const long L = (long)i * G + c; if (L >= nwg) return false;
        int wgid = (int)L; { const int q = nwg / NXCD, r = nwg % NXCD, xcd = wgid % NXCD, off = wgid / NXCD; wgid = (xcd < r ? xcd * (q + 1) : r * (q + 1) + (xcd - r) * q) + off; }
        const int nig = WGM * nN, gid = wgid / nig, fm = gid * WGM, gsz = (nM - fm) < WGM ? (nM - fm) : WGM;
        u.pm = fm + ((wgid % nig) % gsz); u.pn = (wgid % nig) / gsz; return true;
    }
    __device__ __forceinline__ void a_ready(const Unit&) const {}
    __device__ __forceinline__ void done(const Unit&) const {}
};

template <class Epi, class Sched, bool ALIGN_EPI = true, bool SP2 = true>
__device__ __forceinline__ void gemm_phase(LAS unsigned char* lds, const Gemm g, const Sched& S, const Epi& E, const int wid) {
    const int lane = lane_id_v(), tid = wid * 64 + lane, wr = wid >> 2, wc = wid & 3, fr = lane & 15, fq = lane >> 4;
    int K = g.K; asm volatile("" : "+s"(K));
    const int nt = K / BK;
    unsigned voffA[2], voffB[2];
#pragma unroll
    for (int i = 0; i < 2; ++i) { int R, C; stage_rc(tid * 16 + i * 8192, R, C); const int Rb = (R & ~31) + perm32(R & 31);
        voffA[i] = (unsigned)(R * K + C) * 2u; voffB[i] = (unsigned)(Rb * K + C) * 2u; }
    const size_t kstep = (size_t)(BK * 2);
    const size_t hstep = (size_t)HALF * K * 2;
    const size_t tstep = 2 * hstep;
    const unsigned ldsw = (unsigned)wid * 1024u;
    const int aoff = lds_byte(wr * 64 + fr, fq * 8), boff = lds_byte(wc * 32 + fr, fq * 8);
#define PG8_SA(b, h) (((b) * 2 + (h)) * HTB)
#define PG8_SB(b, h) ((4 + (b) * 2 + (h)) * HTB)
#define PG8_STAGE(bufoff, gbase, voff) do { _Pragma("unroll") for (int _i = 0; _i < 2; ++_i) \
        __builtin_amdgcn_global_load_lds((const unsigned*)((const char*)(gbase) + (voff)[_i]), (LAS unsigned*)(lds + (bufoff) + ldsw + _i * 8192), 16, 0, 0); } while (0)
#define PG8_LDA(dst, b, h) do { _Pragma("unroll") for (int m = 0; m < 4; ++m) _Pragma("unroll") for (int k = 0; k < 2; ++k) dst[m][k] = *(const LAS h16x8*)(lds + PG8_SA(b, h) + aoff + m * 2048 + k * 1024); } while (0)
#define PG8_LDB(dst, b, h) do { _Pragma("unroll") for (int n = 0; n < 2; ++n) _Pragma("unroll") for (int k = 0; k < 2; ++k) dst[n][k] = *(const LAS h16x8*)(lds + PG8_SB(b, h) + boff + n * 2048 + k * 1024); } while (0)
#define PG8_MMA(ai, bj, At, Bt) do { __builtin_amdgcn_s_setprio(1); _Pragma("unroll") for (int m = 0; m < 4; ++m) _Pragma("unroll") for (int n = 0; n < 2; ++n) _Pragma("unroll") for (int k = 0; k < 2; ++k) \
        acc[ai][bj][m][n] = __builtin_amdgcn_mfma_f32_16x16x32_f16(Bt[n][k], At[m][k], acc[ai][bj][m][n], 0, 0, 0); __builtin_amdgcn_s_setprio(0); } while (0)
#define PG8_WAIT_V(n) asm volatile("s_waitcnt vmcnt(" #n ")" ::: "memory")
#define PG8_WAIT_L(n) asm volatile("s_waitcnt lgkmcnt(" #n ")" ::: "memory")
#define PG8_BAR __builtin_amdgcn_s_barrier()
#define PG8_SCHED __builtin_amdgcn_sched_barrier(0)
    PSEC_DECL;
    Unit cur, nxt; int ui = 0;
    if (!S.next(0, cur)) return;
    f32x4 acc[2][2][4][2];
#pragma unroll
    for (int a = 0; a < 2; ++a)
#pragma unroll
        for (int b = 0; b < 2; ++b)
#pragma unroll
            for (int m = 0; m < 4; ++m)
#pragma unroll
                for (int n = 0; n < 2; ++n) acc[a][b][m][n] = (f32x4){0.f, 0.f, 0.f, 0.f};
    h16x8 At[4][2], B0[2][2], B1[2][2];
    const char* cA = (const char*)g.A + (size_t)cur.pm * tstep; const char* cB = (const char*)g.Bt + (size_t)cur.pn * tstep;
    S.a_ready(cur);
    typename Epi::Pre pre_cur = E.pre(cur, wr, wc, fr, fq), pre_nxt = pre_cur;
    if constexpr (SP2) {
        PG8_STAGE(PG8_SB(0, 0), cB, voffB); PG8_STAGE(PG8_SB(0, 1), cB + hstep, voffB); PG8_STAGE(PG8_SA(0, 0), cA, voffA); PG8_STAGE(PG8_SA(0, 1), cA + hstep, voffA);
        if (wr == 1) PG8_BAR;
        PG8_WAIT_V(2); PG8_BAR;
        PG8_STAGE(PG8_SB(1, 0), cB + kstep, voffB); PG8_STAGE(PG8_SA(1, 0), cA + kstep, voffA); PG8_STAGE(PG8_SB(1, 1), cB + hstep + kstep, voffB);
        PG8_WAIT_V(6); PG8_BAR;
    } else {
        PG8_STAGE(PG8_SB(0, 0), cB, voffB); PG8_STAGE(PG8_SA(0, 0), cA, voffA); PG8_STAGE(PG8_SB(0, 1), cB + hstep, voffB); PG8_STAGE(PG8_SA(0, 1), cA + hstep, voffA);
        if (wr == 1) PG8_BAR;
        PG8_WAIT_V(4); PG8_BAR;
        PG8_STAGE(PG8_SB(1, 0), cB + kstep, voffB); PG8_STAGE(PG8_SA(1, 0), cA + kstep, voffA); PG8_STAGE(PG8_SB(1, 1), cB + hstep + kstep, voffB);
        PG8_WAIT_V(6); PG8_BAR;
    }
    for (;;) {
        const bool has_next = S.next(ui + 1, nxt);
        const char* nA = has_next ? (const char*)g.A + (size_t)nxt.pm * tstep : cA; const char* nB = has_next ? (const char*)g.Bt + (size_t)nxt.pn * tstep : cB;
        for (int t = 0; t < nt; t += 2) {
            const bool last = (t == nt - 2);
            const char* a1 = cA + (size_t)(t + 1) * kstep;
            const char* a2 = last ? nA : cA + (size_t)(t + 2) * kstep; const char* b2 = last ? nB : cB + (size_t)(t + 2) * kstep;
            const char* a3 = a2 + kstep; const char* b3 = b2 + kstep;
            if (last && has_next) { S.a_ready(nxt); pre_nxt = E.pre(nxt, wr, wc, fr, fq); }
            if constexpr (SP2) {
            PG8_LDB(B0, 0, 0); PG8_LDB(B1, 0, 1); PG8_SCHED; PG8_LDA(At, 0, 0); PG8_STAGE(PG8_SA(1, 1), a1 + hstep, voffA);
            PG8_WAIT_V(8); PG8_WAIT_L(0); PG8_BAR; PG8_MMA(0, 0, At, B0); PG8_MMA(0, 1, At, B1); PG8_BAR; PG8_SCHED;
            PG8_LDA(At, 0, 1); PG8_STAGE(PG8_SB(0, 0), b2, voffB); PG8_STAGE(PG8_SB(0, 1), b2 + hstep, voffB); PG8_STAGE(PG8_SA(0, 0), a2, voffA);
            PG8_WAIT_V(8); PG8_WAIT_L(0); PG8_BAR; PG8_MMA(1, 0, At, B0); PG8_MMA(1, 1, At, B1); PG8_BAR; PG8_SCHED;
            PG8_LDB(B0, 1, 0); PG8_LDB(B1, 1, 1); PG8_SCHED; PG8_LDA(At, 1, 0); PG8_STAGE(PG8_SA(0, 1), a2 + hstep, voffA);
            PG8_WAIT_V(8); PG8_WAIT_L(0); PG8_BAR; PG8_MMA(0, 0, At, B0); PG8_MMA(0, 1, At, B1); PG8_BAR; PG8_SCHED;
            PG8_LDA(At, 1, 1); PG8_STAGE(PG8_SB(1, 0), b3, voffB); PG8_STAGE(PG8_SB(1, 1), b3 + hstep, voffB); PG8_STAGE(PG8_SA(1, 0), a3, voffA);
            PG8_WAIT_V(8); PG8_WAIT_L(0); PG8_BAR; PG8_MMA(1, 0, At, B0); PG8_MMA(1, 1, At, B1); PG8_BAR; PG8_SCHED;
            } else {
            PG8_LDB(B0, 0, 0); PG8_SCHED; PG8_LDA(At, 0, 0); PG8_STAGE(PG8_SA(1, 1), a1 + hstep, voffA);
            PG8_WAIT_L(8); PG8_BAR; PG8_WAIT_L(0); PG8_MMA(0, 0, At, B0); PG8_BAR; PG8_SCHED;
            PG8_LDB(B1, 0, 1); PG8_STAGE(PG8_SB(0, 0), b2, voffB);
            PG8_BAR; PG8_WAIT_L(0); PG8_MMA(0, 1, At, B1); PG8_BAR;
            PG8_LDA(At, 0, 1); PG8_STAGE(PG8_SA(0, 0), a2, voffA);
            PG8_BAR; PG8_WAIT_L(0); PG8_MMA(1, 0, At, B0); PG8_BAR; PG8_SCHED;
            PG8_STAGE(PG8_SB(0, 1), b2 + hstep, voffB);
            PG8_WAIT_V(6); PG8_BAR; PG8_MMA(1, 1, At, B1); PG8_BAR;
            PG8_LDB(B0, 1, 0); PG8_SCHED; PG8_LDA(At, 1, 0); PG8_STAGE(PG8_SA(0, 1), a2 + hstep, voffA);
            PG8_WAIT_L(8); PG8_BAR; PG8_WAIT_L(0); PG8_MMA(0, 0, At, B0); PG8_BAR; PG8_SCHED;
            PG8_LDB(B1, 1, 1); PG8_STAGE(PG8_SB(1, 0), b3, voffB);
            PG8_BAR; PG8_WAIT_L(0); PG8_MMA(0, 1, At, B1); PG8_BAR;
            PG8_LDA(At, 1, 1); PG8_STAGE(PG8_SA(1, 0), a3, voffA);
            PG8_BAR; PG8_WAIT_L(0); PG8_MMA(1, 0, At, B0); PG8_BAR; PG8_SCHED;
            PG8_STAGE(PG8_SB(1, 1), b3 + hstep, voffB);
            PG8_WAIT_V(6); PG8_BAR; PG8_MMA(1, 1, At, B1); PG8_BAR;
            }
        }
        if constexpr (ALIGN_EPI) { if (wr == 0) PG8_BAR; }
        PSEC_BEGIN(40); E(acc, cur, pre_cur, wr, wc, fr, fq); PSEC_END(40); S.done(cur);
        if (!has_next) break;
#pragma unroll
        for (int a = 0; a < 2; ++a)
#pragma unroll
            for (int b = 0; b < 2; ++b)
#pragma unroll
                for (int m = 0; m < 4; ++m)
#pragma unroll
                    for (int n = 0; n < 2; ++n) acc[a][b][m][n] = (f32x4){0.f, 0.f, 0.f, 0.f};
        cur = nxt; cA = nA; cB = nB; ++ui; pre_cur = pre_nxt;
        if constexpr (ALIGN_EPI) { if (wr == 1) PG8_BAR; }
    }
    PG8_WAIT_V(0);
    if constexpr (!ALIGN_EPI) { if (wr == 0) PG8_BAR; }
    PG8_BAR;
    PSEC_BURN(40, 40);
#undef PG8_SA
#undef PG8_SB
#undef PG8_STAGE
#undef PG8_LDA
#undef PG8_LDB
#undef PG8_MMA
#undef PG8_WAIT_V
#undef PG8_WAIT_L
#undef PG8_BAR
#undef PG8_SCHED
}
}

struct PreNone {};
struct PreRows { float rs[8]; };
#define EPI_NOPRE typedef PreNone Pre; __device__ __forceinline__ Pre pre(const pg8::Unit&, int, int, int, int) const { return Pre{}; }
#define EPI_ROWS _Pragma("unroll") for (int ai = 0; ai < 2; ++ai) _Pragma("unroll") for (int m = 0; m < 4; ++m)
#define EPI_BJ _Pragma("unroll") for (int bj = 0; bj < 2; ++bj)
__device__ __forceinline__ void ld_h8(const h16* p, f32x4& a, f32x4& b) { const u32x4 w = *(const u32x4*)p; const h16x8 h = __builtin_bit_cast(h16x8, w);
    a = (f32x4){(float)h[0], (float)h[1], (float)h[2], (float)h[3]}; b = (f32x4){(float)h[4], (float)h[5], (float)h[6], (float)h[7]}; }
__device__ __forceinline__ float ssq8(const f32x4& v0, const f32x4& v1) { return ((v0[0] * v0[0] + v0[1] * v0[1]) + (v0[2] * v0[2] + v0[3] * v0[3])) + ((v1[0] * v1[0] + v1[1] * v1[1]) + (v1[2] * v1[2] + v1[3] * v1[3])); }

struct EpiInProj {
    const float* rs1; h16* AQ; h16* AK; h16* AV; h16* BQ; float* RAW4; h16* IQ; unsigned char* GATES; const float* bg;
    typedef PreRows Pre;
    __device__ __forceinline__ Pre pre(const pg8::Unit& u, int wr, int wc, int fr, int fq) const { Pre p; const int row0 = u.pm * 256 + wr * 64 + fr;
        _Pragma("unroll") for (int ai = 0; ai < 2; ++ai) _Pragma("unroll") for (int m = 0; m < 4; ++m) p.rs[ai * 4 + m] = rs1[row0 + ai * 128 + m * 16]; return p; }
    __device__ __forceinline__ void operator()(const f32x4 (&acc)[2][2][4][2], const pg8::Unit& u, const Pre& P_, int wr, int wc, int fr, int fq) const {
        int ct = wc * 32 + 8 * fq; asm volatile("" : "+v"(ct));
        const int pn = u.pn, row0 = u.pm * 256 + wr * 64 + fr;
        if (pn >= 6) {
            const int gc0 = (pn - 6) * 256 + ct;
            f32x4 b[2][2];
            EPI_BJ { b[bj][0] = *(const f32x4*)(bg + gc0 + bj * 128) * -LOG2E - 7.994353436858858f; b[bj][1] = *(const f32x4*)(bg + gc0 + bj * 128 + 4) * -LOG2E - 7.994353436858858f; }
            EPI_ROWS { const int row = row0 + ai * 128 + m * 16; const float s = P_.rs[ai * 4 + m] * -LOG2E; unsigned char* rp = GATES + (size_t)row * 2048 + gc0;
                EPI_BJ { f32x4 v0 = acc[ai][bj][m][0] * s + b[bj][0], v1 = acc[ai][bj][m][1] * s + b[bj][1];
                    unsigned q0[4], q1[4];
                    _Pragma("unroll") for (int e = 0; e < 4; ++e) { q0[e] = (unsigned)(__builtin_amdgcn_rcpf(__builtin_amdgcn_exp2f(v0[e]) + (1.0f / 255.0f)) + 0.5f);
                        q1[e] = (unsigned)(__builtin_amdgcn_rcpf(__builtin_amdgcn_exp2f(v1[e]) + (1.0f / 255.0f)) + 0.5f); }
                    u32x2 w; w.x = q0[0] | (q0[1] << 8) | (q0[2] << 16) | (q0[3] << 24); w.y = q1[0] | (q1[1] << 8) | (q1[2] << 16) | (q1[3] << 24);
                    *(u32x2*)(rp + bj * 128) = w; } }
        } else if (pn == 4) {
            EPI_ROWS { const int row = row0 + ai * 128 + m * 16; const float s = P_.rs[ai * 4 + m]; float* rp = RAW4 + (size_t)row * 256 + ct;
                EPI_BJ { *(f32x4*)(rp + bj * 128) = acc[ai][bj][m][0] * s; *(f32x4*)(rp + bj * 128 + 4) = acc[ai][bj][m][1] * s; } }
        } else if (pn == 2) {
            EPI_ROWS { const int row = row0 + ai * 128 + m * 16; const float s = P_.rs[ai * 4 + m]; const size_t prow = (size_t)(row >> 11) * P + BLK + (row & 2047);
                *(u32x4*)(AK + prow * 128 + ct) = pk_h8(acc[ai][0][m][0] * s, acc[ai][0][m][1] * s);
                *(u32x4*)(AV + prow * 128 + ct) = pk_h8(acc[ai][1][m][0] * s, acc[ai][1][m][1] * s); }
        } else {
            h16* base = pn < 2 ? AQ + pn * 256 : (pn == 3 ? BQ : IQ); const int ld = pn < 2 ? 512 : 256;
            EPI_ROWS { const int row = row0 + ai * 128 + m * 16; const float s = P_.rs[ai * 4 + m]; h16* rp = base + (size_t)row * ld + ct;
                EPI_BJ *(u32x4*)(rp + bj * 128) = pk_h8(acc[ai][bj][m][0] * s, acc[ai][bj][m][1] * s); }
        }
    }
};
struct EpiH16 {
    h16* O; int ldc;
    EPI_NOPRE
    __device__ __forceinline__ void operator()(const f32x4 (&acc)[2][2][4][2], const pg8::Unit& u, const Pre&, int wr, int wc, int fr, int fq) const {
        const int row0 = u.pm * 256 + wr * 64 + fr, col0 = u.pn * 256 + wc * 32 + 8 * fq;
        EPI_ROWS { const int row = row0 + ai * 128 + m * 16; h16* rp = O + (size_t)row * ldc + col0;
            EPI_BJ *(u32x4*)(rp + bj * 128) = pk_h8(acc[ai][bj][m][0], acc[ai][bj][m][1]); }
    }
};
template <bool ACCUM> struct EpiGate {
    const unsigned char* G; h16* O;
    EPI_NOPRE
    __device__ __forceinline__ void operator()(const f32x4 (&acc)[2][2][4][2], const pg8::Unit& u, const Pre&, int wr, int wc, int fr, int fq) const {
        const int row0 = u.pm * 256 + wr * 64 + fr, col0 = u.pn * 256 + wc * 32 + 8 * fq;
#pragma unroll
        for (int ai = 0; ai < 2; ++ai) {
            u32x2 gwv[4][2]; u32x4 tmv[4][2];
#pragma unroll
            for (int m = 0; m < 4; ++m) { const int row = row0 + ai * 128 + m * 16; const unsigned char* gp = G + (size_t)row * 2048 + col0; const h16* rp = O + (size_t)row * 1024 + col0;
                EPI_BJ { gwv[m][bj] = *(const u32x2*)(gp + bj * 128); if (ACCUM) tmv[m][bj] = *(const u32x4*)(rp + bj * 128); } }
            asm volatile("" ::: "memory");
#pragma unroll
            for (int m = 0; m < 4; ++m) { const int row = row0 + ai * 128 + m * 16; h16* rp = O + (size_t)row * 1024 + col0;
                EPI_BJ { const u32x2 gw = gwv[m][bj];
                    const f32x4 g0 = (f32x4){(float)(gw.x & 255u), (float)((gw.x >> 8) & 255u), (float)((gw.x >> 16) & 255u), (float)(gw.x >> 24)} * (1.0f / 255.0f);
                    const f32x4 g1 = (f32x4){(float)(gw.y & 255u), (float)((gw.y >> 8) & 255u), (float)((gw.y >> 16) & 255u), (float)(gw.y >> 24)} * (1.0f / 255.0f);
                    f32x4 v0 = acc[ai][bj][m][0] * g0, v1 = acc[ai][bj][m][1] * g1;
                    if (ACCUM) { const h16x8 h = __builtin_bit_cast(h16x8, tmv[m][bj]);
                        v0 += (f32x4){(float)h[0], (float)h[1], (float)h[2], (float)h[3]}; v1 += (f32x4){(float)h[4], (float)h[5], (float)h[6], (float)h[7]}; }
                    *(u32x4*)(rp + bj * 128) = pk_h8(v0, v1); } }
            asm volatile("" ::: "memory");
        }
    }
};
struct EpiWo {
    const h16* XHp; h16* H1; float* SSQ;
    EPI_NOPRE
    __device__ __forceinline__ void operator()(const f32x4 (&acc)[2][2][4][2], const pg8::Unit& u, const Pre&, int wr, int wc, int fr, int fq) const {
        const int row0 = u.pm * 256 + wr * 64 + fr, col0 = u.pn * 256 + wc * 32 + 8 * fq;
        u32x4 xv[2][4][2];
        EPI_ROWS { const h16* xp = XHp + (size_t)(row0 + ai * 128 + m * 16) * 1024 + col0; EPI_BJ xv[ai][m][bj] = *(const u32x4*)(xp + bj * 128); }
        asm volatile("" ::: "memory");
        EPI_ROWS { const int row = row0 + ai * 128 + m * 16; h16* rp = H1 + (size_t)row * 1024 + col0; float q = 0.f;
            EPI_BJ { const h16x8 h = __builtin_bit_cast(h16x8, xv[ai][m][bj]);
                const f32x4 v0 = acc[ai][bj][m][0] + (f32x4){(float)h[0], (float)h[1], (float)h[2], (float)h[3]}, v1 = acc[ai][bj][m][1] + (f32x4){(float)h[4], (float)h[5], (float)h[6], (float)h[7]};
                q += ssq8(v0, v1); *(u32x4*)(rp + bj * 128) = pk_h8(v0, v1); }
            q = xor32_sum(xor16_sum(q));
            if (fq == 0) SSQ[(size_t)row * 16 + u.pn * 4 + wc] = q; }
    }
};
__device__ __forceinline__ float row_rs16(const float* ssq_row) {
    const f32x4* sp = (const f32x4*)ssq_row; const f32x4 s0 = sp[0], s1 = sp[1], s2 = sp[2], s3 = sp[3];
    const float ss = (((s0[0] + s0[1]) + (s0[2] + s0[3])) + ((s1[0] + s1[1]) + (s1[2] + s1[3]))) + (((s2[0] + s2[1]) + (s2[2] + s2[3])) + ((s3[0] + s3[1]) + (s3[2] + s3[3])));
    return __builtin_amdgcn_rsqf(ss * (1.0f / 1024.0f) + EPS);
}
struct EpiSwiGLU {
    const float* RS2; h16* ACT;
    typedef PreRows Pre;
    __device__ __forceinline__ Pre pre(const pg8::Unit& u, int wr, int wc, int fr, int fq) const { Pre p; const int row0 = u.pm * 256 + wr * 64 + fr;
        _Pragma("unroll") for (int ai = 0; ai < 2; ++ai) _Pragma("unroll") for (int m = 0; m < 4; ++m) p.rs[ai * 4 + m] = RS2[row0 + ai * 128 + m * 16]; return p; }
    __device__ __forceinline__ void operator()(const f32x4 (&acc)[2][2][4][2], const pg8::Unit& u, const Pre& P_, int wr, int wc, int fr, int fq) const {
        const int row0 = u.pm * 256 + wr * 64 + fr, col0 = u.pn * 128 + wc * 32 + 8 * fq;
        EPI_ROWS { const int row = row0 + ai * 128 + m * 16; const float rs = P_.rs[ai * 4 + m], nrs = -LOG2E * rs, v = __builtin_amdgcn_rcpf(rs * rs);
            f32x4 o[2];
            _Pragma("unroll") for (int n = 0; n < 2; ++n)
                _Pragma("unroll") for (int e = 0; e < 4; ++e) { const float ag = acc[ai][0][m][n][e], au = acc[ai][1][m][n][e];
                    const float ex = __builtin_amdgcn_exp2f(ag * nrs); o[n][e] = (ag * au) * __builtin_amdgcn_rcpf(ex * v + v); }
            *(u32x4*)(ACT + (size_t)row * DFF + col0) = pk_h8(o[0], o[1]); }
    }
};
struct EpiDown {
    const h16* H1; h16* H2; float* SSQ;
    EPI_NOPRE
    __device__ __forceinline__ void operator()(const f32x4 (&acc)[2][2][4][2], const pg8::Unit& u, const Pre&, int wr, int wc, int fr, int fq) const {
        const int row0 = u.pm * 256 + wr * 64 + fr, col0 = u.pn * 256 + wc * 32 + 8 * fq;
        u32x4 hv[2][4][2];
        EPI_ROWS { const h16* hp = H1 + (size_t)(row0 + ai * 128 + m * 16) * 1024 + col0; EPI_BJ hv[ai][m][bj] = *(const u32x4*)(hp + bj * 128); }
        asm volatile("" ::: "memory");
        EPI_ROWS { const int row = row0 + ai * 128 + m * 16; h16* rp = H2 + (size_t)row * 1024 + col0; float q = 0.f;
            EPI_BJ { const h16x8 h = __builtin_bit_cast(h16x8, hv[ai][m][bj]);
                const f32x4 v0 = acc[ai][bj][m][0] + (f32x4){(float)h[0], (float)h[1], (float)h[2], (float)h[3]}, v1 = acc[ai][bj][m][1] + (f32x4){(float)h[4], (float)h[5], (float)h[6], (float)h[7]};
                q += ssq8(v0, v1); *(u32x4*)(rp + bj * 128) = pk_h8(v0, v1); }
            q = xor32_sum(xor16_sum(q));
            if (fq == 0) SSQ[(size_t)row * 16 + u.pn * 4 + wc] = q; }
    }
};

constexpr size_t MiB = 1u << 20;
constexpr size_t WS_CTL = 0, CTL_ZERO_BYTES = 65536;
constexpr size_t WS_WIN = 2 * MiB, WS_WQABS = 9 * MiB, WS_WA = 10 * MiB, WS_WUVB = 11 * MiB, WS_WO = 13 * MiB, WS_WGU = 15 * MiB, WS_WD = 26 * MiB;
constexpr size_t WS_RS1 = 32 * MiB, WS_RSQ = WS_RS1 + 256 * 1024, WS_RS2 = WS_RS1 + 512 * 1024, WS_IWS = 33 * MiB, WS_SSQ1 = 34 * MiB, WS_SSQ2 = 38 * MiB, WS_METAP = 42 * MiB, WS_TBL = WS_METAP + 512 * 1024;
constexpr size_t KVROWS = (size_t)BATCH * P;
constexpr size_t WS_AK = 44 * MiB, WS_AV = 61 * MiB, WS_CKV = 78 * MiB, WS_IKN = 95 * MiB;
constexpr size_t WS_OA = 104 * MiB, WS_GATES = 168 * MiB  , WS_H2 = 296 * MiB  ;
constexpr size_t WS_AQ = 424 * MiB, WS_BQ = 488 * MiB, WS_IQ = 520 * MiB, WS_H1 = 424 * MiB;
constexpr size_t WS_XH = WS_H2  , WS_MIXED = 552 * MiB, WS_QABS = 680 * MiB, WS_RAW4 = 808 * MiB, WS_LAT = 808 * MiB, WS_ACT = 552 * MiB, WS_END = 936 * MiB;
static_assert(WS_WIN + (size_t)DINP * D * 2 <= WS_WQABS && WS_WGU + (size_t)NGU * D * 2 <= WS_WD && WS_WD + (size_t)D * DFF * 2 <= WS_RS1, "weights map");
static_assert(WS_AK + KVROWS * 256 <= WS_AV && WS_CKV + KVROWS * 256 <= WS_IKN && WS_IKN + KVROWS * 128 <= WS_OA, "kv map");
static_assert(WS_ACT + (size_t)M * DFF * 2 <= WS_END && WS_LAT + (size_t)M * 1024 * 2 <= WS_END && WS_TBL + 16 * 132 * 4 <= WS_AK, "act map");
constexpr int CW_TMO = 0, CW_ATTN = 2048  , CW_BAR = 4096;
constexpr int TBLW = 132;

constexpr int RING_OFF = 0, RING_BYTES = 131072;
constexpr int LDSCTL_OFF = RING_BYTES, MISC_OFF = LDSCTL_OFF + 320;
constexpr int LDS_BYTES = 163840;
constexpr int NWAVES = 8;

#define RLX_AGENT __ATOMIC_RELAXED, __HIP_MEMORY_SCOPE_AGENT
#define LDS_WAIT() asm volatile("s_waitcnt lgkmcnt(0)" ::: "memory")
#define VM_WAIT() asm volatile("s_waitcnt vmcnt(0)" ::: "memory")

#define XB_TMO      128
#define XB_XCNT(j)  (256  + 64 * (j))
#define XB_XSUB(j)  (1280 + 64 * (j))
#define XB_XGEN(j)  (2304 + 64 * (j))
#define XB_TOP      3328
#define XB_TOPGEN   3392
#define XCD_BAR_WORDS 3456
#define XB_SPIN_CAP (1u << 18)
__device__ __forceinline__ unsigned xb_ld(unsigned* p)              { return __hip_atomic_load(p, __ATOMIC_RELAXED, __HIP_MEMORY_SCOPE_AGENT); }
__device__ __forceinline__ unsigned xb_add(unsigned* p, unsigned v) { return __hip_atomic_fetch_add(p, v, __ATOMIC_RELAXED, __HIP_MEMORY_SCOPE_AGENT); }
__device__ __forceinline__ unsigned xb_xcc_id() { return (unsigned)__builtin_amdgcn_s_getreg((3 << 11) | 20) & 0xFu; }
#define XB_SPIN(cond, bar) do { unsigned _sp = 0; while (cond) { __builtin_amdgcn_s_sleep(1); \
    if ((++_sp & 255u) == 0u) { if (xb_ld(&(bar)[XB_TMO])) break; if (_sp > XB_SPIN_CAP) { atomicAdd(&(bar)[XB_TMO], 1u); break; } } } } while (0)
struct XcdBarrier { unsigned* bar; unsigned x; volatile LAS unsigned* st; int wave; };
__device__ __forceinline__ XcdBarrier xcd_barrier_post(unsigned* bar, volatile LAS unsigned* st, int wave) {
    XcdBarrier b; b.bar = bar; b.x = xb_xcc_id(); b.st = st; b.wave = wave;
    if (wave == 0 && lane_id_v() == 0) (void)xb_add(&bar[XB_XCNT(b.x)], 1u);
    return b;
}
__device__ __forceinline__ void xcd_barrier_complete(unsigned* bar, unsigned x, unsigned& nloc, unsigned& nx) {
    const unsigned G = gridDim.x * gridDim.y * gridDim.z;
    unsigned sum, cnt, mine, sp = 0u;
    for (;;) {
        sum = 0u; cnt = 0u; mine = 0u;
#pragma unroll
        for (unsigned j = 0; j < 16; ++j) { const unsigned c = xb_ld(&bar[XB_XCNT(j)]); sum += c; cnt += (c > 0u) ? 1u : 0u; mine = (j == x) ? c : mine; }
        if (sum == G) break;
        __builtin_amdgcn_s_sleep(1);
        if ((++sp & 255u) == 0u) { if (xb_ld(&bar[XB_TMO])) break; if (sp > XB_SPIN_CAP) { atomicAdd(&bar[XB_TMO], 1u); break; } }
    }
    nloc = mine > 0u ? mine : 1u; nx = cnt > 0u ? cnt : 1u;
}
__device__ __forceinline__ void xcd_barrier(const XcdBarrier& b) {
    asm volatile("s_waitcnt vmcnt(0)" ::: "memory");
    __syncthreads();
    if (b.wave == 0 && lane_id_v() == 0) {
        unsigned* bar = b.bar;
        __builtin_amdgcn_s_waitcnt(0);
        unsigned nloc = b.st[0], nx = b.st[1];
        if (nloc == 0u) { xcd_barrier_complete(bar, b.x, nloc, nx); b.st[0] = nloc; b.st[1] = nx; }
        const unsigned old = xb_add(&bar[XB_XSUB(b.x)], 1u);
        const unsigned gen = old / nloc;
        if (old + 1u == (gen + 1u) * nloc) {
            __builtin_amdgcn_fence(__ATOMIC_RELEASE, "agent");
            asm volatile("s_waitcnt vmcnt(0)" ::: "memory");
            const unsigned og = xb_add(&bar[XB_TOP], 1u);
            const unsigned tg = og / nx;
            if (og + 1u == (tg + 1u) * nx) xb_add(&bar[XB_TOPGEN], 1u);
            else XB_SPIN(xb_ld(&bar[XB_TOPGEN]) == tg, bar);
            __builtin_amdgcn_fence(__ATOMIC_ACQUIRE, "agent");
            xb_add(&bar[XB_XGEN(b.x)], 1u);
            asm volatile("s_waitcnt vmcnt(0)" ::: "memory");
        } else {
            XB_SPIN(xb_ld(&bar[XB_XGEN(b.x)]) == gen, bar);
            __builtin_amdgcn_fence(__ATOMIC_ACQUIRE, "agent");
            asm volatile("s_waitcnt vmcnt(0)" ::: "memory");
        }
    }
    __syncthreads();
}

struct Args { const float* in[22]; float* out; unsigned char* ws; int ph_lo, ph_hi; };
struct Frame {
    const Args& A;
    __device__ __forceinline__ Frame(const Args& a) : A(a) {}
    LAS unsigned char* lds;
    int wave, vcu, G;
    __device__ __forceinline__ int lane() const { return lane_id_v(); }
    __device__ __forceinline__ int tid() const { return wave * 64 + lane_id_v(); }
    __device__ __forceinline__ const float* x() const { return A.in[0]; }
    __device__ __forceinline__ const float* meta() const { return A.in[1]; }
    __device__ __forceinline__ const float* g1() const { return A.in[2]; }
    __device__ __forceinline__ const float* w_in() const { return A.in[3]; }
    __device__ __forceinline__ const float* bg() const { return A.in[4]; }
    __device__ __forceinline__ const float* qg() const { return A.in[5]; }
    __device__ __forceinline__ const float* kvg() const { return A.in[6]; }
    __device__ __forceinline__ const float* w_uq() const { return A.in[7]; }
    __device__ __forceinline__ const float* w_uk() const { return A.in[8]; }
    __device__ __forceinline__ const float* w_uv() const { return A.in[9]; }
    __device__ __forceinline__ const float* lng() const { return A.in[10]; }
    __device__ __forceinline__ const float* lnb() const { return A.in[11]; }
    __device__ __forceinline__ const float* sinks() const { return A.in[12]; }
    __device__ __forceinline__ const float* relb() const { return A.in[13]; }
    __device__ __forceinline__ const float* w_a() const { return A.in[14]; }
    __device__ __forceinline__ const float* w_b() const { return A.in[15]; }
    __device__ __forceinline__ const float* w_o() const { return A.in[16]; }
    __device__ __forceinline__ const float* g2() const { return A.in[17]; }
    __device__ __forceinline__ const float* w_g() const { return A.in[18]; }
    __device__ __forceinline__ const float* w_u() const { return A.in[19]; }
    __device__ __forceinline__ const float* w_d() const { return A.in[20]; }
    __device__ __forceinline__ const float* gf() const { return A.in[21]; }
    __device__ __forceinline__ float* out() const { return A.out; }
    unsigned char* ws;
    __device__ __forceinline__ h16* Win_t() const { return (h16*)(ws + WS_WIN); }
    __device__ __forceinline__ h16* Wqabs_t() const { return (h16*)(ws + WS_WQABS); }
    __device__ __forceinline__ h16* Wa_t() const { return (h16*)(ws + WS_WA); }
    __device__ __forceinline__ h16* Wuvb_t() const { return (h16*)(ws + WS_WUVB); }
    __device__ __forceinline__ h16* Wo_t() const { return (h16*)(ws + WS_WO); }
    __device__ __forceinline__ h16* Wgu_t() const { return (h16*)(ws + WS_WGU); }
    __device__ __forceinline__ h16* Wd_t() const { return (h16*)(ws + WS_WD); }
    __device__ __forceinline__ h16* H2() const { return (h16*)(ws + WS_H2); }
    __device__ __forceinline__ h16* AK() const { return (h16*)(ws + WS_AK); }
    __device__ __forceinline__ h16* AV() const { return (h16*)(ws + WS_AV); }
    __device__ __forceinline__ h16* CKV() const { return (h16*)(ws + WS_CKV); }
    __device__ __forceinline__ h16* IKN() const { return (h16*)(ws + WS_IKN); }
    __device__ __forceinline__ h16* OA() const { return (h16*)(ws + WS_OA); }
    __device__ __forceinline__ h16* AQ() const { return (h16*)(ws + WS_AQ); }
    __device__ __forceinline__ h16* BQ() const { return (h16*)(ws + WS_BQ); }
    __device__ __forceinline__ h16* IQ() const { return (h16*)(ws + WS_IQ); }
    __device__ __forceinline__ h16* H1() const { return (h16*)(ws + WS_H1); }
    __device__ __forceinline__ h16* XH() const { return (h16*)(ws + WS_XH); }
    __device__ __forceinline__ h16* MIXED() const { return (h16*)(ws + WS_MIXED); }
    __device__ __forceinline__ h16* QABS() const { return (h16*)(ws + WS_QABS); }
    __device__ __forceinline__ h16* LAT() const { return (h16*)(ws + WS_LAT); }
    __device__ __forceinline__ h16* ACT() const { return (h16*)(ws + WS_ACT); }
    __device__ __forceinline__ float* RS2() const { return (float*)(ws + WS_RS2); }
    __device__ __forceinline__ float* RS1() const { return (float*)(ws + WS_RS1); }
    __device__ __forceinline__ float* RSQ() const { return (float*)(ws + WS_RSQ); }
    __device__ __forceinline__ float* IWS() const { return (float*)(ws + WS_IWS); }
    __device__ __forceinline__ float* SSQ1() const { return (float*)(ws + WS_SSQ1); }
    __device__ __forceinline__ float* SSQ2() const { return (float*)(ws + WS_SSQ2); }
    __device__ __forceinline__ float* METAP() const { return (float*)(ws + WS_METAP); }
    __device__ __forceinline__ float* TBL() const { return (float*)(ws + WS_TBL); }
    __device__ __forceinline__ float* RAW4() const { return (float*)(ws + WS_RAW4); }
    __device__ __forceinline__ unsigned char* GATES() const { return ws + WS_GATES; }
};
__device__ __forceinline__ float wave_sum(float v) { return wave_sum_all(v); }

__device__ __forceinline__ int inmap(int n) {
    if (n < 1152) return n;
    if (n < 1216) return 1408 + (n - 1152);
    if (n < 1220) return 1472 + (n - 1216);
    if (n < 1280) return -1;
    if (n < 1536) return 1152 + (n - 1280);
    return 1476 + (n - 1536);
}
template <int MODE> __device__ __forceinline__ void p0_transpose_item(const float* W, const float* W2, int ldw, int K, int N, const float* gain, h16* WT, LAS float* scr, int item, int lane) {
    const int nblk = N / 32, kb = item / nblk, nb = item % nblk, k0 = 64 * kb, n0 = 32 * nb;
    const int n4 = n0 + 4 * (lane & 7), kr = lane >> 3;
    const float* src = W; int oc = n4; float cs = 1.f;
    if (MODE == 0) { oc = inmap(n4); if (n4 < 512) cs = QSCALE; }
    if (MODE == 3) { const int pp = n4 >> 8, j = n4 & 255; oc = 128 * pp + (j & 127); src = (j < 128) ? W : W2; }
    f32x4 v[8];
#pragma unroll
    for (int i = 0; i < 8; ++i) { const int kk = 8 * i + kr; v[i] = (f32x4){0.f, 0.f, 0.f, 0.f}; if (oc >= 0) v[i] = *(const f32x4*)(src + (size_t)(k0 + kk) * ldw + oc); }
#pragma unroll
    for (int i = 0; i < 8; ++i) { const int kk = 8 * i + kr; const float gsc = (gain ? gain[k0 + kk] : 1.f) * cs;
#pragma unroll
        for (int e = 0; e < 4; ++e) scr[kk * 33 + 4 * (lane & 7) + e] = v[i][e] * gsc; }
    LDS_WAIT(); asm volatile("" ::: "memory");
    const int c = lane & 7;
#pragma unroll
    for (int j = 0; j < 4; ++j) { const int nn = (lane >> 3) + 8 * j; const LAS float* sp = scr + (8 * c) * 33 + nn;
        u32x4 o; o.x = pk_h2(sp[0 * 33], sp[1 * 33]); o.y = pk_h2(sp[2 * 33], sp[3 * 33]); o.z = pk_h2(sp[4 * 33], sp[5 * 33]); o.w = pk_h2(sp[6 * 33], sp[7 * 33]);
        *(u32x4*)(WT + (size_t)(n0 + nn) * K + k0 + 8 * c) = o; }
    LDS_WAIT(); asm volatile("" ::: "memory");
}
__device__ __forceinline__ int t5_bucket_d(int dist) {
    if (dist < 16) return dist;
    int large = 16 + (int)(log((double)dist / 16.0) / log(8.0) * 16.0);
    return large < 31 ? large : 31;
}
__device__ __forceinline__ void p0_prologue(Frame& F) {
    PSEC_DECL; PSEC_BEGIN(10);
    LAS float* scr = (LAS float*)(F.lds + RING_OFF + F.wave * 16384);
    const int gw = F.vcu * NWAVES + F.wave, NGW = F.G * NWAVES;
    constexpr int I_IN = (D / 64) * (DINP / 32), I_A = (512 / 64) * (D / 32), I_O = (D / 64) * (D / 32), I_GU = (D / 64) * (NGU / 32), I_D = (DFF / 64) * (D / 32);
    constexpr int I_QABS = 1024 * 4, I_UVB = 8 * 16 * 8, I_META = 7 * 8, I_TBL = 1;
    for (int it = gw; it < I_META; it += NGW) {
        const int lane = F.lane();
        int r = it;
        if (r < I_META) {
            const int cg = r >> 3, kc = r & 7, ci = cg * 64 + lane;
            const int oc = ci < 128 ? 512 + ci : (ci < 256 ? 640 + (ci - 128) : (ci < 384 ? 1024 + (ci - 256) : 1408 + (ci - 384)));
#pragma unroll 1
            for (int hf = 0; hf < 2; ++hf) {
                f32x4 mv[4], gv[4];
#pragma unroll
                for (int e4 = 0; e4 < 4; ++e4) { const int idx4 = (4 * hf + e4) * 64 + lane, q = idx4 >> 5, kk4 = idx4 & 31;
                    mv[e4] = *(const f32x4*)(F.meta() + q * 1024 + kc * 128 + 4 * kk4); gv[e4] = *(const f32x4*)(F.g1() + kc * 128 + 4 * kk4); }
#pragma unroll
                for (int e4 = 0; e4 < 4; ++e4) { const int idx4 = (4 * hf + e4) * 64 + lane, q = idx4 >> 5, kk4 = idx4 & 31;
#pragma unroll
                    for (int e = 0; e < 4; ++e) scr[(4 * kk4 + e) * 16 + q] = mv[e4][e] * gv[e4][e]; }
            }
            LDS_WAIT(); asm volatile("" ::: "memory");
            float a[16];
#pragma unroll
            for (int q = 0; q < 16; ++q) a[q] = 0.f;
            const float* wp = F.w_in() + (size_t)(kc * 128) * DIN + oc;
#pragma unroll 1
            for (int kb = 0; kb < 128; kb += 16) {
                float wv_[16];
#pragma unroll
                for (int kk = 0; kk < 16; ++kk) wv_[kk] = wp[(size_t)(kb + kk) * DIN];
#pragma unroll
                for (int kk = 0; kk < 16; ++kk) { const LAS f32x4* mp = (const LAS f32x4*)(scr + (kb + kk) * 16);
#pragma unroll
                    for (int q4 = 0; q4 < 4; ++q4) { const f32x4 m4 = mp[q4];
#pragma unroll
                        for (int e = 0; e < 4; ++e) a[4 * q4 + e] += m4[e] * wv_[kk]; }
                    if ((kk & 3) == 3) asm volatile("" ::: "memory"); } }
#pragma unroll
            for (int q = 0; q < 16; ++q) F.METAP()[(size_t)(kc * 16 + q) * 448 + ci] = a[q];
            LDS_WAIT(); asm volatile("" ::: "memory");
            continue; }
    }
    for (int it = gw; it < I_IN + I_A + I_O + I_GU + I_D; it += NGW) {
        const int lane = F.lane();
        int r = it;
        if (r < I_IN) { p0_transpose_item<0>(F.w_in(), nullptr, DIN, D, DINP, F.g1(), F.Win_t(), scr, r, lane); continue; } r -= I_IN;
        if (r < I_A) { p0_transpose_item<1>(F.w_a(), nullptr, D, 512, D, nullptr, F.Wa_t(), scr, r, lane); continue; } r -= I_A;
        if (r < I_O) { p0_transpose_item<1>(F.w_o(), nullptr, D, D, D, nullptr, F.Wo_t(), scr, r, lane); continue; } r -= I_O;
        if (r < I_GU) { p0_transpose_item<3>(F.w_g(), F.w_u(), DFF, D, NGU, F.g2(), F.Wgu_t(), scr, r, lane); continue; } r -= I_GU;
        if (r < I_D) { p0_transpose_item<1>(F.w_d(), nullptr, D, DFF, D, nullptr, F.Wd_t(), scr, r, lane); continue; }
    }
    for (int it = gw; it < I_QABS; it += NGW) {
        const int lane = F.lane();
        int r = it;
        if (r < I_QABS) {
            const int n = r >> 2, rr = (r & 3) * 64 + lane, h = n >> 7, c = n & 127;
            const f32x4* uq = (const f32x4*)(F.w_uq() + (size_t)rr * 512 + h * 64); const __attribute__((address_space(4))) f32x4* uk = (const __attribute__((address_space(4))) f32x4*)(F.w_uk() + (size_t)c * 512 + h * 64);
            float a = 0.f;
#pragma unroll 8
            for (int d = 0; d < 16; ++d) { const f32x4 p = uq[d], q = uk[d]; a += (p[0] * q[0] + p[1] * q[1]) + (p[2] * q[2] + p[3] * q[3]); }
            F.Wqabs_t()[(size_t)n * 256 + rr] = __builtin_bit_cast(h16, (_Float16)(a * QSCALE * F.qg()[rr]));
            continue; }
    }
    for (int it = (gw + NGW / 2) % NGW; it < I_UVB; it += NGW) {
        const int lane = F.lane();
        int r = it;
        if (r < I_UVB) {
            const int h = r >> 7, cg = (r >> 6) & 1, ng = r & 63, c = cg * 64 + lane, n0 = ng * 16;
            const f32x4* uvp = (const f32x4*)(F.w_uv() + (size_t)c * 512 + h * 64);
            f32x4 uv4[16];
#pragma unroll
            for (int d4 = 0; d4 < 16; ++d4) uv4[d4] = uvp[d4];
            const f32x4* wbp = (const f32x4*)(F.w_b() + (size_t)(h * 64 + lane) * 1024 + n0);
            const f32x4 wv0 = wbp[0], wv1 = wbp[1], wv2 = wbp[2], wv3 = wbp[3];
            { LAS f32x4* sp = (LAS f32x4*)scr + lane * 4; sp[0] = wv0; sp[1] = wv1; sp[2] = wv2; sp[3] = wv3; }
            LDS_WAIT(); asm volatile("" ::: "memory");
            float a[16];
#pragma unroll
            for (int q = 0; q < 16; ++q) a[q] = 0.f;
#pragma unroll
            for (int d4 = 0; d4 < 16; ++d4) {
#pragma unroll
                for (int e = 0; e < 4; ++e) { const LAS f32x4* rp = (const LAS f32x4*)scr + (4 * d4 + e) * 4; const f32x4 w0 = rp[0], w1 = rp[1], w2 = rp[2], w3 = rp[3]; const float u = uv4[d4][e];
#pragma unroll
                    for (int q = 0; q < 4; ++q) { a[q] += u * w0[q]; a[4 + q] += u * w1[q]; a[8 + q] += u * w2[q]; a[12 + q] += u * w3[q]; } }
                asm volatile("" ::: "memory"); }
            h16* op = F.Wuvb_t() + (size_t)n0 * 1024 + h * 128 + c;
#pragma unroll
            for (int q = 0; q < 16; ++q) op[(size_t)q * 1024] = __builtin_bit_cast(h16, (_Float16)a[q]);
            continue; }
    }
    if (gw >= NGW - 3) {
        const int dd = 64 * (NGW - 1 - gw) + F.lane();
        if (dd < 129) { const int bk = t5_bucket_d(dd);
#pragma unroll
            for (int hh = 0; hh < 16; ++hh) F.TBL()[hh * TBLW + dd] = LOG2E * F.relb()[bk * 16 + hh]; }
    }
    PSEC_END(10); PSEC_BEGIN(11);
    const int lane = F.lane();
    f32x4 vn[8], vm[8];
    if (2 * gw < M) { const f32x4* xr = (const f32x4*)(F.x() + (size_t)(2 * gw) * D) + lane;
#pragma unroll
        for (int j = 0; j < 8; ++j) vn[j] = xr[64 * j]; }
    if (2 * gw + 2 * NGW < M) { const f32x4* xr = (const f32x4*)(F.x() + (size_t)(2 * gw + 2 * NGW) * D) + lane;
#pragma unroll
        for (int j = 0; j < 8; ++j) vm[j] = xr[64 * j]; }
    for (int row = 2 * gw; row < M; row += 2 * NGW) {
        f32x4 v[8]; float s0 = 0.f, s1 = 0.f;
#pragma unroll
        for (int j = 0; j < 8; ++j) { v[j] = vn[j]; vn[j] = vm[j]; }
        if (row + 4 * NGW < M) { const f32x4* xr = (const f32x4*)(F.x() + (size_t)(row + 4 * NGW) * D) + lane;
#pragma unroll
            for (int j = 0; j < 8; ++j) vm[j] = xr[64 * j]; }
#pragma unroll
        for (int j = 0; j < 4; ++j) { s0 += (v[j][0] * v[j][0] + v[j][1] * v[j][1]) + (v[j][2] * v[j][2] + v[j][3] * v[j][3]);
            s1 += (v[j + 4][0] * v[j + 4][0] + v[j + 4][1] * v[j + 4][1]) + (v[j + 4][2] * v[j + 4][2] + v[j + 4][3] * v[j + 4][3]); }
        s0 = wave_sum_all(s0); s1 = wave_sum_all(s1);
        if (lane == 0) { F.RS1()[row] = 1.0f / sqrtf(s0 * (1.0f / D) + EPS); F.RS1()[row + 1] = 1.0f / sqrtf(s1 * (1.0f / D) + EPS); }
        u32x2* o8 = (u32x2*)(F.XH() + (size_t)row * D) + lane;
#pragma unroll
        for (int j = 0; j < 8; ++j) { u32x2 w; w.x = pk_h2(v[j][0], v[j][1]); w.y = pk_h2(v[j][2], v[j][3]); o8[64 * j] = w; }
    }
    PSEC_END(11); PSEC_BURN(10, 11);
}

__device__ __forceinline__ void p2_norms(Frame& F) {
    PSEC_DECL; PSEC_BEGIN(20);
    const int gw = F.vcu * NWAVES + F.wave, NGW = F.G * NWAVES, lane = F.lane();
    const float kg0 = F.kvg()[2 * lane], kg1 = F.kvg()[2 * lane + 1], lg = F.lng()[lane], lb = F.lnb()[lane];
    float nb0[4], nb1[4], nik[4], niw[4]; u32x2 nqw[4];
#define P2_LOAD(r4_) do { _Pragma("unroll") for (int u = 0; u < 4; ++u) { const float* rw = F.RAW4() + (size_t)((r4_) + u) * 256; \
            nb0[u] = rw[2 * lane]; nb1[u] = rw[2 * lane + 1]; nik[u] = rw[128 + lane]; niw[u] = rw[192 + (lane & 3)]; \
            nqw[u] = ((const u32x2*)(F.BQ() + (size_t)((r4_) + u) * 256))[lane]; } } while (0)
    if (4 * gw < M) P2_LOAD(4 * gw);
    for (int row4 = 4 * gw; row4 < M; row4 += 4 * NGW) {
        float b0[4], b1[4], ik[4], q0[4], q1[4], q2[4], q3[4], iw[4];
#pragma unroll
        for (int u = 0; u < 4; ++u) { b0[u] = nb0[u]; b1[u] = nb1[u]; ik[u] = nik[u]; iw[u] = niw[u]; const h16x4 qh = __builtin_bit_cast(h16x4, nqw[u]);
            q0[u] = (float)qh[0]; q1[u] = (float)qh[1]; q2[u] = (float)qh[2]; q3[u] = (float)qh[3]; }
        if (row4 + 4 * NGW < M) P2_LOAD(row4 + 4 * NGW);
        float sb[4], si[4], sq[4];
#pragma unroll
        for (int u = 0; u < 4; ++u) { sb[u] = b0[u] * b0[u] + b1[u] * b1[u]; si[u] = ik[u]; sq[u] = (q0[u] * q0[u] + q1[u] * q1[u]) + (q2[u] * q2[u] + q3[u] * q3[u]); }
#pragma unroll
        for (int u = 0; u < 4; ++u) { sb[u] = wave_sum_all(sb[u]); si[u] = wave_sum_all(si[u]); sq[u] = wave_sum_all(sq[u]); }
        float dc[4], sv[4];
#pragma unroll
        for (int u = 0; u < 4; ++u) { dc[u] = ik[u] - si[u] * (1.0f / 64.0f); sv[u] = dc[u] * dc[u]; }
#pragma unroll
        for (int u = 0; u < 4; ++u) sv[u] = wave_sum_all(sv[u]);
#pragma unroll
        for (int u = 0; u < 4; ++u) { const int row = row4 + u; const size_t prow = (size_t)(row >> 11) * P + BLK + (row & 2047);
            const float rk = 1.0f / sqrtf(sb[u] * (1.0f / 128.0f) + EPS);
            ((unsigned*)(F.CKV() + prow * 128))[lane] = pk_h2(b0[u] * rk * kg0, b1[u] * rk * kg1);
            F.IKN()[prow * 64 + lane] = __builtin_bit_cast(h16, (_Float16)(dc[u] * (1.0f / sqrtf(sv[u] * (1.0f / 64.0f) + EPS)) * lg + lb));
            if (lane < 4) F.IWS()[(size_t)row * 4 + lane] = iw[u] * 0.0625f;
            if (lane == 0) F.RSQ()[row] = 1.0f / sqrtf(sq[u] * (1.0f / 256.0f) + EPS); }
    }
#undef P2_LOAD
    for (int it = gw; it < 16 * BATCH; it += NGW) {
        const int r = it & 15, b = it >> 4;
        float mv[16]; float s = 0.f;
#pragma unroll
        for (int k = 0; k < 16; ++k) mv[k] = F.meta()[r * 1024 + k * 64 + lane];
        float v[7], pa[7][8];
#pragma unroll
        for (int cg = 0; cg < 7; ++cg)
#pragma unroll
            for (int kc = 0; kc < 8; ++kc) pa[cg][kc] = F.METAP()[(size_t)(kc * 16 + r) * 448 + cg * 64 + lane];
#pragma unroll
        for (int k = 0; k < 16; ++k) s += mv[k] * mv[k];
        const float rsm = 1.0f / sqrtf(wave_sum(s) * (1.0f / D) + EPS);
#pragma unroll
        for (int cg = 0; cg < 7; ++cg) { float a = 0.f;
#pragma unroll
            for (int kc = 0; kc < 8; ++kc) a += pa[cg][kc];
            v[cg] = a * rsm; }
        const float rk = 1.0f / sqrtf(wave_sum(v[4] * v[4] + v[5] * v[5]) * (1.0f / 128.0f) + EPS);
        const float c0 = v[4] * rk * F.kvg()[lane], c1 = v[5] * rk * F.kvg()[64 + lane];
        const float mu = wave_sum(v[6]) * (1.0f / 64.0f), dc = v[6] - mu, var = wave_sum(dc * dc) * (1.0f / 64.0f);
        const float ikn = dc * (1.0f / sqrtf(var + EPS)) * lg + lb;
        const size_t prow = (size_t)b * P + NPAD + r;
        F.AK()[prow * 128 + lane] = __builtin_bit_cast(h16, (_Float16)v[0]); F.AK()[prow * 128 + 64 + lane] = __builtin_bit_cast(h16, (_Float16)v[1]);
        F.AV()[prow * 128 + lane] = __builtin_bit_cast(h16, (_Float16)v[2]); F.AV()[prow * 128 + 64 + lane] = __builtin_bit_cast(h16, (_Float16)v[3]);
        F.CKV()[prow * 128 + lane] = __builtin_bit_cast(h16, (_Float16)c0); F.CKV()[prow * 128 + 64 + lane] = __builtin_bit_cast(h16, (_Float16)c1);
        F.IKN()[prow * 64 + lane] = __builtin_bit_cast(h16, (_Float16)ikn);
    }
    for (int it = gw; it < BATCH * NPAD; it += NGW) { const size_t prow = (size_t)(it / NPAD) * P + (it % NPAD);
        ((unsigned*)(F.AK() + prow * 128))[lane] = 0u; ((unsigned*)(F.AV() + prow * 128))[lane] = 0u; ((unsigned*)(F.CKV() + prow * 128))[lane] = 0u;
        if (lane < 32) ((unsigned*)(F.IKN() + prow * 64))[lane] = 0u; }
    PSEC_END(20); PSEC_BURN(20, 20);
}

constexpr int A_KSTR = 144, A_LDS_K = 0, A_LDS_V = 256 * A_KSTR, A_LDS_TB = 2 * 256 * A_KSTR;
__device__ __forceinline__ void attn_a_phase(Frame& F) {
    PSEC_DECL; PSEC_BEGIN(5);
    LAS unsigned char* lds = F.lds;
    const int lane = F.lane(), w = F.wave, tid = F.tid(), q32 = lane & 31, hh = lane >> 5;
    const float NINF = -__builtin_inff();
    const int g = w & 3;
    const int nun = BATCH * 16 * 2;
    u32x4 kreg[4], vreg[4]; float tbreg = 0.f; h16x8 qn[2][4];
#define AA_LOAD(u_) do { const int kvh_ = (u_) & 1, blk_ = 1 + (((u_) >> 1) & 15), b_ = (u_) >> 5; const size_t kb_ = (size_t)b_ * P + (size_t)(blk_ - 1) * BLK; \
        _Pragma("unroll") for (int i = 0; i < 4; ++i) { const int id = i * 512 + tid, row = id >> 3, ch = id & 7; \
            kreg[i] = *(const u32x4*)(F.AK() + (kb_ + row) * 128 + kvh_ * 64 + ch * 8); vreg[i] = *(const u32x4*)(F.AV() + (kb_ + row) * 128 + kvh_ * 64 + ch * 8); } \
        tbreg = F.TBL()[(kvh_ * 4 + (tid >> 7)) * TBLW + (tid & 127)]; \
        _Pragma("unroll") for (int qq = 0; qq < 2; ++qq) { const size_t qrow_ = (size_t)b_ * SEQ + (size_t)(blk_ - 1) * BLK + ((w >> 2) * 2 + qq) * 32 + q32; \
            _Pragma("unroll") for (int ks = 0; ks < 4; ++ks) qn[qq][ks] = *(const h16x8*)(F.AQ() + qrow_ * 512 + (kvh_ * 4 + g) * 64 + ks * 16 + hh * 8); } } while (0)
    unsigned* actr = (unsigned*)(F.ws + WS_CTL) + CW_ATTN;
    volatile LAS int* slot = (volatile LAS int*)(lds + A_LDS_TB + 2048);
    int u = F.vcu, tok = nun;
    if (tid == 0) tok = F.G + (int)__hip_atomic_fetch_add(actr, 1u, __ATOMIC_RELAXED, __HIP_MEMORY_SCOPE_AGENT);
    if (u < nun) AA_LOAD(u);
    while (u < nun) {
        const int kvh = u & 1, blk = 1 + ((u >> 1) & 15), b = u >> 5;
        __syncthreads();
#pragma unroll
        for (int i = 0; i < 4; ++i) { const int id = i * 512 + tid, row = id >> 3, ch = id & 7;
            *(LAS u32x4*)(lds + A_LDS_K + row * A_KSTR + ch * 16) = kreg[i]; *(LAS u32x4*)(lds + A_LDS_V + row * A_KSTR + ch * 16) = vreg[i]; }
        ((LAS float*)(lds + A_LDS_TB))[tid] = tbreg;
        h16x8 qf[2][4];
#pragma unroll
        for (int qq = 0; qq < 2; ++qq)
#pragma unroll
            for (int ks = 0; ks < 4; ++ks) qf[qq][ks] = qn[qq][ks];
        if (tid == 0) { *slot = tok; tok = F.G + (int)__hip_atomic_fetch_add(actr, 1u, __ATOMIC_RELAXED, __HIP_MEMORY_SCOPE_AGENT); }
        __syncthreads();
        const int un = __builtin_amdgcn_readfirstlane(*slot);
        if (un < nun) AA_LOAD(un);
        const int head = kvh * 4 + g;
        const float sink = F.sinks()[head] * LOG2E;
        const LAS float* TB = (const LAS float*)(lds + A_LDS_TB) + g * 128;
        const unsigned vtr = (unsigned)(A_LDS_V + (4 * hh + ((lane & 15) >> 2)) * A_KSTR + (16 * ((lane >> 4) & 1) + 4 * (lane & 3)) * 2);
#pragma unroll 1
        for (int qq = 0; qq < 2; ++qq) {
            h16x8 qc[4];
            if (qq == 0) { qc[0] = qf[0][0]; qc[1] = qf[0][1]; qc[2] = qf[0][2]; qc[3] = qf[0][3]; } else { qc[0] = qf[1][0]; qc[1] = qf[1][1]; qc[2] = qf[1][2]; qc[3] = qf[1][3]; }
            const int qg = (w >> 2) * 2 + qq, i_loc = qg * 32 + q32;
            const size_t qrow = (size_t)b * SEQ + (size_t)(blk - 1) * BLK + i_loc;
            float m_run = sink, l_run = hh ? 0.f : 1.0f;
            f32x16 o0, o1;
#pragma unroll
            for (int r = 0; r < 16; ++r) { o0[r] = 0.f; o1[r] = 0.f; }
            for (int kt = qg; kt <= qg + 4; ++kt) {
                f32x16 sacc;
#pragma unroll
                for (int r = 0; r < 16; ++r) sacc[r] = 0.f;
#pragma unroll
                for (int ks = 0; ks < 4; ++ks) { const h16x8 kf = *(const LAS h16x8*)(lds + A_LDS_K + (kt * 32 + q32) * A_KSTR + (ks * 16 + hh * 8) * 2);
                    sacc = __builtin_amdgcn_mfma_f32_32x32x16_f16(kf, qc[ks], sacc, 0, 0, 0); }
                float mx = NINF;
                float bia[16];
                const bool edge = (kt == qg || kt == qg + 4 || blk == 1);
                if (edge) {
#pragma unroll
                    for (int r = 0; r < 16; ++r) { const int j = kt * 32 + (r & 3) + 8 * (r >> 2) + 4 * hh, dist = 128 + i_loc - j; bia[r] = TB[dist & 127]; }
                } else {
                    const LAS float* tp = TB + (128 + i_loc - kt * 32 - 4 * hh - 27);
#pragma unroll
                    for (int r = 0; r < 16; ++r) bia[r] = tp[27 - ((r & 3) + 8 * (r >> 2))];
                }
                if (edge) {
#pragma unroll
                    for (int r = 0; r < 16; ++r) { const int j = kt * 32 + (r & 3) + 8 * (r >> 2) + 4 * hh, dist = 128 + i_loc - j;
                        const bool valid = (dist >= 0) && (dist < 128) && ((blk - 1) * BLK + j >= NPAD);
                        const float v0 = sacc[r] + bia[r]; const float v = valid ? v0 : NINF; sacc[r] = v; mx = fmaxf(mx, v); }
                } else {
#pragma unroll
                    for (int r = 0; r < 16; ++r) { const float v = sacc[r] + bia[r]; sacc[r] = v; mx = fmaxf(mx, v); }
                }
                if (__any(mx > m_run + 8.0f)) {
                    mx = fmaxf(mx, __shfl_xor(mx, 32));
                    const float m_new = fmaxf(m_run, mx), alpha = __builtin_amdgcn_exp2f(m_run - m_new);
                    l_run *= alpha; m_run = m_new;
#pragma unroll
                    for (int r = 0; r < 16; ++r) { o0[r] *= alpha; o1[r] *= alpha; }
                }
                float ps = 0.f;
#pragma unroll
                for (int r = 0; r < 16; ++r) { const float p = __builtin_amdgcn_exp2f(sacc[r] - m_run); sacc[r] = p; ps += p; }
                l_run += ps;
#pragma unroll
                for (int sx = 0; sx < 2; ++sx) {
                    const u32x4 pw = {pk_h2(sacc[8 * sx], sacc[8 * sx + 1]), pk_h2(sacc[8 * sx + 2], sacc[8 * sx + 3]), pk_h2(sacc[8 * sx + 4], sacc[8 * sx + 5]), pk_h2(sacc[8 * sx + 6], sacc[8 * sx + 7])};
                    const h16x8 pf = __builtin_bit_cast(h16x8, pw);
                    const LAS unsigned char* vb = lds + vtr + (kt * 32 + 16 * sx) * A_KSTR;
                    const h16x4 a0l = ds_tr16a(vb), a0h = ds_tr16a(vb + 8 * A_KSTR), a1l = ds_tr16a(vb + 64), a1h = ds_tr16a(vb + 8 * A_KSTR + 64);
                    const h16x8 va0 = {a0l[0], a0l[1], a0l[2], a0l[3], a0h[0], a0h[1], a0h[2], a0h[3]}, va1 = {a1l[0], a1l[1], a1l[2], a1l[3], a1h[0], a1h[1], a1h[2], a1h[3]};
                    o0 = __builtin_amdgcn_mfma_f32_32x32x16_f16(va0, pf, o0, 0, 0, 0);
                    o1 = __builtin_amdgcn_mfma_f32_32x32x16_f16(va1, pf, o1, 0, 0, 0); }
            }
            l_run += __shfl_xor(l_run, 32);
            const float inv = 1.0f / l_run;
            h16* op = F.OA() + qrow * 512 + head * 64 + 4 * hh;
#pragma unroll
            for (int g4 = 0; g4 < 4; ++g4) {
                u32x2 w0, w1; w0.x = pk_h2(o0[4 * g4] * inv, o0[4 * g4 + 1] * inv); w0.y = pk_h2(o0[4 * g4 + 2] * inv, o0[4 * g4 + 3] * inv);
                w1.x = pk_h2(o1[4 * g4] * inv, o1[4 * g4 + 1] * inv); w1.y = pk_h2(o1[4 * g4 + 2] * inv, o1[4 * g4 + 3] * inv);
                *(u32x2*)(op + 8 * g4) = w0; *(u32x2*)(op + 32 + 8 * g4) = w1; }
        }
        u = un;
    }
#undef AA_LOAD
    __syncthreads();
    PSEC_END(5); PSEC_BURN(5, 5);
}

constexpr int L3_STAGE = 0  , L3_HIST = 0  , HROW = 260, L3_DUMMY = 32 * HROW * 4,
              L3_SEL = MISC_OFF + 704  , L3_RES = L3_SEL + 32 * 256 * 2, L3_CNT2 = L3_RES + 32 * 4 * 4, L3_TB = L3_CNT2 + 32 * 32 * 4, L3_END = L3_TB + 8 * TBLW * 4;
static_assert(L3_SEL >= MISC_OFF + 128 && L3_SEL % 16 == 0 && L3_END <= LDS_BYTES && L3_DUMMY % 16 == 0 && L3_DUMMY + 4096 <= RING_BYTES && 32 * HROW * 4 > 32768 && 32 * HROW * 4 <= 32768 + 1024 && L3_HIST == 0, "P3 LDS map");
__device__ __forceinline__ h16x4 ds_tr16(const LAS unsigned char* p) { return __builtin_bit_cast(h16x4, __builtin_amdgcn_ds_read_tr16_b64_v4i16((LAS s16x4*)p)); }
__device__ __forceinline__ void mixer_b_phase(Frame& F) {
    PSEC_DECL;
    LAS unsigned char* lds = F.lds;
    const int w = F.wave, tid = F.tid();
    const float NINF = -__builtin_inff();
    LAS unsigned short* SEL = (LAS unsigned short*)(lds + L3_SEL);
    LAS unsigned* HIST = (LAS unsigned*)(lds + L3_HIST);
    LAS unsigned* RES = (LAS unsigned*)(lds + L3_RES);
    LAS unsigned* CNT2 = (LAS unsigned*)(lds + L3_CNT2);
    LAS float* TB = (LAS float*)(lds + L3_TB);
    LAS unsigned char* stage = lds + L3_STAGE + w * 16384;
    __syncthreads();
    for (int e = tid; e < 8 * 130; e += 512) { const int hh = e / 130, dd = e % 130; TB[hh * TBLW + dd] = dd ? F.TBL()[(8 + hh) * TBLW + dd - 1] : NINF; }
    for (int e = F.tid(); e < 32 * HROW; e += 512) HIST[e] = 0u;
    __syncthreads();
    const int nunits = BATCH * 16 * 4;
    PSEC_BEGIN(4);
    for (int it = 0; ; ++it) {
        const int lane = F.lane();
        const int n16 = lane & 15, g = lane >> 4;
        int b, blk, sub;
        if (F.G == 256) {
            if (it >= 8) break; b = 4 * (F.vcu >> 5) + (F.vcu & 3); sub = (F.vcu >> 2) & 3; const int par = (F.vcu >> 4) & 1, k4 = 4 * (it >> 1);
            blk = (it & 1) ? 16 - par - k4 : 1 + par + k4; }
        else { const int uid = F.vcu + it * F.G; if (uid >= nunits) break; b = uid >> 6; sub = (uid >> 4) & 3; blk = 1 + (uid & 15); }
        const int t0 = (blk - 1) * BLK + sub * 32;
        const size_t qrow0 = (size_t)b * SEQ + t0;
        size_t qrow0_next = qrow0;
        { int bn = b, blkn = blk, subn = sub; bool has = false;
          if (F.G == 256) { if (it + 1 < 8) { const int v_ = F.vcu & 31; const int par_ = (F.vcu >> 4) & 1, k4_ = 4 * ((it + 1) >> 1); bn = 4 * (F.vcu >> 5) + (F.vcu & 3); subn = (F.vcu >> 2) & 3;
                                              blkn = ((it + 1) & 1) ? 16 - par_ - k4_ : 1 + par_ + k4_; has = true; (void)v_; } }
          else { const int uid_ = F.vcu + (it + 1) * F.G; if (uid_ < nunits) { bn = uid_ >> 6; subn = (uid_ >> 4) & 3; blkn = 1 + (uid_ & 15); has = true; } }
          if (has) qrow0_next = (size_t)bn * SEQ + (size_t)((blkn - 1) * BLK + subn * 32); }
        const int ntile = (blk + 1) * 8;
        const GAS h16* ikb = (const GAS h16*)(F.IKN() + (size_t)b * P * 64);
        const bool need_radix = (BLK + t0 + 31 - NPAD + 1) > TOPK;
        PSEC_BEGIN(0);
        unsigned sk[2][17][4];
#pragma unroll
        for (int gq = 0; gq < 2; ++gq) {
            h16x8 qb[4][2];
#pragma unroll
            for (int h = 0; h < 4; ++h)
#pragma unroll
                for (int ks = 0; ks < 2; ++ks) qb[h][ks] = *(const GAS h16x8*)((const GAS h16*)F.IQ() + (qrow0 + 16 * gq + n16) * 256 + h * 64 + ks * 32 + 8 * g);
            const f32x4 wv = *(const GAS f32x4*)((const GAS float*)F.IWS() + (qrow0 + 16 * gq + n16) * 4);
            const unsigned pfi = *(const GAS unsigned*)((const GAS char*)F.IQ() + ((gq == 0 ? qrow0 + 16 : qrow0_next) + (size_t)(lane & 15)) * 512 + (size_t)(lane >> 4) * 128);
            const int qpos = BLK + t0 + 16 * gq + n16;
            int kb1 = w * 16 + 4 * g; asm volatile("" : "+v"(kb1));
            const GAS h16* ap = ikb + (size_t)(w * 16 + n16) * 64 + 8 * g;
            h16x8 A0[22], A1[22];
            { const u32x4 z = {0u, 0u, 0u, 0u};
#pragma unroll
              for (int j = 0; j < 22; ++j) { A0[j] = __builtin_bit_cast(h16x8, z); A1[j] = A0[j]; } }
#pragma unroll
            for (int j = 0; j < 3; ++j) if (w + 8 * j < ntile) { A0[j] = *(const GAS h16x8*)(ap + 8192 * j); A1[j] = *(const GAS h16x8*)(ap + 8192 * j + 32); }
            ap += 2 * 8192;
#pragma unroll
            for (int j = 0; j < 17; ++j) {
                const int kt = w + 8 * j;
                ap += 8192; asm volatile("" : "+v"(ap));
                if (j + 3 < 17 && kt + 24 < ntile) { A0[j + 3] = *(const GAS h16x8*)ap; A1[j + 3] = *(const GAS h16x8*)(ap + 32); }
                asm volatile("" ::: "memory");
                if (kt < ntile) {
                    float sc[4] = {0.f, 0.f, 0.f, 0.f};
#pragma unroll
                    for (int h = 0; h < 4; ++h) { f32x4 c = {0.f, 0.f, 0.f, 0.f};
                        c = __builtin_amdgcn_mfma_f32_16x16x32_f16(A0[j], qb[h][0], c, 0, 0, 0); c = __builtin_amdgcn_mfma_f32_16x16x32_f16(A1[j], qb[h][1], c, 0, 0, 0);
#pragma unroll
                        for (int r = 0; r < 4; ++r) sc[r] += relu1(c[r]) * wv[h]; }
                    const unsigned zk = 0x7fffffffu - (unsigned)(kb1 + 128 * j);
#pragma unroll
                    for (int r = 0; r < 4; ++r) { const unsigned bits = __builtin_bit_cast(unsigned, sc[r]);
                        const unsigned key = bits ^ ((unsigned)((int)bits >> 31) | 0x80000000u);
                        sk[gq][j][r] = (sc[r] == 0.f) ? zk - (unsigned)r : key; }
                    if (kt < 7 || kt * 16 + 15 > BLK + t0 + 16 * gq) {
#pragma unroll
                        for (int r = 0; r < 4; ++r) { const int kpos = kb1 + 128 * j + r; if (kpos < NPAD || kpos > qpos) sk[gq][j][r] = 0u; }
                    }
                    if (need_radix) {
#pragma unroll
                        for (int r = 0; r < 4; ++r) __hip_atomic_fetch_add(HIST + (unsigned)(16 * gq + n16) * (unsigned)HROW + (sk[gq][j][r] >> 24), 1u, __ATOMIC_RELAXED, __HIP_MEMORY_SCOPE_WORKGROUP);
                    }
                } else {
#pragma unroll
                    for (int r = 0; r < 4; ++r) sk[gq][j][r] = 0u;
                }
            }
            asm volatile("" :: "v"(pfi));
        }
        PSEC_END(0); PSEC_BEGIN(1);
        unsigned prefix[2] = {0u, 0u}, T[2] = {1u, 1u}; int need[2]; bool done[2]; unsigned hbase[2];
#pragma unroll
        for (int gq = 0; gq < 2; ++gq) { const int nadm = BLK + t0 + 16 * gq + n16 - NPAD + 1; need[gq] = nadm < TOPK ? nadm : TOPK; done[gq] = (nadm <= TOPK); hbase[gq] = (unsigned)(16 * gq + n16) * (unsigned)HROW; }
        const unsigned sink = (unsigned)(L3_DUMMY - L3_HIST) / 4u + (unsigned)tid;
#define RADIX_SCAN_UPDATE() do { \
            __syncthreads(); \
            { \
                const int qs = 4 * w + g, l16 = n16; \
                LAS u32x4* hp = (LAS u32x4*)(HIST + qs * HROW + 16 * l16); \
                const u32x4 c0 = hp[0], c1 = hp[1], c2 = hp[2], c3 = hp[3]; const u32x4 z = {0u, 0u, 0u, 0u}; hp[0] = z; hp[1] = z; hp[2] = z; hp[3] = z; \
                const unsigned cnt[16] = {c0[0], c0[1], c0[2], c0[3], c1[0], c1[1], c1[2], c1[3], c2[0], c2[1], c2[2], c2[3], c3[0], c3[1], c3[2], c3[3]}; \
                unsigned t = 0u; \
_Pragma("unroll") \
                for (int i = 0; i < 16; ++i) t += cnt[i]; \
                unsigned incl = t; \
_Pragma("unroll") \
                for (int d = 1; d < 16; d <<= 1) { const unsigned v = (unsigned)__shfl_down((int)incl, d, 16); incl += (l16 + d < 16) ? v : 0u; } \
                const unsigned S = incl - t; \
 \
                const int nq = 4 * (w & 3) + g; \
                const unsigned mq = (w >= 4) ? (unsigned)__shfl(need[1], nq) : (unsigned)__shfl(need[0], nq); \
                const int dq = (w >= 4) ? __shfl((int)done[1], nq) : __shfl((int)done[0], nq); \
                if (!dq && S < mq && mq <= S + t) { \
                    unsigned acc = S, bsel = 0u, msel = 0u, csel = 0u; \
_Pragma("unroll") \
                    for (int i = 15; i >= 0; --i) { if (acc < mq && mq <= acc + cnt[i]) { bsel = (unsigned)(16 * l16 + i); msel = mq - acc; csel = cnt[i]; } acc += cnt[i]; } \
                    RES[qs * 4 + 0] = bsel; RES[qs * 4 + 1] = msel; RES[qs * 4 + 2] = csel; \
                } \
            } \
            __syncthreads(); \
_Pragma("unroll") \
            for (int gq = 0; gq < 2; ++gq) \
                if (!done[gq]) { const int qi = 16 * gq + n16; const unsigned bsel = RES[qi * 4 + 0], msel = RES[qi * 4 + 1], csel = RES[qi * 4 + 2]; \
                    prefix[gq] |= bsel << shift; \
                    if (csel == msel || pass == 3) { done[gq] = true; T[gq] = prefix[gq]; } else need[gq] = (int)msel; } \
 \
        } while (0)
        if (__any(!done[0] || !done[1])) {
            { const int pass = 0, shift = 24; RADIX_SCAN_UPDATE(); }
#pragma unroll 1
            for (int pass = 1; pass < 4; ++pass) {
                if (!__any(!done[0] || !done[1])) break;
                const int shift = 24 - 8 * pass;
#pragma unroll
                for (int gq = 0; gq < 2; ++gq) {
                    const unsigned pfx = done[gq] ? 0xffffffffu : prefix[gq];
#pragma unroll
                    for (int j = 0; j < 17; ++j) if (w + 8 * j < ntile) {
                        unsigned mm[4];
#pragma unroll
                        for (int r = 0; r < 4; ++r) mm[r] = ((sk[gq][j][r] ^ pfx) >> shift) >> 8;
                        if (pass == 1 || __any((mm[0] == 0u) | (mm[1] == 0u) | (mm[2] == 0u) | (mm[3] == 0u))) {
#pragma unroll
                            for (int r = 0; r < 4; ++r) { const unsigned slot = mm[r] ? sink : hbase[gq] + ((sk[gq][j][r] >> shift) & 255u);
                                __hip_atomic_fetch_add(HIST + slot, 1u, __ATOMIC_RELAXED, __HIP_MEMORY_SCOPE_WORKGROUP); } } } }
                RADIX_SCAN_UPDATE();
            }
        }
#undef RADIX_SCAN_UPDATE
        PSEC_END(1); PSEC_BEGIN(2);
        {
            int kb2 = w * 16 + 4 * g; asm volatile("" : "+v"(kb2));
            const int mine = w * 4 + g;
#pragma unroll
            for (int gq = 0; gq < 2; ++gq) { int c = 0;
#pragma unroll
                for (int j = 0; j < 17; ++j) if (w + 8 * j < ntile) {
#pragma unroll
                    for (int r = 0; r < 4; ++r) c += (sk[gq][j][r] >= T[gq]) ? 1 : 0; }
                CNT2[(16 * gq + n16) * 32 + mine] = (unsigned)c; }
            __syncthreads();
#pragma unroll
            for (int gq = 0; gq < 2; ++gq) { const int qi = 16 * gq + n16; int off = 0;
#pragma unroll
                for (int o4 = 0; o4 < 8; ++o4) { const u32x4 cv = *(const LAS u32x4*)(CNT2 + qi * 32 + 4 * o4);
#pragma unroll
                    for (int e = 0; e < 4; ++e) off += (4 * o4 + e < mine) ? (int)cv[e] : 0; }
                unsigned cur = (unsigned)(L3_SEL + (qi * 256 + off) * 2); const unsigned lim = (unsigned)(L3_SEL + (qi * 256 + 255) * 2), trash = (unsigned)(L3_DUMMY + 2048 + tid * 2);
#pragma unroll
                for (int j = 0; j < 17; ++j) if (w + 8 * j < ntile) {
#pragma unroll
                    for (int r = 0; r < 4; ++r) { const bool selk = sk[gq][j][r] >= T[gq];
                        *(LAS unsigned short*)(lds + (selk ? (cur < lim ? cur : lim) : trash)) = (unsigned short)(kb2 + 128 * j + r); cur += selk ? 2u : 0u; } } }
            if (BLK + t0 - NPAD + 1 < TOPK) {
                for (int e = tid; e < 32 * 256; e += 512) { const int qpe = BLK + t0 + (e >> 8), nse = qpe - NPAD + 1; if ((e & 255) >= nse) SEL[e] = (unsigned short)(qpe + 1); }
            }
            __syncthreads();
        }
        PSEC_END(2); PSEC_BEGIN(3);
        const __amdgpu_buffer_rsrc_t crs = __builtin_amdgcn_make_buffer_rsrc((void*)(F.CKV() + (size_t)b * P * 128), 0, P * 256, 0x00020000);
            u32x4 G[16];
            const unsigned goff = (unsigned)n16 * 16u;
#define MLA_GATHER(sq_, c_) do { _Pragma("unroll") for (int kk = 0; kk < 2; ++kk) { const int i0_ = 64 * (c_) + 32 * kk + 8 * g; const u32x4 sv_ = *(const LAS u32x4*)((sq_) + i0_); \
                _Pragma("unroll") for (int i = 0; i < 8; ++i) {   \
                const unsigned vo_ = __builtin_amdgcn_perm(sv_[i >> 1], goff, (i & 1) ? 0x01070600u : 0x01050400u); \
                G[8 * kk + i] = __builtin_bit_cast(u32x4, __builtin_amdgcn_raw_buffer_load_b128(crs, (int)vo_, 0, 0)); } } } while (0)
#define MLA_WRITE() do { _Pragma("unroll") for (int kk = 0; kk < 2; ++kk) _Pragma("unroll") for (int i = 0; i < 8; ++i) *(LAS u32x4*)(stage + wbase[i >> 2] + 8192 * kk + 64 * i) = G[8 * kk + i]; } while (0)
            const unsigned qd = (unsigned)(n16 >> 2), pp = (unsigned)(lane & 3), ph = pp >> 1;
            unsigned rbase[2], tbase[2][2], wbase[2];
#pragma unroll
            for (int t = 0; t < 2; ++t) { rbase[t] = 2048u * qd + 64u * (4u * t + (n16 & 3)) + 16u * ((unsigned)g ^ ((2u * qd + t) & 3u));
                wbase[t] = 2048u * g + 512u * qd + 16u * ((unsigned)(n16 & 3) ^ (2u * (g & 1) + t));
#pragma unroll
                for (int mp = 0; mp < 2; ++mp) tbase[mp][t] = 2048u * g + 64u * (4u * t + qd) + 16u * ((2u * mp + ph) ^ (2u * (g & 1) + t)) + 8u * (pp & 1); }
            MLA_GATHER(SEL + w * 256, 0);
            h16x8 qa[4]; float rsqn;
#define MLA_QLOAD(row_) do { _Pragma("unroll") for (int ks = 0; ks < 4; ++ks) qa[ks] = *(const GAS h16x8*)((const GAS h16*)F.QABS() + (row_) * 1024 + (n16 & 7) * 128 + ks * 32 + 8 * g); rsqn = F.RSQ()[row_]; } while (0)
            MLA_QLOAD(qrow0 + w);
#pragma unroll 1
        for (int qq = w; qq < 32; qq += 8) {
            const size_t qrow = qrow0 + qq; const int qp = BLK + t0 + qq;
            const int nsel = (qp - NPAD + 1) < TOPK ? (qp - NPAD + 1) : TOPK, nch = (nsel + 63) >> 6;
            const float rsq = __builtin_bit_cast(float, __builtin_amdgcn_readfirstlane(__builtin_bit_cast(int, rsqn)));
            const LAS float* tb = TB + (n16 & 7) * TBLW + 1;
            const LAS unsigned short* selq = SEL + qq * 256;
            const unsigned pfq = *(const GAS unsigned*)((const GAS char*)F.QABS() + (qrow + (qq + 8 < 32 ? 8 : 0)) * 2048 + (size_t)(lane & 15) * 128);
            float m_run = -1e30f, l_run = 0.f;
            f32x4 o[8];
#pragma unroll
            for (int mt = 0; mt < 8; ++mt) o[mt] = (f32x4){0.f, 0.f, 0.f, 0.f};
            MLA_WRITE();
            if (nch > 1) MLA_GATHER(selq, 1); else if (qq + 8 < 32) MLA_GATHER(selq + 8 * 256, 0);
            for (int c = 0; c < nch; ++c) {
                h16x8 af[16];
                float bia[2][8];
#define MLA_BIAS(kk_) do { const u32x4 sv = *(const LAS u32x4*)(selq + 64 * c + 32 * (kk_) + 8 * g); \
                    _Pragma("unroll") for (int e = 0; e < 8; ++e) { const int kp = (int)((sv[e >> 1] >> (16 * (e & 1))) & 0xffffu); int dist = qp - kp; dist = dist < -1 ? -1 : dist; dist = dist < 128 ? dist : 128; bia[kk_][e] = tb[dist]; } } while (0)
#pragma unroll
                for (int q8 = 0; q8 < 8; ++q8) af[q8] = *(const LAS h16x8*)(stage + rbase[(q8 >> 2) & 1] + 8192 * (q8 >> 3) + 512 * (q8 & 3));
                __builtin_amdgcn_sched_barrier(0);
#pragma unroll
                for (int q8 = 8; q8 < 16; ++q8) af[q8] = *(const LAS h16x8*)(stage + rbase[(q8 >> 2) & 1] + 8192 * (q8 >> 3) + 512 * (q8 & 3));
                MLA_BIAS(0);
                f32x4 st[4];
#pragma unroll
                for (int tt = 0; tt < 2; ++tt) { st[tt] = (f32x4){0.f, 0.f, 0.f, 0.f};
#pragma unroll
                    for (int ks = 0; ks < 4; ++ks) st[tt] = __builtin_amdgcn_mfma_f32_16x16x32_f16(af[4 * tt + ks], qa[ks], st[tt], 0, 0, 0); }
                __builtin_amdgcn_sched_barrier(0);
                { float mx = NINF;
#pragma unroll
                  for (int t = 0; t < 2; ++t)
#pragma unroll
                    for (int r = 0; r < 4; ++r) { const float v = st[t][r] * rsq + bia[0][4 * t + r]; st[t][r] = v; mx = fmaxf(mx, v); }
                  if (__any(mx > m_run + 8.0f)) {
                    mx = fmaxf(mx, __shfl_xor(mx, 16)); mx = fmaxf(mx, __shfl_xor(mx, 32));
                    const float m_new = fmaxf(m_run, mx), alpha = __builtin_amdgcn_exp2f(m_run - m_new);
                    l_run *= alpha; m_run = m_new;
#pragma unroll
                    for (int mt = 0; mt < 8; ++mt) o[mt] = o[mt] * alpha;
                  } }
                __builtin_amdgcn_sched_barrier(0);
                h16x4 vlo[2][8], vhi[2][8];
#pragma unroll
                for (int mt = 0; mt < 8; ++mt) { vlo[0][mt] = ds_tr16(stage + tbase[mt & 1][0] + 512 * (mt >> 1)); vhi[0][mt] = ds_tr16(stage + tbase[mt & 1][1] + 512 * (mt >> 1)); }
                MLA_BIAS(1);
#pragma unroll
                for (int tt = 2; tt < 4; ++tt) { st[tt] = (f32x4){0.f, 0.f, 0.f, 0.f};
#pragma unroll
                    for (int ks = 0; ks < 4; ++ks) st[tt] = __builtin_amdgcn_mfma_f32_16x16x32_f16(af[4 * tt + ks], qa[ks], st[tt], 0, 0, 0); }
                { float ps = 0.f;
#pragma unroll
                  for (int tt = 0; tt < 2; ++tt)
#pragma unroll
                    for (int r = 0; r < 4; ++r) { const float p = __builtin_amdgcn_exp2f(st[tt][r] - m_run); st[tt][r] = p; ps += p; }
                  l_run += ps; }
                __builtin_amdgcn_sched_barrier(0);
                if (c + 1 == nch) MLA_QLOAD(qrow + (qq + 8 < 32 ? 8 : 0));
                __builtin_amdgcn_sched_barrier(0);
                { float mx = NINF;
#pragma unroll
                  for (int t = 0; t < 2; ++t)
#pragma unroll
                    for (int r = 0; r < 4; ++r) { const float v = st[2 + t][r] * rsq + bia[1][4 * t + r]; st[2 + t][r] = v; mx = fmaxf(mx, v); }
                  if (__any(mx > m_run + 8.0f)) {
                    mx = fmaxf(mx, __shfl_xor(mx, 16)); mx = fmaxf(mx, __shfl_xor(mx, 32));
                    const float m_new = fmaxf(m_run, mx), alpha = __builtin_amdgcn_exp2f(m_run - m_new);
                    l_run *= alpha; m_run = m_new;
#pragma unroll
                    for (int mt = 0; mt < 8; ++mt) o[mt] = o[mt] * alpha;
                    st[0] = st[0] * alpha; st[1] = st[1] * alpha;
                  } }
                __builtin_amdgcn_sched_barrier(0);
#pragma unroll
                for (int mt = 0; mt < 8; ++mt) { vlo[1][mt] = ds_tr16(stage + tbase[mt & 1][0] + 8192 + 512 * (mt >> 1)); vhi[1][mt] = ds_tr16(stage + tbase[mt & 1][1] + 8192 + 512 * (mt >> 1)); }
                { const u32x4 pw = {pk_h2(st[0][0], st[0][1]), pk_h2(st[0][2], st[0][3]), pk_h2(st[1][0], st[1][1]), pk_h2(st[1][2], st[1][3])};
                  const h16x8 pb = __builtin_bit_cast(h16x8, pw);
#pragma unroll
                  for (int mt = 0; mt < 8; ++mt) { const h16x4 lo4 = vlo[0][mt], hi4 = vhi[0][mt];
                    const h16x8 a = {lo4[0], lo4[1], lo4[2], lo4[3], hi4[0], hi4[1], hi4[2], hi4[3]};
                    o[mt] = __builtin_amdgcn_mfma_f32_16x16x32_f16(a, pb, o[mt], 0, 0, 0); } }
                { float ps = 0.f;
#pragma unroll
                  for (int tt = 2; tt < 4; ++tt)
#pragma unroll
                    for (int r = 0; r < 4; ++r) { const float p = __builtin_amdgcn_exp2f(st[tt][r] - m_run); st[tt][r] = p; ps += p; }
                  l_run += ps; }
                __builtin_amdgcn_sched_barrier(0);
                { const u32x4 pw = {pk_h2(st[2][0], st[2][1]), pk_h2(st[2][2], st[2][3]), pk_h2(st[3][0], st[3][1]), pk_h2(st[3][2], st[3][3])};
                  const h16x8 pb = __builtin_bit_cast(h16x8, pw);
#pragma unroll
                  for (int mt = 0; mt < 4; ++mt) { const h16x4 lo4 = vlo[1][mt], hi4 = vhi[1][mt];
                    const h16x8 a = {lo4[0], lo4[1], lo4[2], lo4[3], hi4[0], hi4[1], hi4[2], hi4[3]};
                    o[mt] = __builtin_amdgcn_mfma_f32_16x16x32_f16(a, pb, o[mt], 0, 0, 0); }
                  if (c + 1 < nch) { MLA_WRITE(); if (c + 2 < nch) MLA_GATHER(selq, c + 2); else if (qq + 8 < 32) MLA_GATHER(selq + 8 * 256, 0); }
#pragma unroll
                  for (int mt = 4; mt < 8; ++mt) { const h16x4 lo4 = vlo[1][mt], hi4 = vhi[1][mt];
                    const h16x8 a = {lo4[0], lo4[1], lo4[2], lo4[3], hi4[0], hi4[1], hi4[2], hi4[3]};
                    o[mt] = __builtin_amdgcn_mfma_f32_16x16x32_f16(a, pb, o[mt], 0, 0, 0); } }
#undef MLA_BIAS
            }
#undef MLA_GATHER
#undef MLA_WRITE
#undef MLA_QLOAD
            asm volatile("" :: "v"(pfq));
            l_run += __shfl_xor(l_run, 16); l_run += __shfl_xor(l_run, 32);
            const float inv = 1.0f / l_run;
            if (n16 < 8) { h16* op = F.LAT() + qrow * 1024 + n16 * 128 + 4 * g;
#pragma unroll
                for (int mt = 0; mt < 8; ++mt) { u32x2 ww; ww.x = pk_h2(o[mt][0] * inv, o[mt][1] * inv); ww.y = pk_h2(o[mt][2] * inv, o[mt][3] * inv); *(u32x2*)(op + 16 * mt) = ww; } }
        }
        { const u32x4 z = {0u, 0u, 0u, 0u};
          if (w < 2) {
#pragma unroll
            for (int i = 0; i < 16; ++i) *(LAS u32x4*)(lds + L3_HIST + w * 16384 + i * 1024 + lane_id_v() * 16) = z;
          } else if (w == 2) { if (lane_id_v() < (32 * HROW * 4 - 32768) / 16) *(LAS u32x4*)(lds + L3_HIST + 32768 + lane_id_v() * 16) = z; } }
        PSEC_END(3);
        __syncthreads();
    }
    PSEC_END(4); PSEC_BURN(0, 4);
}

__device__ __forceinline__ void final_norm_phase(Frame& F) {
    const int gw = F.vcu * NWAVES + F.wave, NGW = F.G * NWAVES, lane = F.lane();
    const f32x4 g4[4] = {((const f32x4*)F.gf())[2 * lane], ((const f32x4*)F.gf())[2 * lane + 1], ((const f32x4*)F.gf())[128 + 2 * lane], ((const f32x4*)F.gf())[128 + 2 * lane + 1]};
    u32x4 hn[2][2]; f32x4 sn[2][4];
#define P9_LOAD(r0_) do { _Pragma("unroll") for (int q = 0; q < 2; ++q) { const int r_ = (r0_) + q * NGW; if (r_ < M) { \
        const u32x4* hr_ = (const u32x4*)(F.H2() + (size_t)r_ * D) + lane; hn[q][0] = hr_[0]; hn[q][1] = hr_[64];       \
        const f32x4* sp_ = (const f32x4*)(F.SSQ2() + (size_t)r_ * 16); sn[q][0] = sp_[0]; sn[q][1] = sp_[1]; sn[q][2] = sp_[2]; sn[q][3] = sp_[3]; } } } while (0)
    P9_LOAD(gw);
    for (int row = gw; row < M; row += 2 * NGW) {
        u32x4 hc[2][2]; f32x4 sc[2][4];
#pragma unroll
        for (int q = 0; q < 2; ++q) { hc[q][0] = hn[q][0]; hc[q][1] = hn[q][1]; sc[q][0] = sn[q][0]; sc[q][1] = sn[q][1]; sc[q][2] = sn[q][2]; sc[q][3] = sn[q][3]; }
        if (row + 2 * NGW < M) P9_LOAD(row + 2 * NGW);
#pragma unroll
        for (int q = 0; q < 2; ++q) { const int r = row + q * NGW; if (r < M) {
            const f32x4 t = (sc[q][0] + sc[q][1]) + (sc[q][2] + sc[q][3]);
            const float rs = __builtin_amdgcn_rsqf(((t[0] + t[1]) + (t[2] + t[3])) * (1.0f / 1024.0f) + EPS);
            f32x4* orow = (f32x4*)(F.out() + (size_t)r * D);
#pragma unroll
            for (int j = 0; j < 2; ++j) { const h16x8 h = __builtin_bit_cast(h16x8, hc[q][j]);
                orow[128 * j + 2 * lane] = (f32x4){(float)h[0], (float)h[1], (float)h[2], (float)h[3]} * rs * g4[2 * j];
                orow[128 * j + 2 * lane + 1] = (f32x4){(float)h[4], (float)h[5], (float)h[6], (float)h[7]} * rs * g4[2 * j + 1]; } } }
    }
#undef P9_LOAD
}

#ifndef MK_N_LAUNCHES
#define MK_N_LAUNCHES 1
#endif
constexpr int N_PHASES = 10;
__global__ void __launch_bounds__(NWAVES * 64, 2) fwd_kernel(Args args) {
    extern __shared__ __attribute__((aligned(16))) unsigned char lds_raw[];
    Frame F(args);
    F.lds = (LAS unsigned char*)lds_raw;
    F.wave = __builtin_amdgcn_readfirstlane((int)threadIdx.x >> 6);
    F.G = gridDim.x; { const int bx = blockIdx.x; F.vcu = (F.G % 8 == 0) ? (bx % 8) * (F.G / 8) + bx / 8 : bx; }
    unsigned char* ws = args.ws;
    F.ws = ws;
    for (int u = F.tid(); u < (LDS_BYTES - LDSCTL_OFF) / 4; u += NWAVES * 64) ((LAS unsigned*)(F.lds + LDSCTL_OFF))[u] = 0u;
    __syncthreads();
    XcdBarrier bar; bar.bar = (unsigned*)(ws + WS_CTL) + CW_BAR; bar.x = 0; bar.st = nullptr;
    if (MK_N_LAUNCHES == 1) bar = xcd_barrier_post((unsigned*)(ws + WS_CTL) + CW_BAR, (volatile LAS unsigned*)(F.lds + MISC_OFF) + 8, F.wave);
    const int lo = args.ph_lo, hi = args.ph_hi;
#ifndef PHMASK
#define PHMASK 0x3ff
#endif
#define IN(k) ((((PHMASK) >> (k)) & 1) && lo <= (k) && (k) < hi)
#ifdef PROBE_PH
    unsigned long long ppt0_ = 0ull, ppacc_ = 0ull;
#define SEAM(k) do { if ((k) + 1 == PROBE_PH) { if (IN(k) && IN((k) + 1)) xcd_barrier(bar); ppt0_ = __builtin_amdgcn_s_memtime(); } \
        else if ((k) == PROBE_PH) { if (IN(k) && IN((k) + 1)) xcd_barrier(bar); ppacc_ = __builtin_amdgcn_s_memtime() - ppt0_; } \
        else { if (IN(k) && IN((k) + 1)) xcd_barrier(bar); } } while (0)
    if (PROBE_PH == 0) ppt0_ = __builtin_amdgcn_s_memtime();
#else
#define SEAM(k) do { if (MK_N_LAUNCHES == 1) { if (IN(k) && IN((k) + 1)) xcd_barrier(bar); } } while (0)
#endif

    if (IN(0)) { p0_prologue(F); } SEAM(0);
    if (IN(1)) {
        pg8::Gemm g{F.XH(), F.Win_t(), M, DINP, D}; pg8::StaticOrder S; S.init(M, DINP, F.G, (int)blockIdx.x);
        EpiInProj E{F.RS1(), F.AQ(), F.AK(), F.AV(), F.BQ(), F.RAW4(), F.IQ(), F.GATES(), F.bg()};
        pg8::gemm_phase<EpiInProj, pg8::StaticOrder>(F.lds + RING_OFF, g, S, E, F.wave);
    } SEAM(1);
    if (IN(2)) {
#ifndef NO_NORMS
        p2_norms(F);
#endif
        { pg8::Gemm g{F.BQ(), F.Wqabs_t(), M, 1024, 256}; pg8::StaticOrder S; S.init(M, 1024, F.G, (int)blockIdx.x);
          EpiH16 E{F.QABS(), 1024};
          pg8::gemm_phase<EpiH16, pg8::StaticOrder>(F.lds + RING_OFF, g, S, E, F.wave); }
    } SEAM(2);
    if (IN(3)) {
#ifndef NO_MIXER_B
        mixer_b_phase(F);
#endif
#ifndef NO_ATTN_A
        attn_a_phase(F);
#endif
    } SEAM(3);
    if (IN(4)) {
        { pg8::Gemm g{F.OA(), F.Wa_t(), M, D, 512}; pg8::StaticOrder S; S.init(M, D, F.G, (int)blockIdx.x);
          EpiGate<false> E{F.GATES(), F.MIXED()};
          pg8::gemm_phase<EpiGate<false>, pg8::StaticOrder>(F.lds + RING_OFF, g, S, E, F.wave); }
        { pg8::Gemm g{F.LAT(), F.Wuvb_t(), M, D, 1024}; pg8::StaticOrder S; S.init(M, D, F.G, (int)blockIdx.x);
          EpiGate<true> E{F.GATES() + 1024, F.MIXED()};
          pg8::gemm_phase<EpiGate<true>, pg8::StaticOrder>(F.lds + RING_OFF, g, S, E, F.wave); }
    } SEAM(4);
    if (IN(6)) {
        pg8::Gemm g{F.MIXED(), F.Wo_t(), M, D, D}; pg8::StaticOrder S; S.init(M, D, F.G, (int)blockIdx.x);
        EpiWo E{F.XH(), F.H1(), F.SSQ1()};
        pg8::gemm_phase<EpiWo, pg8::StaticOrder>(F.lds + RING_OFF, g, S, E, F.wave);
    } SEAM(6);
    if (IN(7)) {
        pg8::Gemm g{F.H1(), F.Wgu_t(), M, NGU, D}; pg8::StaticOrder S; S.init(M, NGU, F.G, (int)blockIdx.x);
        {
            int last_pm = -1;
            for (int i = 0; ; ++i) { pg8::Unit u; if (!S.next(i, u)) break; if (u.pm == last_pm) continue; last_pm = u.pm;
                if (F.tid() < 256) { const int row = u.pm * 256 + F.tid(); F.RS2()[row] = row_rs16(F.SSQ1() + (size_t)row * 16); } }
            asm volatile("s_waitcnt vmcnt(0)" ::: "memory"); __syncthreads();
            __builtin_amdgcn_fence(__ATOMIC_ACQUIRE, "agent"); asm volatile("s_waitcnt vmcnt(0)" ::: "memory"); __syncthreads();
        }
        EpiSwiGLU E{F.RS2(), F.ACT()};
        pg8::gemm_phase<EpiSwiGLU, pg8::StaticOrder>(F.lds + RING_OFF, g, S, E, F.wave);
    } SEAM(7);
    if (IN(8)) {
        pg8::Gemm g{F.ACT(), F.Wd_t(), M, D, DFF}; pg8::StaticOrder S; S.init(M, D, F.G, (int)blockIdx.x);
        EpiDown E{F.H1(), F.H2(), F.SSQ2()};
        pg8::gemm_phase<EpiDown, pg8::StaticOrder>(F.lds + RING_OFF, g, S, E, F.wave);
    } SEAM(8);
    if (IN(9)) { final_norm_phase(F); }
#ifdef PROBE_PH
    if (PROBE_PH == 9) { asm volatile("s_waitcnt vmcnt(0)" ::: "memory"); ppacc_ = __builtin_amdgcn_s_memtime() - ppt0_; }
    if (blockIdx.x == 0) { const unsigned long long te = __builtin_amdgcn_s_memtime() + ppacc_; while (__builtin_amdgcn_s_memtime() < te) __builtin_amdgcn_s_sleep(8); }
#endif
#undef IN
#undef SEAM
}

extern "C" void kernel_launch(void* const* d_in, const int* in_sizes, int n_in, void* d_out, int out_size, void* d_ws, size_t ws_size, hipStream_t stream) {
    static int grid = 0;
    if (grid == 0) {
        if (n_in != 22 || in_sizes[0] != M * D || out_size != M * D || ws_size < WS_END) {
            fprintf(stderr, "kernel_launch: built for 22 inputs, x/out of %d floats, >= %zu bytes of workspace; got n_in %d, in0 %d, out %d, ws %zu; nothing launched\n", M * D, (size_t)WS_END, n_in, n_in > 0 ? in_sizes[0] : -1, out_size, ws_size);
            grid = -1; return; }
        int dev = 0, cus = 0, per_cu = 0;
        if (hipGetDevice(&dev) != hipSuccess || hipDeviceGetAttribute(&cus, hipDeviceAttributeMultiprocessorCount, dev) != hipSuccess) { fprintf(stderr, "kernel_launch: device query failed\n"); grid = -1; return; }
        if (hipFuncSetAttribute((const void*)fwd_kernel, hipFuncAttributeMaxDynamicSharedMemorySize, LDS_BYTES) != hipSuccess) { fprintf(stderr, "kernel_launch: hipFuncSetAttribute failed\n"); grid = -1; return; }
        if (hipOccupancyMaxActiveBlocksPerMultiprocessor(&per_cu, (const void*)fwd_kernel, NWAVES * 64, LDS_BYTES) != hipSuccess || per_cu < 1)
            fprintf(stderr, "kernel_launch: note: occupancy query reports %d workgroups per CU\n", per_cu);
        (void)hipGetLastError();
        grid = cus;
    }
    if (grid < 0) return;
    if (hipMemsetAsync((char*)d_ws + WS_CTL, 0, CTL_ZERO_BYTES, stream) != hipSuccess) { fprintf(stderr, "kernel_launch: hipMemsetAsync failed\n"); return; }
    Args a{};
    for (int i = 0; i < 22; ++i) a.in[i] = (const float*)d_in[i];
    a.out = (float*)d_out; a.ws = (unsigned char*)d_ws;
    for (int li = 0; li < MK_N_LAUNCHES; ++li) {
        a.ph_lo = (MK_N_LAUNCHES == 1) ? 0 : li; a.ph_hi = (MK_N_LAUNCHES == 1) ? N_PHASES : li + 1;
        hipLaunchKernelGGL(fwd_kernel, dim3(grid), dim3(NWAVES * 64), LDS_BYTES, stream, a);
        const hipError_t le = hipPeekAtLastError();
        if (le != hipSuccess) { fprintf(stderr, "kernel_launch: launch %d failed: %s\n", li, hipGetErrorName(le)); break; }
    }
}
```
